# Optimizing an MI355X kernel written in HIP

```python
import jax, jax.numpy as jnp
from jax import lax
import numpy as np

D_MODEL = 2048
BATCH = 4
SEQ = 4096
DEPTH = 1

GRID_W = 64
N_MEM = 256
HEAD_DIM = 128
NA_HEADS = 8
NA_WIN_ROWS = 8
NA_WIN_COLS = 16
SG_GROUPS = 4
SG_CHUNK = 128
MEM_HEADS = 4
D_NA = NA_HEADS * HEAD_DIM
D_SG = SG_GROUPS * HEAD_DIM
D_MEM = MEM_HEADS * HEAD_DIM
D_MIX = D_NA + D_SG + D_MEM
D_IN = 3 * D_NA + 2 * D_SG + D_MEM
D_FF = 5632
EPS = 1e-6
NEG_INF = -1e30

kernel_name = "hybrid_natten_gmlp_memxattn_macaron"


def _rmsnorm(x, g):
    xf = x.astype(jnp.float32)
    y = xf * lax.rsqrt(jnp.mean(xf * xf, axis=-1, keepdims=True) + EPS)
    return (y * g.astype(jnp.float32)).astype(x.dtype)


def _layernorm(x, g, b):
    xf = x.astype(jnp.float32)
    mu = jnp.mean(xf, axis=-1, keepdims=True)
    var = jnp.mean(jnp.square(xf - mu), axis=-1, keepdims=True)
    y = (xf - mu) * lax.rsqrt(var + EPS)
    return (y * g.astype(jnp.float32) + b.astype(jnp.float32)).astype(x.dtype)


def _swiglu(x, w_gate_up, w_down):
    gu = x @ w_gate_up
    g, u = jnp.split(gu, 2, axis=-1)
    return (jax.nn.silu(g) * u) @ w_down


def _neighbourhood_attention(q, k, v, rpb):
    B, T, H, Dh = q.shape
    rows = T // GRID_W
    kh = min(NA_WIN_ROWS, rows)
    qg = q.reshape(B, rows, GRID_W, H, Dh)
    kg = k.reshape(B, rows, GRID_W, H, Dh)
    vg = v.reshape(B, rows, GRID_W, H, Dh)
    r = jnp.arange(rows)
    row_start = jnp.clip(r - kh // 2, 0, rows - kh)
    key_rows = row_start[:, None] + jnp.arange(kh)[None, :]
    k_blk = kg[:, key_rows]
    v_blk = vg[:, key_rows]
    c = jnp.arange(GRID_W)
    col_start = jnp.clip(c - NA_WIN_COLS // 2, 0, GRID_W - NA_WIN_COLS)
    col_in = (c[None, :] >= col_start[:, None]) & (c[None, :] < col_start[:, None] + NA_WIN_COLS)
    dr = key_rows - r[:, None]
    dc = jnp.clip(c[None, :] - c[:, None], -(NA_WIN_COLS - 1), NA_WIN_COLS - 1)
    bias = rpb[:, dr[:, None, :, None] + (NA_WIN_ROWS - 1),
               dc[None, :, None, :] + (NA_WIN_COLS - 1)]
    scale = Dh ** -0.5
    s = jnp.einsum('brqhd,brikhd->bhrqik', qg, k_blk).astype(jnp.float32) * scale
    s = s + bias[None].astype(jnp.float32)
    s = jnp.where(col_in[None, None, None, :, None, :], s, NEG_INF)
    p = jax.nn.softmax(s.reshape(B, H, rows, GRID_W, kh * GRID_W), axis=-1)
    p = p.reshape(B, H, rows, GRID_W, kh, GRID_W).astype(v.dtype)
    o = jnp.einsum('bhrqik,brikhd->brqhd', p, v_blk)
    return o.reshape(B, T, H * Dh)


def _spatial_gating(z, ln_g, ln_b, w_s, b_s):
    B, T, _ = z.shape
    n = T // SG_CHUNK
    u, vv = jnp.split(z, 2, axis=-1)
    vv = vv.reshape(B, n, SG_CHUNK, SG_GROUPS, HEAD_DIM)
    vv = _layernorm(vv, ln_g, ln_b)
    mixed = jnp.einsum('gpq,bnqgc->bnpgc', w_s, vv) + b_s.T[None, None, :, :, None]
    return u * mixed.reshape(B, T, D_SG)


def _memory_attention(q, mem_n, w_mem_kv):
    B, M, _ = mem_n.shape
    kv = mem_n @ w_mem_kv
    km, vm = jnp.split(kv, 2, axis=-1)
    km = km.reshape(B, M, MEM_HEADS, HEAD_DIM)
    vm = vm.reshape(B, M, MEM_HEADS, HEAD_DIM)
    s = jnp.einsum('bthd,bmhd->bhtm', q, km).astype(jnp.float32) * (HEAD_DIM ** -0.5)
    p = jax.nn.softmax(s, axis=-1).astype(vm.dtype)
    o = jnp.einsum('bhtm,bmhd->bthd', p, vm)
    return o.reshape(q.shape[0], q.shape[1], D_MEM)


def _mixer(xn, mem_n, w_in, w_mem_kv, na_rpb, sg_ln_gain, sg_ln_bias, sg_w_spatial,
           sg_b_spatial, out_norm_na, out_norm_sg, out_norm_mem, w_out):
    B, T, _ = xn.shape
    proj = xn @ w_in
    q_na, k_na, v_na, z_sg, q_mem = jnp.split(
        proj, [D_NA, 2 * D_NA, 3 * D_NA, 3 * D_NA + 2 * D_SG], axis=-1)
    shp = (B, T, NA_HEADS, HEAD_DIM)
    y_na = _neighbourhood_attention(q_na.reshape(shp), k_na.reshape(shp), v_na.reshape(shp), na_rpb)
    y_sg = _spatial_gating(jax.nn.gelu(z_sg), sg_ln_gain, sg_ln_bias, sg_w_spatial, sg_b_spatial)
    y_mem = _memory_attention(q_mem.reshape(B, T, MEM_HEADS, HEAD_DIM), mem_n, w_mem_kv)
    y = jnp.concatenate([_rmsnorm(y_na, out_norm_na),
                         _rmsnorm(y_sg, out_norm_sg),
                         _rmsnorm(y_mem, out_norm_mem)], axis=-1)
    return y @ w_out


def setup_inputs(seed: int = 0) -> dict:
    key = jax.random.key(seed)
    ks = jax.random.split(key, 32)
    L = DEPTH

    def nrm(k, shape, scale):
        return jax.random.normal(k, shape, jnp.float32) * scale

    def gain(k, shape):
        return 1.0 + 0.05 * jax.random.normal(k, shape, jnp.float32)

    return {
        "x": nrm(ks[0], (BATCH, SEQ, D_MODEL), 1.0),
        "mem": nrm(ks[1], (BATCH, N_MEM, D_MODEL), 1.0),
        "ffn1_norm_pre": gain(ks[2], (L, D_MODEL)),
        "ffn1_w_gate_up": nrm(ks[3], (L, D_MODEL, 2 * D_FF), D_MODEL ** -0.5),
        "ffn1_w_down": nrm(ks[4], (L, D_FF, D_MODEL), D_FF ** -0.5),
        "ffn1_norm_post": gain(ks[5], (L, D_MODEL)),
        "mix_norm_pre": gain(ks[6], (L, D_MODEL)),
        "mem_norm": gain(ks[7], (L, D_MODEL)),
        "w_in": nrm(ks[8], (L, D_MODEL, D_IN), D_MODEL ** -0.5),
        "w_mem_kv": nrm(ks[9], (L, D_MODEL, 2 * D_MEM), D_MODEL ** -0.5),
        "na_rpb": nrm(ks[10], (L, NA_HEADS, 2 * NA_WIN_ROWS - 1, 2 * NA_WIN_COLS - 1), 0.1),
        "sg_ln_gain": gain(ks[11], (L, SG_GROUPS, HEAD_DIM)),
        "sg_ln_bias": nrm(ks[12], (L, SG_GROUPS, HEAD_DIM), 0.02),
        "sg_w_spatial": nrm(ks[13], (L, SG_GROUPS, SG_CHUNK, SG_CHUNK), SG_CHUNK ** -0.5),
        "sg_b_spatial": nrm(ks[14], (L, SG_GROUPS, SG_CHUNK), 0.02),
        "out_norm_na": gain(ks[15], (L, D_NA)),
        "out_norm_sg": gain(ks[16], (L, D_SG)),
        "out_norm_mem": gain(ks[17], (L, D_MEM)),
        "w_out": nrm(ks[18], (L, D_MIX, D_MODEL), D_MIX ** -0.5),
        "mix_norm_post": gain(ks[19], (L, D_MODEL)),
        "ffn2_norm_pre": gain(ks[20], (L, D_MODEL)),
        "ffn2_w_gate_up": nrm(ks[21], (L, D_MODEL, 2 * D_FF), D_MODEL ** -0.5),
        "ffn2_w_down": nrm(ks[22], (L, D_FF, D_MODEL), D_FF ** -0.5),
        "ffn2_norm_post": gain(ks[23], (L, D_MODEL)),
        "final_norm": gain(ks[24], (L, D_MODEL)),
    }


def reference(x, mem, ffn1_norm_pre, ffn1_w_gate_up, ffn1_w_down, ffn1_norm_post,
              mix_norm_pre, mem_norm, w_in, w_mem_kv, na_rpb, sg_ln_gain, sg_ln_bias,
              sg_w_spatial, sg_b_spatial, out_norm_na, out_norm_sg, out_norm_mem, w_out,
              mix_norm_post, ffn2_norm_pre, ffn2_w_gate_up, ffn2_w_down, ffn2_norm_post,
              final_norm):
    h = x
    for l in range(DEPTH):
        f = _swiglu(_rmsnorm(h, ffn1_norm_pre[l]), ffn1_w_gate_up[l], ffn1_w_down[l])
        h = h + 0.5 * _rmsnorm(f, ffn1_norm_post[l])
        xn = _rmsnorm(h, mix_norm_pre[l])
        mem_n = _rmsnorm(mem, mem_norm[l])
        m = _mixer(xn, mem_n, w_in[l], w_mem_kv[l], na_rpb[l], sg_ln_gain[l], sg_ln_bias[l],
                   sg_w_spatial[l], sg_b_spatial[l], out_norm_na[l], out_norm_sg[l],
                   out_norm_mem[l], w_out[l])
        h = h + _rmsnorm(m, mix_norm_post[l])
        f = _swiglu(_rmsnorm(h, ffn2_norm_pre[l]), ffn2_w_gate_up[l], ffn2_w_down[l])
        h = h + 0.5 * _rmsnorm(f, ffn2_norm_post[l])
        h = _rmsnorm(h, final_norm[l])
    return h
```

```cpp
#include <hip/hip_runtime.h>
#include <hip/hip_cooperative_groups.h>
#include <cstdio>
namespace cg = cooperative_groups;

#ifndef MULTI_LAUNCH
#define MULTI_LAUNCH 0
#endif
#ifndef NAIVE_GEMM
#define NAIVE_GEMM 0
#endif
#ifndef NAIVE_P5
#define NAIVE_P5 0
#endif

#define LAS __attribute__((address_space(3)))
typedef unsigned short bf16_t;
typedef short bf16x8 __attribute__((ext_vector_type(8)));
typedef float f32x4 __attribute__((ext_vector_type(4)));
typedef unsigned u32x4 __attribute__((ext_vector_type(4)));
typedef unsigned u32x2 __attribute__((ext_vector_type(2)));

constexpr int MTOK = 16384, DM = 2048, DFF = 5632, NGU = 11264, SEQ = 4096;
constexpr int PROJ_LD = 3072, VT_LD = 16384;
constexpr float EPS = 1e-6f;
constexpr float LOG2E = 1.4426950408889634f;
constexpr float QSCALE = 0.08838834764831845f * LOG2E;
constexpr int NPHASE = 12;
constexpr int LDS_BYTES = 156 * 1024;

constexpr size_t WS_WGU1 = 0;
constexpr size_t WS_WD1 = WS_WGU1 + (size_t)NGU * DM * 2;
constexpr size_t WS_WIN = WS_WD1 + (size_t)DM * DFF * 2;
constexpr size_t WS_WMKV = WS_WIN + (size_t)4608 * DM * 2;
constexpr size_t WS_WOUT = WS_WMKV + (size_t)1024 * DM * 2;
constexpr size_t WS_WGU2 = WS_WOUT + (size_t)DM * DM * 2;
constexpr size_t WS_WD2 = WS_WGU2 + (size_t)NGU * DM * 2;
constexpr size_t WS_WSB = WS_WD2 + (size_t)DM * DFF * 2;
constexpr size_t WS_MEMN = WS_WSB + (size_t)4 * 128 * 128 * 2;
constexpr size_t WS_KM = WS_MEMN + (size_t)1024 * DM * 2;
constexpr size_t WS_VMT = WS_KM + (size_t)1024 * 512 * 2;
constexpr size_t WS_XN = WS_VMT + (size_t)512 * 1024 * 2;
constexpr size_t WS_H = WS_XN + (size_t)MTOK * DM * 2;
constexpr size_t WS_PROJ = WS_H;
constexpr size_t WS_VT = WS_H + (size_t)MTOK * PROJ_LD * 2;
constexpr size_t WS_F = WS_H + (size_t)MTOK * DFF * 2;
constexpr size_t WS_END = WS_F + (size_t)MTOK * DM * 2;
static_assert(WS_VT + (size_t)1536 * VT_LD * 2 <= WS_F, "overlay");
static_assert(WS_END <= (size_t)536870912, "workspace");

__device__ __forceinline__ unsigned pk2(float lo, float hi) { unsigned r; asm("v_cvt_pk_bf16_f32 %0, %1, %2" : "=v"(r) : "v"(lo), "v"(hi)); return r; }
__device__ __forceinline__ float bflo(unsigned u) { return __uint_as_float(u << 16); }
__device__ __forceinline__ float bfhi(unsigned u) { return __uint_as_float(u & 0xffff0000u); }
__device__ __forceinline__ float bf1(bf16_t b) { return __uint_as_float(((unsigned)b) << 16); }
__device__ __forceinline__ float wave_sum(float v) {
#pragma unroll
    for (int o = 1; o < 64; o <<= 1) v += __shfl_xor(v, o);
    return v;
}
__device__ __forceinline__ float fexp2(float x) { return __builtin_amdgcn_exp2f(x); }
__device__ __forceinline__ float frcp(float x) { return __builtin_amdgcn_rcpf(x); }
__device__ __forceinline__ float gelu_tanh(float x) {
    const float t = x * (1.0f + 0.044715f * x * x);
    return x * frcp(1.0f + fexp2(t * (-2.0f * 0.7978845608028654f * LOG2E)));
}
__device__ __forceinline__ float silu_mul(float g, float u) { return g * frcp(1.0f + fexp2(g * (-LOG2E))) * u; }
__device__ __forceinline__ f32x4 mfma16(bf16x8 a, bf16x8 b, f32x4 c) { return __builtin_amdgcn_mfma_f32_16x16x32_bf16(a, b, c, 0, 0, 0); }

struct OutBf {
    bf16_t* base; int ld; int act; float sc;
    __device__ __forceinline__ f32x4 xf(f32x4 v) const {
        v = v * sc;
        if (act) { v.x = gelu_tanh(v.x); v.y = gelu_tanh(v.y); v.z = gelu_tanh(v.z); v.w = gelu_tanh(v.w); }
        return v;
    }
    __device__ __forceinline__ void st4(int row, int col, f32x4 v) const {
        v = xf(v); u32x2 w; w.x = pk2(v.x, v.y); w.y = pk2(v.z, v.w);
        *(u32x2*)(base + (size_t)row * ld + col) = w;
    }
    __device__ __forceinline__ void st8(int row, int col, f32x4 a, f32x4 b) const {
        a = xf(a); b = xf(b); u32x4 w; w.x = pk2(a.x, a.y); w.y = pk2(a.z, a.w); w.z = pk2(b.x, b.y); w.w = pk2(b.z, b.w);
        *(u32x4*)(base + (size_t)row * ld + col) = w;
    }
};
__device__ __forceinline__ OutBf p4_sel(int job, int pm, int pn, bf16_t* proj, bf16_t* vt, bf16_t* km, bf16_t* vmt) {
    OutBf o; o.act = 0; o.sc = 1.0f; o.base = proj; o.ld = PROJ_LD;
    if (job == 0) { if (pn < 4 || pn >= 10) o.sc = QSCALE; else if (pn >= 8) o.act = 1; }
    if (job == 1) { o.base = vt; o.ld = VT_LD; if (pm >= 4) o.act = 1; }
    if (job == 2) { o.base = km; o.ld = 512; }
    if (job == 3) { o.base = vmt; o.ld = 1024; }
    return o;
}

namespace pg8 {
constexpr int BM = 256, BK = 64, HALF = 128, HTB = HALF * BK * 2, STAGE_BYTES = 8 * HTB, NXCD = 8, WGM = 8;
__device__ __forceinline__ int lds_byte(int r, int c) { const int st = (r >> 4) * 2 + (c >> 5), rr = r & 15, cc = c & 31, ob = rr * 64 + cc * 2; return st * 1024 + (ob ^ (((ob >> 9) & 1) << 5)); }
__device__ __forceinline__ void stage_rc(int b, int& R, int& C) { const int st = b / 1024, sb = b % 1024, swz = sb ^ (((sb >> 9) & 1) << 5); R = (st >> 1) * 16 + swz / 64; C = (st & 1) * 32 + (swz % 64) / 2; }
__device__ __forceinline__ int perm32(int rho) { const int n = rho >> 4, i = rho & 15; return 8 * (i >> 2) + 4 * n + (i & 3); }

struct Unit { int pm, pn, job; const bf16_t* A; const bf16_t* B; };
struct GP {
    int K, G, c, mode, ld, nM0, nN0, total;
    bf16_t* out; const bf16_t *A0, *B0, *A1, *B1, *A2, *B2, *A3, *B3; bf16_t *proj, *vt, *km, *vmt;
};
__device__ __forceinline__ bool sched_next(int i, Unit& u, int G, int c, int total, int mode, int nM0, int nN0, const bf16_t* A0, const bf16_t* B0,
                                           const bf16_t* A1, const bf16_t* B1, const bf16_t* A2, const bf16_t* B2, const bf16_t* A3, const bf16_t* B3) {
    const int L = i * G + c; if (L >= total) return false;
    int job = 0, st = 0, nM = nM0, nN = nN0; const bf16_t* pa = A0; const bf16_t* pb = B0;
    if (mode == 2) {
        if (L >= 768) { job = 1; st = 768; nM = 6; nN = 64; pa = A1; pb = B1; }
        if (L >= 1152) { job = 2; st = 1152; nM = 4; nN = 2; pa = A2; pb = B2; }
        if (L >= 1160) { job = 3; st = 1160; nM = 2; nN = 4; pa = A3; pb = B3; }
    }
    int wgid = L - st; const int nwg = nM * nN;
    { const int q = nwg / NXCD, r = nwg % NXCD, xcd = wgid % NXCD, off = wgid / NXCD; wgid = (xcd < r ? xcd * (q + 1) : r * (q + 1) + (xcd - r) * q) + off; }
    const int nig = WGM * nN, gid = wgid / nig, fm = gid * WGM, gsz = (nM - fm) < WGM ? (nM - fm) : WGM;
    u.pm = fm + ((wgid % nig) % gsz); u.pn = (wgid % nig) / gsz; u.job = job; u.A = pa; u.B = pb; return true;
}
__device__ __forceinline__ void epilogue(const f32x4 (&acc)[2][2][4][2], const Unit& u, int wr, int wc, int fr, int fq, int mode, bf16_t* out, int ld, bf16_t* proj, bf16_t* vt, bf16_t* km, bf16_t* vmt) {
    const int row0 = u.pm * BM + wr * 64 + fr, cb = wc * 32 + 8 * fq;
    if (mode == 0) {
#pragma unroll
        for (int ai = 0; ai < 2; ++ai)
#pragma unroll
            for (int m = 0; m < 4; ++m) {
                const f32x4 g0 = acc[ai][0][m][0], g1 = acc[ai][0][m][1], u0 = acc[ai][1][m][0], u1 = acc[ai][1][m][1];
                u32x4 w;
                w.x = pk2(silu_mul(g0.x, u0.x), silu_mul(g0.y, u0.y)); w.y = pk2(silu_mul(g0.z, u0.z), silu_mul(g0.w, u0.w));
                w.z = pk2(silu_mul(g1.x, u1.x), silu_mul(g1.y, u1.y)); w.w = pk2(silu_mul(g1.z, u1.z), silu_mul(g1.w, u1.w));
                *(u32x4*)(out + (size_t)(row0 + ai * HALF + m * 16) * DFF + u.pn * 128 + cb) = w;
            }
    } else {
        OutBf o; o.base = out; o.ld = ld; o.act = 0; o.sc = 1.0f;
        if (mode == 2) o = p4_sel(u.job, u.pm, u.pn, proj, vt, km, vmt);
#pragma unroll
        for (int ai = 0; ai < 2; ++ai)
#pragma unroll
            for (int m = 0; m < 4; ++m)
#pragma unroll
                for (int bj = 0; bj < 2; ++bj)
                    o.st8(row0 + ai * HALF + m * 16, u.pn * BM + bj * HALF + cb, acc[ai][bj][m][0], acc[ai][bj][m][1]);
    }
}

__device__ __forceinline__ void gemm_phase(LAS unsigned char* lds, const GP p, const int tid) {
    const int K = p.K; const size_t tstep = (size_t)256 * K * 2;
#define SNEXT(i, u) sched_next(i, u, p.G, p.c, p.total, p.mode, p.nM0, p.nN0, p.A0, p.B0, p.A1, p.B1, p.A2, p.B2, p.A3, p.B3)
#define APTR(u) ((const char*)(u).A + (size_t)(u).pm * tstep)
#define BPTR(u) ((const char*)(u).B + (size_t)(u).pn * tstep)
    const int wid = __builtin_amdgcn_readfirstlane(tid >> 6), lane = tid & 63, wr = wid >> 2, wc = wid & 3, fr = lane & 15, fq = lane >> 4;
    const int nt = K / BK;
    unsigned voffA[2], voffB[2];
#pragma unroll
    for (int i = 0; i < 2; ++i) { int R, C; stage_rc(tid * 16 + i * 8192, R, C); const int Rb = (R & ~31) + perm32(R & 31);
        voffA[i] = (unsigned)(R * K + C) * 2u; voffB[i] = (unsigned)(Rb * K + C) * 2u; }
    const size_t kstep = (size_t)(BK * 2);
    const size_t hstep = (size_t)HALF * K * 2;
    const unsigned ldsw = (unsigned)wid * 1024u;
    const int aoff = lds_byte(wr * 64 + fr, fq * 8), boff = lds_byte(wc * 32 + fr, fq * 8);
#define PG8_SA(b, h) (((b) * 2 + (h)) * HTB)
#define PG8_SB(b, h) ((4 + (b) * 2 + (h)) * HTB)
#define PG8_STAGE(bufoff, gbase, voff) do { _Pragma("unroll") for (int _i = 0; _i < 2; ++_i) \
        __builtin_amdgcn_global_load_lds((const unsigned*)((const char*)(gbase) + (voff)[_i]), (LAS unsigned*)(lds + (bufoff) + ldsw + _i * 8192), 16, 0, 0); } while (0)
#define PG8_LDA(dst, b, h) do { _Pragma("unroll") for (int m = 0; m < 4; ++m) _Pragma("unroll") for (int k = 0; k < 2; ++k) dst[m][k] = *(const LAS bf16x8*)(lds + PG8_SA(b, h) + aoff + m * 2048 + k * 1024); } while (0)
#define PG8_LDB(dst, b, h) do { _Pragma("unroll") for (int n = 0; n < 2; ++n) _Pragma("unroll") for (int k = 0; k < 2; ++k) dst[n][k] = *(const LAS bf16x8*)(lds + PG8_SB(b, h) + boff + n * 2048 + k * 1024); } while (0)
#define PG8_MMA(ai, bj, At, Bt) do { __builtin_amdgcn_s_setprio(1); _Pragma("unroll") for (int m = 0; m < 4; ++m) _Pragma("unroll") for (int n = 0; n < 2; ++n) _Pragma("unroll") for (int k = 0; k < 2; ++k) \
        acc[ai][bj][m][n] = __builtin_amdgcn_mfma_f32_16x16x32_bf16(Bt[n][k], At[m][k], acc[ai][bj][m][n], 0, 0, 0); __builtin_amdgcn_s_setprio(0); } while (0)
#define PG8_WAIT_V(n) asm volatile("s_waitcnt vmcnt(" #n ")" ::: "memory")
#define PG8_WAIT_L(n) asm volatile("s_waitcnt lgkmcnt(" #n ")" ::: "memory")
#define PG8_BAR __builtin_amdgcn_s_barrier()
#define PG8_SCHED __builtin_amdgcn_sched_barrier(0)
    Unit cur, nxt; int ui = 0;
    if (!SNEXT(0, cur)) return;
    f32x4 acc[2][2][4][2];
#pragma unroll
    for (int a = 0; a < 2; ++a)
#pragma unroll
        for (int b = 0; b < 2; ++b)
#pragma unroll
            for (int m = 0; m < 4; ++m)
#pragma unroll
                for (int n = 0; n < 2; ++n) acc[a][b][m][n] = (f32x4){0.f, 0.f, 0.f, 0.f};
    bf16x8 At[4][2], B0[2][2], B1[2][2];
    const char* cA = APTR(cur); const char* cB = BPTR(cur);
    PG8_STAGE(PG8_SB(0, 0), cB, voffB); PG8_STAGE(PG8_SB(0, 1), cB + hstep, voffB); PG8_STAGE(PG8_SA(0, 0), cA, voffA); PG8_STAGE(PG8_SA(0, 1), cA + hstep, voffA);
    if (wr == 1) PG8_BAR;
    PG8_WAIT_V(2); PG8_BAR;
    PG8_STAGE(PG8_SB(1, 0), cB + kstep, voffB); PG8_STAGE(PG8_SA(1, 0), cA + kstep, voffA); PG8_STAGE(PG8_SB(1, 1), cB + hstep + kstep, voffB);
    PG8_WAIT_V(6); PG8_BAR;
    for (;;) {
        const bool has_next = SNEXT(ui + 1, nxt);
        const char* nA = has_next ? APTR(nxt) : cA; const char* nB = has_next ? BPTR(nxt) : cB;
        for (int t = 0; t < nt; t += 2) {
            const bool last = (t == nt - 2);
            const char* a1 = cA + (size_t)(t + 1) * kstep;
            const char* a2 = last ? nA : cA + (size_t)(t + 2) * kstep; const char* b2 = last ? nB : cB + (size_t)(t + 2) * kstep;
            const char* a3 = a2 + kstep; const char* b3 = b2 + kstep;
            PG8_LDB(B0, 0, 0); PG8_LDB(B1, 0, 1); PG8_SCHED; PG8_LDA(At, 0, 0); PG8_STAGE(PG8_SA(1, 1), a1 + hstep, voffA);
            PG8_WAIT_V(8); PG8_WAIT_L(0); PG8_BAR; PG8_MMA(0, 0, At, B0); PG8_MMA(0, 1, At, B1); PG8_BAR; PG8_SCHED;
            PG8_LDA(At, 0, 1); PG8_STAGE(PG8_SB(0, 0), b2, voffB); PG8_STAGE(PG8_SB(0, 1), b2 + hstep, voffB); PG8_STAGE(PG8_SA(0, 0), a2, voffA);
            PG8_WAIT_V(8); PG8_WAIT_L(0); PG8_BAR; PG8_MMA(1, 0, At, B0); PG8_MMA(1, 1, At, B1); PG8_BAR; PG8_SCHED;
            PG8_LDB(B0, 1, 0); PG8_LDB(B1, 1, 1); PG8_SCHED; PG8_LDA(At, 1, 0); PG8_STAGE(PG8_SA(0, 1), a2 + hstep, voffA);
            PG8_WAIT_V(8); PG8_WAIT_L(0); PG8_BAR; PG8_MMA(0, 0, At, B0); PG8_MMA(0, 1, At, B1); PG8_BAR; PG8_SCHED;
            PG8_LDA(At, 1, 1); PG8_STAGE(PG8_SB(1, 0), b3, voffB); PG8_STAGE(PG8_SB(1, 1), b3 + hstep, voffB); PG8_STAGE(PG8_SA(1, 0), a3, voffA);
            PG8_WAIT_V(8); PG8_WAIT_L(0); PG8_BAR; PG8_MMA(1, 0, At, B0); PG8_MMA(1, 1, At, B1); PG8_BAR; PG8_SCHED;
        }
        if (wr == 0) PG8_BAR;
        epilogue(acc, cur, wr, wc, fr, fq, p.mode, p.out, p.ld, p.proj, p.vt, p.km, p.vmt);
        if (!has_next) break;
#pragma unroll
        for (int a = 0; a < 2; ++a)
#pragma unroll
            for (int b = 0; b < 2; ++b)
#pragma unroll
                for (int m = 0; m < 4; ++m)
#pragma unroll
                    for (int n = 0; n < 2; ++n) acc[a][b][m][n] = (f32x4){0.f, 0.f, 0.f, 0.f};
        cur = nxt; cA = nA; cB = nB; ++ui;
        if (wr == 1) PG8_BAR;
    }
    PG8_WAIT_V(0);
    PG8_BAR;
#undef SNEXT
#undef APTR
#undef BPTR
#undef PG8_SA
#undef PG8_SB
#undef PG8_STAGE
#undef PG8_LDA
#undef PG8_LDB
#undef PG8_MMA
#undef PG8_WAIT_V
#undef PG8_WAIT_L
#undef PG8_BAR
#undef PG8_SCHED
}
}

__device__ __forceinline__ void simple_gemm_job(const bf16_t* A, const bf16_t* Bt, int Mr, int Nc, int K, int job, bf16_t* proj, bf16_t* vt, bf16_t* km, bf16_t* vmt, int mode, bf16_t* out, int ld, int gw, int ngw, int lane) {
    const int fr = lane & 15, fq = lane >> 4, tn = Nc / 64, tiles = (Mr / 64) * tn;
    for (int t = gw; t < tiles; t += ngw) {
        const int row0 = (t / tn) * 64, col0 = (t % tn) * 64;
        f32x4 acc[4][4];
#pragma unroll
        for (int i = 0; i < 4; ++i)
#pragma unroll
            for (int j = 0; j < 4; ++j) acc[i][j] = (f32x4){0.f, 0.f, 0.f, 0.f};
        const bf16_t* ap = A + (size_t)(row0 + fr) * K + fq * 8; const bf16_t* bp = Bt + (size_t)(col0 + fr) * K + fq * 8;
        for (int k = 0; k < K; k += 32) {
            bf16x8 a[4], b[4];
#pragma unroll
            for (int i = 0; i < 4; ++i) { a[i] = *(const bf16x8*)(ap + (size_t)i * 16 * K + k); b[i] = *(const bf16x8*)(bp + (size_t)i * 16 * K + k); }
#pragma unroll
            for (int i = 0; i < 4; ++i)
#pragma unroll
                for (int j = 0; j < 4; ++j) acc[i][j] = mfma16(b[j], a[i], acc[i][j]);
        }
        OutBf o; o.base = out; o.ld = ld; o.act = 0; o.sc = 1.0f; if (mode == 2) o = p4_sel(job, row0 / 256, col0 / 256, proj, vt, km, vmt);
#pragma unroll
        for (int i = 0; i < 4; ++i)
#pragma unroll
            for (int j = 0; j < 4; ++j) o.st4(row0 + i * 16 + fr, col0 + j * 16 + fq * 4, acc[i][j]);
    }
}
__device__ __forceinline__ void simple_gemm_swiglu(const bf16_t* A, const bf16_t* Wt, bf16_t* H, int gw, int ngw, int lane) {
    const int fr = lane & 15, fq = lane >> 4, K = DM, tn = DFF / 32, tiles = (MTOK / 64) * tn;
    for (int t = gw; t < tiles; t += ngw) {
        const int row0 = (t / tn) * 64, h0 = (t % tn) * 32, wrow = 256 * (h0 >> 7) + (h0 & 127);
        f32x4 g[4][2], u[4][2];
#pragma unroll
        for (int i = 0; i < 4; ++i)
#pragma unroll
            for (int j = 0; j < 2; ++j) { g[i][j] = (f32x4){0.f, 0.f, 0.f, 0.f}; u[i][j] = (f32x4){0.f, 0.f, 0.f, 0.f}; }
        const bf16_t* ap = A + (size_t)(row0 + fr) * K + fq * 8; const bf16_t* bp = Wt + (size_t)(wrow + fr) * K + fq * 8;
        for (int k = 0; k < K; k += 32) {
            bf16x8 a[4], bg[2], bu[2];
#pragma unroll
            for (int i = 0; i < 4; ++i) a[i] = *(const bf16x8*)(ap + (size_t)i * 16 * K + k);
#pragma unroll
            for (int j = 0; j < 2; ++j) { bg[j] = *(const bf16x8*)(bp + (size_t)j * 16 * K + k); bu[j] = *(const bf16x8*)(bp + (size_t)(128 + j * 16) * K + k); }
#pragma unroll
            for (int i = 0; i < 4; ++i)
#pragma unroll
                for (int j = 0; j < 2; ++j) { g[i][j] = mfma16(bg[j], a[i], g[i][j]); u[i][j] = mfma16(bu[j], a[i], u[i][j]); }
        }
#pragma unroll
        for (int i = 0; i < 4; ++i)
#pragma unroll
            for (int j = 0; j < 2; ++j) {
                u32x2 w; w.x = pk2(silu_mul(g[i][j].x, u[i][j].x), silu_mul(g[i][j].y, u[i][j].y)); w.y = pk2(silu_mul(g[i][j].z, u[i][j].z), silu_mul(g[i][j].w, u[i][j].w));
                *(u32x2*)(H + (size_t)(row0 + i * 16 + fr) * DFF + h0 + j * 16 + fq * 4) = w;
            }
    }
}

__device__ __forceinline__ void transpose_item(const float* W, int K, int N, bf16_t* WT, int kb, int nbd, int src0, LAS float* scr, int lane) {
    const int k0 = kb * 64;
#pragma unroll 4
    for (int i = 0; i < 16; ++i) {
        const int kk = 4 * i + (lane >> 4);
        const f32x4 v = *(const f32x4*)(W + (size_t)(k0 + kk) * N + src0 + (lane & 15) * 4);
        LAS float* s = scr + kk * 65 + (lane & 15) * 4; s[0] = v.x; s[1] = v.y; s[2] = v.z; s[3] = v.w;
    }
    const int c = lane & 7;
#pragma unroll
    for (int jj = 0; jj < 8; ++jj) {
        const int n = (lane >> 3) + 8 * jj; const LAS float* s = scr + (8 * c) * 65 + n;
        u32x4 o; o.x = pk2(s[0], s[65]); o.y = pk2(s[2 * 65], s[3 * 65]); o.z = pk2(s[4 * 65], s[5 * 65]); o.w = pk2(s[6 * 65], s[7 * 65]);
        *(u32x4*)(WT + (size_t)(nbd * 64 + n) * K + k0 + 8 * c) = o;
    }
}
__device__ __forceinline__ int map_gu(int nb) { const int j = nb >> 2, part = nb & 3; return part < 2 ? 128 * j + 64 * part : DFF + 128 * j + 64 * (part - 2); }
__device__ __forceinline__ int map_win(int nb) { const int n = nb * 64; return n < 2048 ? n : n < 2560 ? n + 1024 : n < 3072 ? n + 1536 : n < 4096 ? n - 1024 : n - 512; }

__device__ __forceinline__ void norm_row_bf16(const float* xr, const float* g, bf16_t* o, int lane) {
    f32x4 v[8]; float s = 0.f;
#pragma unroll
    for (int j = 0; j < 8; ++j) { v[j] = *(const f32x4*)(xr + 256 * j + 4 * lane); s += (v[j].x * v[j].x + v[j].y * v[j].y) + (v[j].z * v[j].z + v[j].w * v[j].w); }
    const float rs = rsqrtf(wave_sum(s) * (1.0f / DM) + EPS);
#pragma unroll
    for (int j = 0; j < 8; ++j) { const f32x4 gv = *(const f32x4*)(g + 256 * j + 4 * lane);
        u32x2 w; w.x = pk2(v[j].x * rs * gv.x, v[j].y * rs * gv.y); w.y = pk2(v[j].z * rs * gv.z, v[j].w * rs * gv.w);
        *(u32x2*)(o + 256 * j + 4 * lane) = w; }
}
template <bool FINAL>
__device__ __forceinline__ void resid_row(const bf16_t* f, const float* hin, float* hout, const float* gpost, float alpha, const float* gnext, bf16_t* xn, float* fin, int lane) {
    f32x4 v[8]; float s = 0.f;
#pragma unroll
    for (int j = 0; j < 8; ++j) { const u32x2 w = *(const u32x2*)(f + 256 * j + 4 * lane); v[j] = (f32x4){bflo(w.x), bfhi(w.x), bflo(w.y), bfhi(w.y)};
        s += (v[j].x * v[j].x + v[j].y * v[j].y) + (v[j].z * v[j].z + v[j].w * v[j].w); }
    const float rs = rsqrtf(wave_sum(s) * (1.0f / DM) + EPS) * alpha;
    float s2 = 0.f;
#pragma unroll
    for (int j = 0; j < 8; ++j) { const f32x4 gv = *(const f32x4*)(gpost + 256 * j + 4 * lane); const f32x4 hv = *(const f32x4*)(hin + 256 * j + 4 * lane);
        v[j] = hv + v[j] * rs * gv; s2 += (v[j].x * v[j].x + v[j].y * v[j].y) + (v[j].z * v[j].z + v[j].w * v[j].w);
        if (!FINAL) *(f32x4*)(hout + 256 * j + 4 * lane) = v[j]; }
    const float rs2 = rsqrtf(wave_sum(s2) * (1.0f / DM) + EPS);
#pragma unroll
    for (int j = 0; j < 8; ++j) { const f32x4 gv = *(const f32x4*)(gnext + 256 * j + 4 * lane); const f32x4 o = v[j] * rs2 * gv;
        if (FINAL) *(f32x4*)(fin + 256 * j + 4 * lane) = o;
        else { u32x2 w; w.x = pk2(o.x, o.y); w.y = pk2(o.z, o.w); *(u32x2*)(xn + 256 * j + 4 * lane) = w; } }
}
__device__ __forceinline__ void rescale_row(bf16_t* y, const float* gna, const float* gsg, const float* gmem, int lane) {
    u32x4 w[4]; float ss[4];
#pragma unroll
    for (int j = 0; j < 4; ++j) { w[j] = *(const u32x4*)(y + 512 * j + 8 * lane);
        const float a0 = bflo(w[j].x), a1 = bfhi(w[j].x), a2 = bflo(w[j].y), a3 = bfhi(w[j].y), a4 = bflo(w[j].z), a5 = bfhi(w[j].z), a6 = bflo(w[j].w), a7 = bfhi(w[j].w);
        ss[j] = (a0 * a0 + a1 * a1) + (a2 * a2 + a3 * a3) + (a4 * a4 + a5 * a5) + (a6 * a6 + a7 * a7); }
    const float rna = rsqrtf(wave_sum(ss[0] + ss[1]) * (1.0f / 1024) + EPS), rsg = rsqrtf(wave_sum(ss[2]) * (1.0f / 512) + EPS), rme = rsqrtf(wave_sum(ss[3]) * (1.0f / 512) + EPS);
#pragma unroll
    for (int j = 0; j < 4; ++j) {
        const float* g = (j < 2 ? gna + 512 * j : j == 2 ? gsg : gmem) + 8 * lane; const float r = j < 2 ? rna : j == 2 ? rsg : rme;
        const f32x4 g0 = *(const f32x4*)g, g1 = *(const f32x4*)(g + 4);
        u32x4 o; o.x = pk2(bflo(w[j].x) * r * g0.x, bfhi(w[j].x) * r * g0.y); o.y = pk2(bflo(w[j].y) * r * g0.z, bfhi(w[j].y) * r * g0.w);
        o.z = pk2(bflo(w[j].z) * r * g1.x, bfhi(w[j].z) * r * g1.y); o.w = pk2(bflo(w[j].w) * r * g1.z, bfhi(w[j].w) * r * g1.w);
        *(u32x4*)(y + 512 * j + 8 * lane) = o; }
}

template <bool NA>
__device__ __forceinline__ void attn_qb(const bf16_t* qp, const bf16_t* kp0, int kld, size_t kis, const bf16_t* vp0, int vld, int vis,
                                        const LAS float* bias_h, int dr0, int qc, int w0, bf16_t* yp, int fq) {
    bf16x8 qf[4];
#pragma unroll
    for (int dc = 0; dc < 4; ++dc) qf[dc] = *(const bf16x8*)(qp + dc * 32);
    int bidx[8]; bool bval[8];
    if (NA) {
        const int cs = min(max(qc - 8, 0), 48);
#pragma unroll
        for (int e = 0; e < 8; ++e) { const int kc = w0 + (e >> 2) * 16 + fq * 4 + (e & 3); bval[e] = (kc >= cs) && (kc < cs + 16); bidx[e] = min(max(kc - qc, -15), 15) + 15; }
    }
    f32x4 o[8];
#pragma unroll
    for (int d = 0; d < 8; ++d) o[d] = (f32x4){0.f, 0.f, 0.f, 0.f};
    float m = -3.0e38f, l = 0.f;
#pragma unroll 1
    for (int i = 0; i < 8; ++i) {
        const bf16_t* kp = kp0 + (size_t)i * kis;
        bf16x8 kf[2][4];
#pragma unroll
        for (int a = 0; a < 2; ++a)
#pragma unroll
            for (int dc = 0; dc < 4; ++dc) kf[a][dc] = *(const bf16x8*)(kp + (size_t)a * 16 * kld + dc * 32);
        const bf16_t* vp = vp0 + (size_t)i * vis;
        u32x2 vlo[8], vhi[8];
#pragma unroll
        for (int d = 0; d < 8; ++d) { vlo[d] = *(const u32x2*)(vp + (size_t)d * 16 * vld); vhi[d] = *(const u32x2*)(vp + (size_t)d * 16 * vld + 16); }
        f32x4 s0 = (f32x4){0.f, 0.f, 0.f, 0.f}, s1 = (f32x4){0.f, 0.f, 0.f, 0.f};
#pragma unroll
        for (int dc = 0; dc < 4; ++dc) { s0 = mfma16(kf[0][dc], qf[dc], s0); s1 = mfma16(kf[1][dc], qf[dc], s1); }
        if (NA) {
            const LAS float* br = bias_h + (dr0 + i) * 31;
#pragma unroll
            for (int e = 0; e < 4; ++e) { s0[e] = bval[e] ? s0[e] + br[bidx[e]] : -1.0e30f; s1[e] = bval[4 + e] ? s1[e] + br[bidx[4 + e]] : -1.0e30f; }
        }
        float mx = fmaxf(fmaxf(fmaxf(s0.x, s0.y), fmaxf(s0.z, s0.w)), fmaxf(fmaxf(s1.x, s1.y), fmaxf(s1.z, s1.w)));
        mx = fmaxf(mx, __shfl_xor(mx, 16)); mx = fmaxf(mx, __shfl_xor(mx, 32));
        const float mn = fmaxf(m, mx), alpha = fexp2(m - mn); m = mn;
#pragma unroll
        for (int e = 0; e < 4; ++e) { s0[e] = fexp2(s0[e] - mn); s1[e] = fexp2(s1[e] - mn); }
        l = l * alpha + ((s0.x + s0.y) + (s0.z + s0.w)) + ((s1.x + s1.y) + (s1.z + s1.w));
        u32x4 pw; pw.x = pk2(s0.x, s0.y); pw.y = pk2(s0.z, s0.w); pw.z = pk2(s1.x, s1.y); pw.w = pk2(s1.z, s1.w);
        const bf16x8 pb = __builtin_bit_cast(bf16x8, pw);
#pragma unroll
        for (int d = 0; d < 8; ++d) {
            u32x4 vw; vw.x = vlo[d].x; vw.y = vlo[d].y; vw.z = vhi[d].x; vw.w = vhi[d].y;
            o[d] = mfma16(__builtin_bit_cast(bf16x8, vw), pb, o[d] * alpha);
        }
    }
    l += __shfl_xor(l, 16); l += __shfl_xor(l, 32);
    const float inv = frcp(l);
#pragma unroll
    for (int d = 0; d < 8; ++d) { u32x2 w; w.x = pk2(o[d].x * inv, o[d].y * inv); w.y = pk2(o[d].z * inv, o[d].w * inv); *(u32x2*)(yp + d * 16) = w; }
}

struct Ptrs {
    const float* in[25]; float* out; unsigned char* ws;
};

constexpr int RPB_OFF = 0, VVT_OFF = 15360, VVT_LD = 136;

__device__ __forceinline__ void p5_unit(const Ptrs& P, LAS unsigned char* lds, int unit, int tid, int lane, int wave) {
    const bf16_t* proj = (const bf16_t*)(P.ws + WS_PROJ); const bf16_t* vt = (const bf16_t*)(P.ws + WS_VT);
    const bf16_t* km = (const bf16_t*)(P.ws + WS_KM); const bf16_t* vmt = (const bf16_t*)(P.ws + WS_VMT);
    const bf16_t* wsb = (const bf16_t*)(P.ws + WS_WSB);
    bf16_t* Y = (bf16_t*)(P.ws + WS_XN);
    const int b = unit >> 6, r = unit & 63, tok0 = b * SEQ + r * 64, fr = lane & 15, fq = lane >> 4;
    const int rs = min(max(r - 4, 0), 56);
    LAS float* rpb = (LAS float*)(lds + RPB_OFF);
    LAS bf16_t* vvt = (LAS bf16_t*)(lds + VVT_OFF);
    __syncthreads();
    for (int i = tid; i < 8 * 15 * 31; i += 512) rpb[i] = P.in[10][i] * LOG2E;
    {
        const int g = wave & 3, q = (wave >> 2) * 64 + lane, ctok = b * SEQ + (r >> 1) * 128;
        const bf16_t* vs = vt + (size_t)(1024 + g * 128) * VT_LD + ctok + q;
        float s = 0.f, ss = 0.f;
#pragma unroll 16
        for (int c = 0; c < 128; ++c) { const float x = bf1(vs[(size_t)c * VT_LD]); s += x; ss += x * x; }
        const float mu = s * (1.0f / 128), var = fmaxf(ss * (1.0f / 128) - mu * mu, 0.f), rstd = rsqrtf(var + EPS);
        const float* lg = P.in[11] + g * 128; const float* lb = P.in[12] + g * 128;
#pragma unroll 16
        for (int c = 0; c < 128; ++c) { const float x = bf1(vs[(size_t)c * VT_LD]); const float yv = (x - mu) * rstd * lg[c] + lb[c];
            vvt[(g * 128 + c) * VVT_LD + q] = (bf16_t)(pk2(yv, 0.f) & 0xffffu); }
    }
    __syncthreads();
    {
        const int h = wave;
#pragma unroll 1
        for (int qb = 0; qb < 4; ++qb) {
            const int w0 = qb == 0 ? 0 : qb == 1 ? 8 : qb == 2 ? 24 : 32;
            const size_t qtok = (size_t)tok0 + qb * 16 + fr, ktok = (size_t)b * SEQ + rs * 64 + w0;
            attn_qb<true>(proj + qtok * PROJ_LD + h * 128 + fq * 8,
                          proj + (ktok + fr) * PROJ_LD + 1024 + h * 128 + fq * 8, PROJ_LD, (size_t)64 * PROJ_LD,
                          vt + (size_t)(h * 128 + fr) * VT_LD + ktok + fq * 4, VT_LD, 64,
                          rpb + h * 465, rs - r + 7, qb * 16 + fr, w0, Y + qtok * DM + h * 128 + fq * 4, fq);
        }
    }
    {
        const int hm = wave & 3, half = wave >> 2;
#pragma unroll 1
        for (int qq = 0; qq < 2; ++qq) {
            const int qb = half * 2 + qq; const size_t qtok = (size_t)tok0 + qb * 16 + fr;
            attn_qb<false>(proj + qtok * PROJ_LD + 2560 + hm * 128 + fq * 8,
                           km + (size_t)(b * 256 + fr) * 512 + hm * 128 + fq * 8, 512, (size_t)32 * 512,
                           vmt + (size_t)(hm * 128 + fr) * 1024 + b * 256 + fq * 4, 1024, 32,
                           rpb, 0, 0, 0, Y + qtok * DM + 1536 + hm * 128 + fq * 4, fq);
        }
    }
    {
        const int g = wave & 3, half = wave >> 2;
#pragma unroll 1
        for (int pb = 0; pb < 2; ++pb) {
            const int pl = half * 32 + pb * 16 + fr, pp = (r & 1) * 64 + pl;
            f32x4 acc[8];
#pragma unroll
            for (int c = 0; c < 8; ++c) acc[c] = (f32x4){0.f, 0.f, 0.f, 0.f};
#pragma unroll
            for (int qc = 0; qc < 4; ++qc) {
                const bf16x8 wf = *(const bf16x8*)(wsb + (size_t)(g * 128 + pp) * 128 + qc * 32 + fq * 8);
#pragma unroll
                for (int c = 0; c < 8; ++c) {
                    const bf16x8 af = *(const LAS bf16x8*)(vvt + (g * 128 + c * 16 + fr) * VVT_LD + qc * 32 + fq * 8);
                    acc[c] = mfma16(af, wf, acc[c]);
                }
            }
            const float bs = P.in[14][g * 128 + pp];
            const bf16_t* up = proj + ((size_t)tok0 + pl) * PROJ_LD + 2048 + g * 128 + fq * 4;
            bf16_t* yp = Y + ((size_t)tok0 + pl) * DM + 1024 + g * 128 + fq * 4;
#pragma unroll
            for (int c = 0; c < 8; ++c) { const u32x2 uw = *(const u32x2*)(up + c * 16);
                u32x2 w; w.x = pk2(bflo(uw.x) * (acc[c].x + bs), bfhi(uw.x) * (acc[c].y + bs)); w.y = pk2(bflo(uw.y) * (acc[c].z + bs), bfhi(uw.y) * (acc[c].w + bs));
                *(u32x2*)(yp + c * 16) = w; }
        }
    }
    __threadfence(); __syncthreads(); __threadfence();
    for (int t = wave; t < 64; t += 8) rescale_row(Y + ((size_t)tok0 + t) * DM, P.in[15], P.in[16], P.in[17], lane);
}

__device__ __forceinline__ void naive_p5(const Ptrs& P, int gw, int ngw, int lane) {
    const bf16_t* proj = (const bf16_t*)(P.ws + WS_PROJ); const bf16_t* vt = (const bf16_t*)(P.ws + WS_VT);
    const bf16_t* km = (const bf16_t*)(P.ws + WS_KM); const bf16_t* vmt = (const bf16_t*)(P.ws + WS_VMT);
    bf16_t* Y = (bf16_t*)(P.ws + WS_XN);
    for (int task = gw; task < MTOK * 16; task += ngw) {
        const int t = task >> 4, sub = task & 15, b = t / SEQ, pos = t % SEQ;
        if (sub < 12) {
            const bool na = sub < 8; const int h = na ? sub : sub - 8;
            const unsigned qw = *(const unsigned*)(proj + (size_t)t * PROJ_LD + (na ? 0 : 2560) + h * 128 + 2 * lane);
            const float q0 = bflo(qw), q1 = bfhi(qw);
            const int r = pos >> 6, c = pos & 63, rs = min(max(r - 4, 0), 56), cs = min(max(c - 8, 0), 48);
            float m = -3.0e38f, l = 0.f, o0 = 0.f, o1 = 0.f;
            const int nk = na ? 128 : 256;
            for (int kk = 0; kk < nk; ++kk) {
                float bias = 0.f; size_t koff, voff;
                if (na) { const int kr = rs + (kk >> 4), kc = cs + (kk & 15), kt = b * SEQ + kr * 64 + kc;
                    koff = (size_t)kt * PROJ_LD + 1024 + h * 128 + 2 * lane; voff = (size_t)(h * 128 + 2 * lane) * VT_LD + kt;
                    bias = P.in[10][(h * 15 + (kr - r + 7)) * 31 + min(max(kc - c, -15), 15) + 15] * LOG2E;
                } else { koff = (size_t)(b * 256 + kk) * 512 + h * 128 + 2 * lane; voff = (size_t)(h * 128 + 2 * lane) * 1024 + b * 256 + kk; }
                const unsigned kw = *(const unsigned*)((na ? proj : km) + koff);
                const float s = wave_sum(q0 * bflo(kw) + q1 * bfhi(kw)) + bias;
                const bf16_t* vb = na ? vt : vmt; const int vl = na ? VT_LD : 1024;
                const float v0 = bf1(vb[voff]), v1 = bf1(vb[voff + vl]);
                const float mn = fmaxf(m, s), al = fexp2(m - mn), p = fexp2(s - mn); m = mn;
                l = l * al + p; o0 = o0 * al + p * v0; o1 = o1 * al + p * v1;
            }
            const float inv = 1.0f / l;
            *(unsigned*)(Y + (size_t)t * DM + (na ? 0 : 1536) + h * 128 + 2 * lane) = pk2(o0 * inv, o1 * inv);
        } else {
            const int g = sub - 12, p = pos & 127, ctok = t - p;
            float a0 = 0.f, a1 = 0.f;
            const float lg0 = P.in[11][g * 128 + 2 * lane], lg1 = P.in[11][g * 128 + 2 * lane + 1], lb0 = P.in[12][g * 128 + 2 * lane], lb1 = P.in[12][g * 128 + 2 * lane + 1];
            for (int q = 0; q < 128; ++q) {
                const float x0 = bf1(vt[(size_t)(1024 + g * 128 + 2 * lane) * VT_LD + ctok + q]), x1 = bf1(vt[(size_t)(1024 + g * 128 + 2 * lane + 1) * VT_LD + ctok + q]);
                const float mu = wave_sum(x0 + x1) * (1.0f / 128), d0 = x0 - mu, d1 = x1 - mu;
                const float rstd = rsqrtf(wave_sum(d0 * d0 + d1 * d1) * (1.0f / 128) + EPS);
                const float w = P.in[13][(size_t)(g * 128 + p) * 128 + q];
                a0 += w * (d0 * rstd * lg0 + lb0); a1 += w * (d1 * rstd * lg1 + lb1);
            }
            const float bs = P.in[14][g * 128 + p];
            const unsigned uw = *(const unsigned*)(proj + (size_t)t * PROJ_LD + 2048 + g * 128 + 2 * lane);
            *(unsigned*)(Y + (size_t)t * DM + 1024 + g * 128 + 2 * lane) = pk2(bflo(uw) * (a0 + bs), bfhi(uw) * (a1 + bs));
        }
    }
}

struct Args { const float* in[25]; float* out; unsigned char* ws; int ph_lo, ph_hi; };

__global__ void __launch_bounds__(512, 2) fwd_kernel(Args a) {
    extern __shared__ __attribute__((aligned(16))) unsigned char smem[];
    LAS unsigned char* lds = (LAS unsigned char*)smem;
    cg::grid_group grid = cg::this_grid();
    const int tid0 = threadIdx.x;
    const int G = gridDim.x, bid = blockIdx.x, ngw = G * 8;
    Ptrs P;
#pragma unroll
    for (int i = 0; i < 25; ++i) P.in[i] = a.in[i];
    P.out = a.out; P.ws = a.ws;
    unsigned char* ws = a.ws;
    bf16_t* XN = (bf16_t*)(ws + WS_XN); bf16_t* H = (bf16_t*)(ws + WS_H); bf16_t* F = (bf16_t*)(ws + WS_F);

    for (int ph = a.ph_lo; ph < a.ph_hi; ++ph) {
        if (ph == 6 && !NAIVE_P5) continue;
        int tid = tid0; asm volatile("" : "+v"(tid));
        const int lane = tid & 63, wave = __builtin_amdgcn_readfirstlane(tid >> 6), gw = bid * 8 + wave;
        const bool is_gemm = (ph == 1 || ph == 2 || ph == 4 || ph == 7 || ph == 9 || ph == 10);
        if (is_gemm) {
            pg8::GP p; p.K = DM; p.G = G; p.c = bid; p.mode = 1; p.ld = DM; p.out = F; p.nM0 = 64; p.nN0 = 8; p.total = 512;
            p.proj = (bf16_t*)(ws + WS_PROJ); p.vt = (bf16_t*)(ws + WS_VT); p.km = (bf16_t*)(ws + WS_KM); p.vmt = (bf16_t*)(ws + WS_VMT);
            const bf16_t* win = (const bf16_t*)(ws + WS_WIN); const bf16_t* wmkv = (const bf16_t*)(ws + WS_WMKV); const bf16_t* memn = (const bf16_t*)(ws + WS_MEMN);
            p.A0 = XN; p.B0 = (const bf16_t*)(ws + WS_WOUT);
            p.A1 = win + (size_t)3072 * DM; p.B1 = XN; p.A2 = memn; p.B2 = wmkv; p.A3 = wmkv + (size_t)512 * DM; p.B3 = memn;
            if (ph == 1 || ph == 9) { p.B0 = (const bf16_t*)(ws + (ph == 1 ? WS_WGU1 : WS_WGU2)); p.nN0 = 44; p.total = 64 * 44; p.mode = 0; p.out = H; }
            else if (ph == 2 || ph == 10) { p.A0 = H; p.B0 = (const bf16_t*)(ws + (ph == 2 ? WS_WD1 : WS_WD2)); p.K = DFF; }
            else if (ph == 4) { p.B0 = win; p.nN0 = 12; p.total = 1168; p.mode = 2; }
#if NAIVE_GEMM
            if (p.mode == 0) simple_gemm_swiglu(p.A0, p.B0, H, gw, ngw, lane);
            else {
                simple_gemm_job(p.A0, p.B0, p.nM0 * 256, p.nN0 * 256, p.K, 0, p.proj, p.vt, p.km, p.vmt, p.mode, p.out, p.ld, gw, ngw, lane);
                if (p.mode == 2) {
                    simple_gemm_job(p.A1, p.B1, 6 * 256, 64 * 256, p.K, 1, p.proj, p.vt, p.km, p.vmt, 2, p.out, p.ld, gw, ngw, lane);
                    simple_gemm_job(p.A2, p.B2, 4 * 256, 2 * 256, p.K, 2, p.proj, p.vt, p.km, p.vmt, 2, p.out, p.ld, gw, ngw, lane);
                    simple_gemm_job(p.A3, p.B3, 2 * 256, 4 * 256, p.K, 3, p.proj, p.vt, p.km, p.vmt, 2, p.out, p.ld, gw, ngw, lane);
                }
            }
#else
            pg8::gemm_phase(lds, p, tid);
#endif
        } else if (ph == 0) {
            LAS float* scr = (LAS float*)(lds + wave * (64 * 65 * 4));
            constexpr int I_GU = 32 * 176, I_D = 88 * 32, I_IN = 32 * 72, I_MKV = 32 * 16, I_OUT = 32 * 32;
            constexpr int NITEMS = 2 * I_GU + 2 * I_D + I_IN + I_MKV + I_OUT;
            for (int it = gw; it < NITEMS; it += ngw) {
                int r = it;
                if (r < I_GU) { const int nb = r % 176; transpose_item(P.in[3], DM, NGU, (bf16_t*)(ws + WS_WGU1), r / 176, nb, map_gu(nb), scr, lane); continue; } r -= I_GU;
                if (r < I_GU) { const int nb = r % 176; transpose_item(P.in[21], DM, NGU, (bf16_t*)(ws + WS_WGU2), r / 176, nb, map_gu(nb), scr, lane); continue; } r -= I_GU;
                if (r < I_D) { const int nb = r % 32; transpose_item(P.in[4], DFF, DM, (bf16_t*)(ws + WS_WD1), r / 32, nb, nb * 64, scr, lane); continue; } r -= I_D;
                if (r < I_D) { const int nb = r % 32; transpose_item(P.in[22], DFF, DM, (bf16_t*)(ws + WS_WD2), r / 32, nb, nb * 64, scr, lane); continue; } r -= I_D;
                if (r < I_IN) { const int nb = r % 72; transpose_item(P.in[8], DM, 4608, (bf16_t*)(ws + WS_WIN), r / 72, nb, map_win(nb), scr, lane); continue; } r -= I_IN;
                if (r < I_MKV) { const int nb = r % 16; transpose_item(P.in[9], DM, 1024, (bf16_t*)(ws + WS_WMKV), r / 16, nb, nb * 64, scr, lane); continue; } r -= I_MKV;
                { const int nb = r % 32; transpose_item(P.in[18], DM, DM, (bf16_t*)(ws + WS_WOUT), r / 32, nb, nb * 64, scr, lane); }
            }
            for (int i = gw * 64 + lane; i < 4 * 128 * 128 / 2; i += ngw * 64) { const float2 v = *(const float2*)(P.in[13] + 2 * i); ((unsigned*)(ws + WS_WSB))[i] = pk2(v.x, v.y); }
            for (int m = gw; m < MTOK; m += ngw) norm_row_bf16(P.in[0] + (size_t)m * DM, P.in[2], XN + (size_t)m * DM, lane);
            for (int m = gw; m < 1024; m += ngw) norm_row_bf16(P.in[1] + (size_t)m * DM, P.in[7], (bf16_t*)(ws + WS_MEMN) + (size_t)m * DM, lane);
        } else if (ph == 3) {
            for (int m = gw; m < MTOK; m += ngw) resid_row<false>(F + (size_t)m * DM, P.in[0] + (size_t)m * DM, P.out + (size_t)m * DM, P.in[5], 0.5f, P.in[6], XN + (size_t)m * DM, nullptr, lane);
        } else if (ph == 8) {
            for (int m = gw; m < MTOK; m += ngw) resid_row<false>(F + (size_t)m * DM, P.out + (size_t)m * DM, P.out + (size_t)m * DM, P.in[19], 1.0f, P.in[20], XN + (size_t)m * DM, nullptr, lane);
        } else if (ph == 11) {
            for (int m = gw; m < MTOK; m += ngw) resid_row<true>(F + (size_t)m * DM, P.out + (size_t)m * DM, nullptr, P.in[23], 0.5f, P.in[24], nullptr, P.out + (size_t)m * DM, lane);
        } else if (ph == 5) {
#if NAIVE_P5
            naive_p5(P, gw, ngw, lane);
#else
            for (int u = bid; u < 256; u += G) p5_unit(P, lds, u, tid, lane, wave);
#endif
        } else if (ph == 6) {
            for (int m = gw; m < MTOK; m += ngw) rescale_row(XN + (size_t)m * DM, P.in[15], P.in[16], P.in[17], lane);
        }
        if (ph + 1 < a.ph_hi) grid.sync();
    }
}

extern "C" void kernel_launch(void* const* d_in, const int* in_sizes, int n_in, void* d_out, int out_size, void* d_ws, size_t ws_size, hipStream_t stream) {
    static int grid = 0;
    if (grid == 0) {
        if (n_in != 25 || out_size != MTOK * DM || ws_size < WS_END) { fprintf(stderr, "kernel_launch: unexpected problem (n_in %d, out %d, ws %zu < %zu)\n", n_in, out_size, ws_size, (size_t)WS_END); grid = -1; return; }
        int dev = 0, cus = 0, per_cu = 0;
        (void)hipGetDevice(&dev);
        (void)hipDeviceGetAttribute(&cus, hipDeviceAttributeMultiprocessorCount, dev);
        (void)hipFuncSetAttribute((const void*)fwd_kernel, hipFuncAttributeMaxDynamicSharedMemorySize, LDS_BYTES);
        (void)hipOccupancyMaxActiveBlocksPerMultiprocessor(&per_cu, (const void*)fwd_kernel, 512, LDS_BYTES);
        if (per_cu < 1) { fprintf(stderr, "kernel_launch: occupancy query says %d blocks per CU\n", per_cu); per_cu = 1; }
        grid = cus * 1;
        (void)hipGetLastError();
    }
    if (grid < 0) return;
    Args a{};
    for (int i = 0; i < 25; ++i) a.in[i] = (const float*)d_in[i];
    a.out = (float*)d_out; a.ws = (unsigned char*)d_ws;
#if MULTI_LAUNCH
    for (int ph = 0; ph < NPHASE; ++ph) {
        if (ph == 6 && !NAIVE_P5) continue;
        a.ph_lo = ph; a.ph_hi = ph + 1;
        hipLaunchKernelGGL(fwd_kernel, dim3(grid), dim3(512), LDS_BYTES, stream, a);
    }
#else
    a.ph_lo = 0; a.ph_hi = NPHASE;
    void* args[] = {&a};
    hipError_t e = hipLaunchCooperativeKernel((const void*)fwd_kernel, dim3(grid), dim3(512), args, LDS_BYTES, stream);
    if (e != hipSuccess) fprintf(stderr, "cooperative launch failed: %s (grid %d)\n", hipGetErrorString(e), grid);
#endif
}
```

```cpp
#include <hip/hip_runtime.h>
#include <hip/hip_cooperative_groups.h>
#include <cstdio>
namespace cg = cooperative_groups;

#ifndef MULTI_LAUNCH
#define MULTI_LAUNCH 0
#endif
#ifndef NAIVE_GEMM
#define NAIVE_GEMM 0
#endif
#ifndef NAIVE_P5
#define NAIVE_P5 0
#endif

#ifndef PROBE_PH
#define PROBE_PH (-1)
#define PROBE_N 0
#endif

#ifndef P5_REP_PRE
#define P5_REP_PRE 1
#define P5_REP_NA 1
#define P5_REP_MEM 1
#define P5_REP_SG 1
#endif
#define LAS __attribute__((address_space(3)))
typedef unsigned short bf16_t;
typedef short bf16x8 __attribute__((ext_vector_type(8)));
typedef float f32x4 __attribute__((ext_vector_type(4)));
typedef unsigned u32x4 __attribute__((ext_vector_type(4)));
typedef unsigned u32x2 __attribute__((ext_vector_type(2)));

constexpr int MTOK = 16384, DM = 2048, DFF = 5632, NGU = 11264, SEQ = 4096;
constexpr int PROJ_LD = 3072, VT_LD = 16384;
constexpr float EPS = 1e-6f;
constexpr float LOG2E = 1.4426950408889634f;
constexpr float QSCALE = 0.08838834764831845f * LOG2E;
constexpr int NPHASE = 12;
constexpr int LDS_BYTES = 156 * 1024;

constexpr size_t WS_WGU1 = 0;
constexpr size_t WS_WD1 = WS_WGU1 + (size_t)NGU * DM * 2;
constexpr size_t WS_WIN = WS_WD1 + (size_t)DM * DFF * 2;
constexpr size_t WS_WMKV = WS_WIN + (size_t)4608 * DM * 2;
constexpr size_t WS_WOUT = WS_WMKV + (size_t)1024 * DM * 2;
constexpr size_t WS_WGU2 = WS_WOUT + (size_t)DM * DM * 2;
constexpr size_t WS_WD2 = WS_WGU2 + (size_t)NGU * DM * 2;
constexpr size_t WS_WSB = WS_WD2 + (size_t)DM * DFF * 2;
constexpr size_t WS_MEMN = WS_WSB + (size_t)4 * 128 * 128 * 2;
constexpr size_t WS_KM = WS_MEMN + (size_t)1024 * DM * 2;
constexpr size_t WS_VMT = WS_KM + (size_t)1024 * 512 * 2;
constexpr size_t WS_XN = WS_VMT + (size_t)512 * 1024 * 2;
constexpr size_t WS_H = WS_XN + (size_t)MTOK * DM * 2;
constexpr size_t WS_PROJ = WS_H;
constexpr size_t WS_VT = WS_H + (size_t)MTOK * PROJ_LD * 2;
constexpr size_t WS_F = WS_H + (size_t)MTOK * DFF * 2;
constexpr size_t WS_END = WS_F + (size_t)MTOK * DM * 2;
static_assert(WS_VT + (size_t)1536 * VT_LD * 2 <= WS_F, "overlay");
static_assert(WS_END <= (size_t)536870912, "workspace");

__device__ __forceinline__ unsigned pk2(float lo, float hi) { unsigned r; asm("v_cvt_pk_bf16_f32 %0, %1, %2" : "=v"(r) : "v"(lo), "v"(hi)); return r; }
__device__ __forceinline__ float bflo(unsigned u) { return __uint_as_float(u << 16); }
__device__ __forceinline__ float bfhi(unsigned u) { return __uint_as_float(u & 0xffff0000u); }
__device__ __forceinline__ float bf1(bf16_t b) { return __uint_as_float(((unsigned)b) << 16); }
__device__ __forceinline__ float wave_sum(float v) {
#pragma unroll
    for (int o = 1; o < 64; o <<= 1) v += __shfl_xor(v, o);
    return v;
}
__device__ __forceinline__ float fexp2(float x) { return __builtin_amdgcn_exp2f(x); }
__device__ __forceinline__ float frcp(float x) { return __builtin_amdgcn_rcpf(x); }
__device__ __forceinline__ float gelu_tanh(float x) {
    const float t = x * (1.0f + 0.044715f * x * x);
    return x * frcp(1.0f + fexp2(t * (-2.0f * 0.7978845608028654f * LOG2E)));
}
__device__ __forceinline__ float silu_mul(float g, float u) { return g * frcp(1.0f + fexp2(g * (-LOG2E))) * u; }
__device__ __forceinline__ f32x4 mfma16(bf16x8 a, bf16x8 b, f32x4 c) { return __builtin_amdgcn_mfma_f32_16x16x32_bf16(a, b, c, 0, 0, 0); }

struct OutBf {
    bf16_t* base; int ld; int act; float sc;
    __device__ __forceinline__ f32x4 xf(f32x4 v) const {
        v = v * sc;
        if (act) { v.x = gelu_tanh(v.x); v.y = gelu_tanh(v.y); v.z = gelu_tanh(v.z); v.w = gelu_tanh(v.w); }
        return v;
    }
    __device__ __forceinline__ void st4(int row, int col, f32x4 v) const {
        v = xf(v); u32x2 w; w.x = pk2(v.x, v.y); w.y = pk2(v.z, v.w);
        *(u32x2*)(base + (size_t)row * ld + col) = w;
    }
    __device__ __forceinline__ void st8(int row, int col, f32x4 a, f32x4 b) const {
        a = xf(a); b = xf(b); u32x4 w; w.x = pk2(a.x, a.y); w.y = pk2(a.z, a.w); w.z = pk2(b.x, b.y); w.w = pk2(b.z, b.w);
        *(u32x4*)(base + (size_t)row * ld + col) = w;
    }
};
__device__ __forceinline__ OutBf p4_sel(int job, int pm, int pn, bf16_t* proj, bf16_t* vt, bf16_t* km, bf16_t* vmt) {
    OutBf o; o.act = 0; o.sc = 1.0f; o.base = proj; o.ld = PROJ_LD;
    if (job == 0) { if (pn < 4 || pn >= 10) o.sc = QSCALE; else if (pn >= 8) o.act = 1; }
    if (job == 1) { o.base = vt; o.ld = VT_LD; if (pm >= 4) o.act = 1; }
    if (job == 2) { o.base = km; o.ld = 512; }
    if (job == 3) { o.base = vmt; o.ld = 1024; }
    return o;
}

namespace pg8 {
constexpr int BM = 256, BK = 64, HALF = 128, HTB = HALF * BK * 2, STAGE_BYTES = 8 * HTB, NXCD = 8, WGM = 8;
__device__ __forceinline__ int lds_byte(int r, int c) { const int st = (r >> 4) * 2 + (c >> 5), rr = r & 15, cc = c & 31, ob = rr * 64 + cc * 2; return st * 1024 + (ob ^ (((ob >> 9) & 1) << 5)); }
__device__ __forceinline__ void stage_rc(int b, int& R, int& C) { const int st = b / 1024, sb = b % 1024, swz = sb ^ (((sb >> 9) & 1) << 5); R = (st >> 1) * 16 + swz / 64; C = (st & 1) * 32 + (swz % 64) / 2; }
__device__ __forceinline__ int perm32(int rho) { const int n = rho >> 4, i = rho & 15; return 8 * (i >> 2) + 4 * n + (i & 3); }

struct Unit { int pm, pn, job; const bf16_t* A; const bf16_t* B; };
struct GP {
    int K, G, c, mode, ld, nM0, nN0, total;
    bf16_t* out; const bf16_t *A0, *B0, *A1, *B1, *A2, *B2, *A3, *B3; bf16_t *proj, *vt, *km, *vmt;
};
__device__ __forceinline__ bool sched_next(int i, Unit& u, int G, int c, int total, int mode, int nM0, int nN0, const bf16_t* A0, const bf16_t* B0,
                                           const bf16_t* A1, const bf16_t* B1, const bf16_t* A2, const bf16_t* B2, const bf16_t* A3, const bf16_t* B3) {
    const int L = i * G + c; if (L >= total) return false;
    int job = 0, st = 0, nM = nM0, nN = nN0; const bf16_t* pa = A0; const bf16_t* pb = B0;
    if (mode == 2) {
        if (L >= 768) { job = 1; st = 768; nM = 6; nN = 64; pa = A1; pb = B1; }
        if (L >= 1152) { job = 2; st = 1152; nM = 4; nN = 2; pa = A2; pb = B2; }
        if (L >= 1160) { job = 3; st = 1160; nM = 2; nN = 4; pa = A3; pb = B3; }
    }
    int wgid = L - st; const int nwg = nM * nN;
    { const int q = nwg / NXCD, r = nwg % NXCD, xcd = wgid % NXCD, off = wgid / NXCD; wgid = (xcd < r ? xcd * (q + 1) : r * (q + 1) + (xcd - r) * q) + off; }
    const int nig = WGM * nN, gid = wgid / nig, fm = gid * WGM, gsz = (nM - fm) < WGM ? (nM - fm) : WGM;
    u.pm = fm + ((wgid % nig) % gsz); u.pn = (wgid % nig) / gsz; u.job = job; u.A = pa; u.B = pb; return true;
}
__device__ __forceinline__ void epilogue(const f32x4 (&acc)[2][2][4][2], const Unit& u, int wr, int wc, int fr, int fq, int mode, bf16_t* out, int ld, bf16_t* proj, bf16_t* vt, bf16_t* km, bf16_t* vmt) {
    const int row0 = u.pm * BM + wr * 64 + fr, cb = wc * 32 + 8 * fq;
    if (mode == 0) {
#pragma unroll
        for (int ai = 0; ai < 2; ++ai)
#pragma unroll
            for (int m = 0; m < 4; ++m) {
                const f32x4 g0 = acc[ai][0][m][0], g1 = acc[ai][0][m][1], u0 = acc[ai][1][m][0], u1 = acc[ai][1][m][1];
                u32x4 w;
                w.x = pk2(silu_mul(g0.x, u0.x), silu_mul(g0.y, u0.y)); w.y = pk2(silu_mul(g0.z, u0.z), silu_mul(g0.w, u0.w));
                w.z = pk2(silu_mul(g1.x, u1.x), silu_mul(g1.y, u1.y)); w.w = pk2(silu_mul(g1.z, u1.z), silu_mul(g1.w, u1.w));
                *(u32x4*)(out + (size_t)(row0 + ai * HALF + m * 16) * DFF + u.pn * 128 + cb) = w;
            }
    } else {
        OutBf o; o.base = out; o.ld = ld; o.act = 0; o.sc = 1.0f;
        if (mode == 2) o = p4_sel(u.job, u.pm, u.pn, proj, vt, km, vmt);
#pragma unroll
        for (int ai = 0; ai < 2; ++ai)
#pragma unroll
            for (int m = 0; m < 4; ++m)
#pragma unroll
                for (int bj = 0; bj < 2; ++bj)
                    o.st8(row0 + ai * HALF + m * 16, u.pn * BM + bj * HALF + cb, acc[ai][bj][m][0], acc[ai][bj][m][1]);
    }
}

__device__ __forceinline__ void gemm_phase(LAS unsigned char* lds, const GP p, const int tid) {
    const int K = p.K; const size_t tstep = (size_t)256 * K * 2;
#define SNEXT(i, u) sched_next(i, u, p.G, p.c, p.total, p.mode, p.nM0, p.nN0, p.A0, p.B0, p.A1, p.B1, p.A2, p.B2, p.A3, p.B3)
#define APTR(u) ((const char*)(u).A + (size_t)(u).pm * tstep)
#define BPTR(u) ((const char*)(u).B + (size_t)(u).pn * tstep)
    const int wid = __builtin_amdgcn_readfirstlane(tid >> 6), lane = tid & 63, wr = wid >> 2, wc = wid & 3, fr = lane & 15, fq = lane >> 4;
    const int nt = K / BK;
    unsigned voffA[2], voffB[2];
#pragma unroll
    for (int i = 0; i < 2; ++i) { int R, C; stage_rc(tid * 16 + i * 8192, R, C); const int Rb = (R & ~31) + perm32(R & 31);
        voffA[i] = (unsigned)(R * K + C) * 2u; voffB[i] = (unsigned)(Rb * K + C) * 2u; }
    const size_t kstep = (size_t)(BK * 2);
    const size_t hstep = (size_t)HALF * K * 2;
    const unsigned ldsw = (unsigned)wid * 1024u;
    const int aoff = lds_byte(wr * 64 + fr, fq * 8), boff = lds_byte(wc * 32 + fr, fq * 8);
#define PG8_SA(b, h) (((b) * 2 + (h)) * HTB)
#define PG8_SB(b, h) ((4 + (b) * 2 + (h)) * HTB)
#define PG8_STAGE(bufoff, gbase, voff) do { _Pragma("unroll") for (int _i = 0; _i < 2; ++_i) \
        __builtin_amdgcn_global_load_lds((const unsigned*)((const char*)(gbase) + (voff)[_i]), (LAS unsigned*)(lds + (bufoff) + ldsw + _i * 8192), 16, 0, 0); } while (0)
#define PG8_LDA(dst, b, h) do { _Pragma("unroll") for (int m = 0; m < 4; ++m) _Pragma("unroll") for (int k = 0; k < 2; ++k) dst[m][k] = *(const LAS bf16x8*)(lds + PG8_SA(b, h) + aoff + m * 2048 + k * 1024); } while (0)
#define PG8_LDB(dst, b, h) do { _Pragma("unroll") for (int n = 0; n < 2; ++n) _Pragma("unroll") for (int k = 0; k < 2; ++k) dst[n][k] = *(const LAS bf16x8*)(lds + PG8_SB(b, h) + boff + n * 2048 + k * 1024); } while (0)
#define PG8_MMA(ai, bj, At, Bt) do { __builtin_amdgcn_s_setprio(1); _Pragma("unroll") for (int m = 0; m < 4; ++m) _Pragma("unroll") for (int n = 0; n < 2; ++n) _Pragma("unroll") for (int k = 0; k < 2; ++k) \
        acc[ai][bj][m][n] = __builtin_amdgcn_mfma_f32_16x16x32_bf16(Bt[n][k], At[m][k], acc[ai][bj][m][n], 0, 0, 0); __builtin_amdgcn_s_setprio(0); } while (0)
#define PG8_WAIT_V(n) asm volatile("s_waitcnt vmcnt(" #n ")" ::: "memory")
#define PG8_WAIT_L(n) asm volatile("s_waitcnt lgkmcnt(" #n ")" ::: "memory")
#define PG8_BAR __builtin_amdgcn_s_barrier()
#define PG8_SCHED __builtin_amdgcn_sched_barrier(0)
    Unit cur, nxt; int ui = 0;
    if (!SNEXT(0, cur)) return;
    f32x4 acc[2][2][4][2];
#pragma unroll
    for (int a = 0; a < 2; ++a)
#pragma unroll
        for (int b = 0; b < 2; ++b)
#pragma unroll
            for (int m = 0; m < 4; ++m)
#pragma unroll
                for (int n = 0; n < 2; ++n) acc[a][b][m][n] = (f32x4){0.f, 0.f, 0.f, 0.f};
    bf16x8 At[4][2], B0[2][2], B1[2][2];
    const char* cA = APTR(cur); const char* cB = BPTR(cur);
    PG8_STAGE(PG8_SB(0, 0), cB, voffB); PG8_STAGE(PG8_SB(0, 1), cB + hstep, voffB); PG8_STAGE(PG8_SA(0, 0), cA, voffA); PG8_STAGE(PG8_SA(0, 1), cA + hstep, voffA);
    if (wr == 1) PG8_BAR;
    PG8_WAIT_V(2); PG8_BAR;
    PG8_STAGE(PG8_SB(1, 0), cB + kstep, voffB); PG8_STAGE(PG8_SA(1, 0), cA + kstep, voffA); PG8_STAGE(PG8_SB(1, 1), cB + hstep + kstep, voffB);
    PG8_WAIT_V(6); PG8_BAR;
    for (;;) {
        const bool has_next = SNEXT(ui + 1, nxt);
        const char* nA = has_next ? APTR(nxt) : cA; const char* nB = has_next ? BPTR(nxt) : cB;
        for (int t = 0; t < nt; t += 2) {
            const bool last = (t == nt - 2);
            const char* a1 = cA + (size_t)(t + 1) * kstep;
            const char* a2 = last ? nA : cA + (size_t)(t + 2) * kstep; const char* b2 = last ? nB : cB + (size_t)(t + 2) * kstep;
            const char* a3 = a2 + kstep; const char* b3 = b2 + kstep;
            PG8_LDB(B0, 0, 0); PG8_LDB(B1, 0, 1); PG8_SCHED; PG8_LDA(At, 0, 0); PG8_STAGE(PG8_SA(1, 1), a1 + hstep, voffA);
            PG8_WAIT_V(8); PG8_WAIT_L(0); PG8_BAR; PG8_MMA(0, 0, At, B0); PG8_MMA(0, 1, At, B1); PG8_BAR; PG8_SCHED;
            PG8_LDA(At, 0, 1); PG8_STAGE(PG8_SB(0, 0), b2, voffB); PG8_STAGE(PG8_SB(0, 1), b2 + hstep, voffB); PG8_STAGE(PG8_SA(0, 0), a2, voffA);
            PG8_WAIT_V(8); PG8_WAIT_L(0); PG8_BAR; PG8_MMA(1, 0, At, B0); PG8_MMA(1, 1, At, B1); PG8_BAR; PG8_SCHED;
            PG8_LDB(B0, 1, 0); PG8_LDB(B1, 1, 1); PG8_SCHED; PG8_LDA(At, 1, 0); PG8_STAGE(PG8_SA(0, 1), a2 + hstep, voffA);
            PG8_WAIT_V(8); PG8_WAIT_L(0); PG8_BAR; PG8_MMA(0, 0, At, B0); PG8_MMA(0, 1, At, B1); PG8_BAR; PG8_SCHED;
            PG8_LDA(At, 1, 1); PG8_STAGE(PG8_SB(1, 0), b3, voffB); PG8_STAGE(PG8_SB(1, 1), b3 + hstep, voffB); PG8_STAGE(PG8_SA(1, 0), a3, voffA);
            PG8_WAIT_V(8); PG8_WAIT_L(0); PG8_BAR; PG8_MMA(1, 0, At, B0); PG8_MMA(1, 1, At, B1); PG8_BAR; PG8_SCHED;
        }
        if (wr == 0) PG8_BAR;
        epilogue(acc, cur, wr, wc, fr, fq, p.mode, p.out, p.ld, p.proj, p.vt, p.km, p.vmt);
        if (!has_next) break;
#pragma unroll
        for (int a = 0; a < 2; ++a)
#pragma unroll
            for (int b = 0; b < 2; ++b)
#pragma unroll
                for (int m = 0; m < 4; ++m)
#pragma unroll
                    for (int n = 0; n < 2; ++n) acc[a][b][m][n] = (f32x4){0.f, 0.f, 0.f, 0.f};
        cur = nxt; cA = nA; cB = nB; ++ui;
        if (wr == 1) PG8_BAR;
    }
    PG8_WAIT_V(0);
    PG8_BAR;
#undef SNEXT
#undef APTR
#undef BPTR
#undef PG8_SA
#undef PG8_SB
#undef PG8_STAGE
#undef PG8_LDA
#undef PG8_LDB
#undef PG8_MMA
#undef PG8_WAIT_V
#undef PG8_WAIT_L
#undef PG8_BAR
#undef PG8_SCHED
}
}

__device__ __forceinline__ void simple_gemm_job(const bf16_t* A, const bf16_t* Bt, int Mr, int Nc, int K, int job, bf16_t* proj, bf16_t* vt, bf16_t* km, bf16_t* vmt, int mode, bf16_t* out, int ld, int gw, int ngw, int lane) {
    const int fr = lane & 15, fq = lane >> 4, tn = Nc / 64, tiles = (Mr / 64) * tn;
    for (int t = gw; t < tiles; t += ngw) {
        const int row0 = (t / tn) * 64, col0 = (t % tn) * 64;
        f32x4 acc[4][4];
#pragma unroll
        for (int i = 0; i < 4; ++i)
#pragma unroll
            for (int j = 0; j < 4; ++j) acc[i][j] = (f32x4){0.f, 0.f, 0.f, 0.f};
        const bf16_t* ap = A + (size_t)(row0 + fr) * K + fq * 8; const bf16_t* bp = Bt + (size_t)(col0 + fr) * K + fq * 8;
        for (int k = 0; k < K; k += 32) {
            bf16x8 a[4], b[4];
#pragma unroll
            for (int i = 0; i < 4; ++i) { a[i] = *(const bf16x8*)(ap + (size_t)i * 16 * K + k); b[i] = *(const bf16x8*)(bp + (size_t)i * 16 * K + k); }
#pragma unroll
            for (int i = 0; i < 4; ++i)
#pragma unroll
                for (int j = 0; j < 4; ++j) acc[i][j] = mfma16(b[j], a[i], acc[i][j]);
        }
        OutBf o; o.base = out; o.ld = ld; o.act = 0; o.sc = 1.0f; if (mode == 2) o = p4_sel(job, row0 / 256, col0 / 256, proj, vt, km, vmt);
#pragma unroll
        for (int i = 0; i < 4; ++i)
#pragma unroll
            for (int j = 0; j < 4; ++j) o.st4(row0 + i * 16 + fr, col0 + j * 16 + fq * 4, acc[i][j]);
    }
}
__device__ __forceinline__ void simple_gemm_swiglu(const bf16_t* A, const bf16_t* Wt, bf16_t* H, int gw, int ngw, int lane) {
    const int fr = lane & 15, fq = lane >> 4, K = DM, tn = DFF / 32, tiles = (MTOK / 64) * tn;
    for (int t = gw; t < tiles; t += ngw) {
        const int row0 = (t / tn) * 64, h0 = (t % tn) * 32, wrow = 256 * (h0 >> 7) + (h0 & 127);
        f32x4 g[4][2], u[4][2];
#pragma unroll
        for (int i = 0; i < 4; ++i)
#pragma unroll
            for (int j = 0; j < 2; ++j) { g[i][j] = (f32x4){0.f, 0.f, 0.f, 0.f}; u[i][j] = (f32x4){0.f, 0.f, 0.f, 0.f}; }
        const bf16_t* ap = A + (size_t)(row0 + fr) * K + fq * 8; const bf16_t* bp = Wt + (size_t)(wrow + fr) * K + fq * 8;
        for (int k = 0; k < K; k += 32) {
            bf16x8 a[4], bg[2], bu[2];
#pragma unroll
            for (int i = 0; i < 4; ++i) a[i] = *(const bf16x8*)(ap + (size_t)i * 16 * K + k);
#pragma unroll
            for (int j = 0; j < 2; ++j) { bg[j] = *(const bf16x8*)(bp + (size_t)j * 16 * K + k); bu[j] = *(const bf16x8*)(bp + (size_t)(128 + j * 16) * K + k); }
#pragma unroll
            for (int i = 0; i < 4; ++i)
#pragma unroll
                for (int j = 0; j < 2; ++j) { g[i][j] = mfma16(bg[j], a[i], g[i][j]); u[i][j] = mfma16(bu[j], a[i], u[i][j]); }
        }
#pragma unroll
        for (int i = 0; i < 4; ++i)
#pragma unroll
            for (int j = 0; j < 2; ++j) {
                u32x2 w; w.x = pk2(silu_mul(g[i][j].x, u[i][j].x), silu_mul(g[i][j].y, u[i][j].y)); w.y = pk2(silu_mul(g[i][j].z, u[i][j].z), silu_mul(g[i][j].w, u[i][j].w));
                *(u32x2*)(H + (size_t)(row0 + i * 16 + fr) * DFF + h0 + j * 16 + fq * 4) = w;
            }
    }
}

__device__ __forceinline__ void transpose_item(const float* W, int K, int N, bf16_t* WT, int kb, int nbd, int src0, LAS float* scr, int lane) {
    const int k0 = kb * 64;
#pragma unroll 4
    for (int i = 0; i < 16; ++i) {
        const int kk = 4 * i + (lane >> 4);
        const f32x4 v = *(const f32x4*)(W + (size_t)(k0 + kk) * N + src0 + (lane & 15) * 4);
        LAS float* s = scr + kk * 65 + (lane & 15) * 4; s[0] = v.x; s[1] = v.y; s[2] = v.z; s[3] = v.w;
    }
    const int c = lane & 7;
#pragma unroll
    for (int jj = 0; jj < 8; ++jj) {
        const int n = (lane >> 3) + 8 * jj; const LAS float* s = scr + (8 * c) * 65 + n;
        u32x4 o; o.x = pk2(s[0], s[65]); o.y = pk2(s[2 * 65], s[3 * 65]); o.z = pk2(s[4 * 65], s[5 * 65]); o.w = pk2(s[6 * 65], s[7 * 65]);
        *(u32x4*)(WT + (size_t)(nbd * 64 + n) * K + k0 + 8 * c) = o;
    }
}
__device__ __forceinline__ int map_gu(int nb) { const int j = nb >> 2, part = nb & 3; return part < 2 ? 128 * j + 64 * part : DFF + 128 * j + 64 * (part - 2); }
__device__ __forceinline__ int map_win(int nb) { const int n = nb * 64; return n < 2048 ? n : n < 2560 ? n + 1024 : n < 3072 ? n + 1536 : n < 4096 ? n - 1024 : n - 512; }

__device__ __forceinline__ void norm_row_bf16(const float* xr, const float* g, bf16_t* o, int lane) {
    f32x4 v[8]; float s = 0.f;
#pragma unroll
    for (int j = 0; j < 8; ++j) { v[j] = *(const f32x4*)(xr + 256 * j + 4 * lane); s += (v[j].x * v[j].x + v[j].y * v[j].y) + (v[j].z * v[j].z + v[j].w * v[j].w); }
    const float rs = rsqrtf(wave_sum(s) * (1.0f / DM) + EPS);
#pragma unroll
    for (int j = 0; j < 8; ++j) { const f32x4 gv = *(const f32x4*)(g + 256 * j + 4 * lane);
        u32x2 w; w.x = pk2(v[j].x * rs * gv.x, v[j].y * rs * gv.y); w.y = pk2(v[j].z * rs * gv.z, v[j].w * rs * gv.w);
        *(u32x2*)(o + 256 * j + 4 * lane) = w; }
}
template <bool FINAL>
__device__ __forceinline__ void resid_row(const bf16_t* f, const float* hin, float* hout, const float* gpost, float alpha, const float* gnext, bf16_t* xn, float* fin, int lane) {
    f32x4 v[8]; float s = 0.f;
#pragma unroll
    for (int j = 0; j < 8; ++j) { const u32x2 w = *(const u32x2*)(f + 256 * j + 4 * lane); v[j] = (f32x4){bflo(w.x), bfhi(w.x), bflo(w.y), bfhi(w.y)};
        s += (v[j].x * v[j].x + v[j].y * v[j].y) + (v[j].z * v[j].z + v[j].w * v[j].w); }
    const float rs = rsqrtf(wave_sum(s) * (1.0f / DM) + EPS) * alpha;
    float s2 = 0.f;
#pragma unroll
    for (int j = 0; j < 8; ++j) { const f32x4 gv = *(const f32x4*)(gpost + 256 * j + 4 * lane); const f32x4 hv = *(const f32x4*)(hin + 256 * j + 4 * lane);
        v[j] = hv + v[j] * rs * gv; s2 += (v[j].x * v[j].x + v[j].y * v[j].y) + (v[j].z * v[j].z + v[j].w * v[j].w);
        if (!FINAL) *(f32x4*)(hout + 256 * j + 4 * lane) = v[j]; }
    const float rs2 = rsqrtf(wave_sum(s2) * (1.0f / DM) + EPS);
#pragma unroll
    for (int j = 0; j < 8; ++j) { const f32x4 gv = *(const f32x4*)(gnext + 256 * j + 4 * lane); const f32x4 o = v[j] * rs2 * gv;
        if (FINAL) *(f32x4*)(fin + 256 * j + 4 * lane) = o;
        else { u32x2 w; w.x = pk2(o.x, o.y); w.y = pk2(o.z, o.w); *(u32x2*)(xn + 256 * j + 4 * lane) = w; } }
}
__device__ __forceinline__ void rescale_row(bf16_t* y, const float* gna, const float* gsg, const float* gmem, int lane) {
    u32x4 w[4]; float ss[4];
#pragma unroll
    for (int j = 0; j < 4; ++j) { w[j] = *(const u32x4*)(y + 512 * j + 8 * lane);
        const float a0 = bflo(w[j].x), a1 = bfhi(w[j].x), a2 = bflo(w[j].y), a3 = bfhi(w[j].y), a4 = bflo(w[j].z), a5 = bfhi(w[j].z), a6 = bflo(w[j].w), a7 = bfhi(w[j].w);
        ss[j] = (a0 * a0 + a1 * a1) + (a2 * a2 + a3 * a3) + (a4 * a4 + a5 * a5) + (a6 * a6 + a7 * a7); }
    const float rna = rsqrtf(wave_sum(ss[0] + ss[1]) * (1.0f / 1024) + EPS), rsg = rsqrtf(wave_sum(ss[2]) * (1.0f / 512) + EPS), rme = rsqrtf(wave_sum(ss[3]) * (1.0f / 512) + EPS);
#pragma unroll
    for (int j = 0; j < 4; ++j) {
        const float* g = (j < 2 ? gna + 512 * j : j == 2 ? gsg : gmem) + 8 * lane; const float r = j < 2 ? rna : j == 2 ? rsg : rme;
        const f32x4 g0 = *(const f32x4*)g, g1 = *(const f32x4*)(g + 4);
        u32x4 o; o.x = pk2(bflo(w[j].x) * r * g0.x, bfhi(w[j].x) * r * g0.y); o.y = pk2(bflo(w[j].y) * r * g0.z, bfhi(w[j].y) * r * g0.w);
        o.z = pk2(bflo(w[j].z) * r * g1.x, bfhi(w[j].z) * r * g1.y); o.w = pk2(bflo(w[j].w) * r * g1.z, bfhi(w[j].w) * r * g1.w);
        *(u32x4*)(y + 512 * j + 8 * lane) = o; }
}

struct Ptrs {
    const float* in[25]; float* out; unsigned char* ws;
};
constexpr int VVT_LD = 136, KSTR = 272, KT_BYTES = 69632, VSTR_NA = 144, VSTR_MEM = 272, RPB_OFF = 143360;
static_assert(KT_BYTES + 512 * VSTR_NA <= RPB_OFF && KT_BYTES + 256 * VSTR_MEM <= RPB_OFF && 512 * VVT_LD * 2 <= RPB_OFF && RPB_OFF + 8 * 465 * 4 <= LDS_BYTES, "P5 LDS map");

template <bool NA>
__device__ __forceinline__ void attn_row(f32x4 (&o)[8], float& m, float& l, const bf16x8 (&qf)[4], const LAS unsigned char* kp, const LAS unsigned char* vp, const int vstr,
                                         const LAS float* br, const int qc, const int kc0  ) {
    bf16x8 kf[2][4];
#pragma unroll
    for (int a = 0; a < 2; ++a)
#pragma unroll
        for (int dc = 0; dc < 4; ++dc) kf[a][dc] = *(const LAS bf16x8*)(kp + a * 16 * KSTR + dc * 64);
    u32x2 vlo[8], vhi[8];
#pragma unroll
    for (int d = 0; d < 8; ++d) { vlo[d] = *(const LAS u32x2*)(vp + d * 16 * vstr); vhi[d] = *(const LAS u32x2*)(vp + d * 16 * vstr + 32); }
    f32x4 s0 = (f32x4){0.f, 0.f, 0.f, 0.f}, s1 = (f32x4){0.f, 0.f, 0.f, 0.f};
#pragma unroll
    for (int dc = 0; dc < 4; ++dc) { s0 = mfma16(kf[0][dc], qf[dc], s0); s1 = mfma16(kf[1][dc], qf[dc], s1); }
    if (NA) {
        const int cs = min(max(qc - 8, 0), 48);
#pragma unroll
        for (int e = 0; e < 4; ++e) {
            const int k0 = kc0 + e, k1 = kc0 + 16 + e;
            s0[e] = (k0 >= cs && k0 < cs + 16) ? s0[e] + br[min(max(k0 - qc, -15), 15) + 15] : -1.0e30f;
            s1[e] = (k1 >= cs && k1 < cs + 16) ? s1[e] + br[min(max(k1 - qc, -15), 15) + 15] : -1.0e30f;
        }
    }
    float mx = fmaxf(fmaxf(fmaxf(s0.x, s0.y), fmaxf(s0.z, s0.w)), fmaxf(fmaxf(s1.x, s1.y), fmaxf(s1.z, s1.w)));
    mx = fmaxf(mx, __shfl_xor(mx, 16)); mx = fmaxf(mx, __shfl_xor(mx, 32));
    const float mn = fmaxf(m, mx), alpha = fexp2(m - mn); m = mn;
#pragma unroll
    for (int e = 0; e < 4; ++e) { s0[e] = fexp2(s0[e] - mn); s1[e] = fexp2(s1[e] - mn); }
    l = l * alpha + ((s0.x + s0.y) + (s0.z + s0.w)) + ((s1.x + s1.y) + (s1.z + s1.w));
    u32x4 pw; pw.x = pk2(s0.x, s0.y); pw.y = pk2(s0.z, s0.w); pw.z = pk2(s1.x, s1.y); pw.w = pk2(s1.z, s1.w);
    const bf16x8 pb = __builtin_bit_cast(bf16x8, pw);
#pragma unroll
    for (int d = 0; d < 8; ++d) {
        u32x4 vw; vw.x = vlo[d].x; vw.y = vlo[d].y; vw.z = vhi[d].x; vw.w = vhi[d].y;
        o[d] = mfma16(__builtin_bit_cast(bf16x8, vw), pb, o[d] * alpha);
    }
}
__device__ __forceinline__ void attn_init(f32x4 (&o)[8], float& m, float& l) {
#pragma unroll
    for (int d = 0; d < 8; ++d) o[d] = (f32x4){0.f, 0.f, 0.f, 0.f};
    m = -3.0e38f; l = 0.f;
}
__device__ __forceinline__ void attn_finish(const f32x4 (&o)[8], float l, bf16_t* yp) {
    l += __shfl_xor(l, 16); l += __shfl_xor(l, 32);
    const float inv = frcp(l);
#pragma unroll
    for (int d = 0; d < 8; ++d) { u32x2 w; w.x = pk2(o[d].x * inv, o[d].y * inv); w.y = pk2(o[d].z * inv, o[d].w * inv); *(u32x2*)(yp + d * 16) = w; }
}
#define P5_LAUNDER() int tid = tid_in; asm volatile("" : "+v"(tid)); const int lane = tid & 63, fr = lane & 15, fq = lane >> 4
__device__ __forceinline__ void p5_unit(const Ptrs& P, LAS unsigned char* lds, int unit, int tid_in, int wave) {
    const bf16_t* proj = (const bf16_t*)(P.ws + WS_PROJ); const bf16_t* vt = (const bf16_t*)(P.ws + WS_VT);
    const bf16_t* km = (const bf16_t*)(P.ws + WS_KM); const bf16_t* vmt = (const bf16_t*)(P.ws + WS_VMT);
    const bf16_t* wsb = (const bf16_t*)(P.ws + WS_WSB);
    bf16_t* Y = (bf16_t*)(P.ws + WS_XN);
    const int b = unit >> 6, r = unit & 63, tok0 = b * SEQ + r * 64;
    const int rs = min(max(r - 4, 0), 56);
    LAS float* rpb = (LAS float*)(lds + RPB_OFF);
    LAS bf16_t* vvt = (LAS bf16_t*)lds;
    __syncthreads();
    for (int i = tid_in; i < 8 * 15 * 31; i += 512) rpb[i] = P.in[10][i] * LOG2E;
    for (int rep = 0; rep < P5_REP_PRE; ++rep) {
        P5_LAUNDER(); (void)fr; (void)fq;
        const int g = wave & 3, q = (wave >> 2) * 64 + lane, ctok = b * SEQ + (r >> 1) * 128;
        const bf16_t* vs = vt + (size_t)(1024 + g * 128) * VT_LD + ctok + q;
        float s = 0.f, ss = 0.f;
#pragma unroll 16
        for (int c = 0; c < 128; ++c) { const float x = bf1(vs[(size_t)c * VT_LD]); s += x; ss += x * x; }
        const float mu = s * (1.0f / 128), var = fmaxf(ss * (1.0f / 128) - mu * mu, 0.f), rstd = rsqrtf(var + EPS);
        const float* lg = P.in[11] + g * 128; const float* lb = P.in[12] + g * 128;
#pragma unroll 16
        for (int c = 0; c < 128; ++c) { const float x = bf1(vs[(size_t)c * VT_LD]); const float yv = (x - mu) * rstd * lg[c] + lb[c];
            vvt[(g * 128 + c) * VVT_LD + q] = (bf16_t)(pk2(yv, 0.f) & 0xffffu); }
    }
    __syncthreads();
    for (int rep = 0; rep < P5_REP_SG; ++rep) {
        P5_LAUNDER();
        const int g = wave & 3, half = wave >> 2;
#pragma unroll 1
        for (int pb = 0; pb < 2; ++pb) {
            const int pl = half * 32 + pb * 16 + fr, pp = (r & 1) * 64 + pl;
            f32x4 acc[8];
#pragma unroll
            for (int c = 0; c < 8; ++c) acc[c] = (f32x4){0.f, 0.f, 0.f, 0.f};
#pragma unroll
            for (int qc = 0; qc < 4; ++qc) {
                const bf16x8 wf = *(const bf16x8*)(wsb + (size_t)(g * 128 + pp) * 128 + qc * 32 + fq * 8);
#pragma unroll
                for (int c = 0; c < 8; ++c) {
                    const bf16x8 af = *(const LAS bf16x8*)(vvt + (g * 128 + c * 16 + fr) * VVT_LD + qc * 32 + fq * 8);
                    acc[c] = mfma16(af, wf, acc[c]);
                }
            }
            const float bs = P.in[14][g * 128 + pp];
            const bf16_t* up = proj + ((size_t)tok0 + pl) * PROJ_LD + 2048 + g * 128 + fq * 4;
            bf16_t* yp = Y + ((size_t)tok0 + pl) * DM + 1024 + g * 128 + fq * 4;
#pragma unroll
            for (int c = 0; c < 8; ++c) { const u32x2 uw = *(const u32x2*)(up + c * 16);
                u32x2 w; w.x = pk2(bflo(uw.x) * (acc[c].x + bs), bfhi(uw.x) * (acc[c].y + bs)); w.y = pk2(bflo(uw.y) * (acc[c].z + bs), bfhi(uw.y) * (acc[c].w + bs));
                *(u32x2*)(yp + c * 16) = w; }
        }
    }
    for (int rep = 0; rep < P5_REP_NA; ++rep) {
        P5_LAUNDER();
        const int hh = wave & 3, qp = wave >> 2, qbA = 2 * qp, qbB = 2 * qp + 1;
        const int w0A = qp == 0 ? 0 : 24, w0B = qp == 0 ? 8 : 32;
        const unsigned kgo = (unsigned)((tid >> 6) * PROJ_LD + (tid & 63) * 8) * 2u, vgo = (unsigned)((tid >> 3) * VT_LD + (tid & 7) * 8) * 2u;
        const unsigned klo = (unsigned)((((tid >> 4) & 3) * 64 + (tid >> 6)) * KSTR + (tid & 15) * 16), vlo = (unsigned)((tid >> 3) * VSTR_NA + (tid & 7) * 16);
#pragma unroll 1
        for (int hg = 0; hg < 2; ++hg) {
            const int h = hg * 4 + hh;
            bf16x8 qfA[4], qfB[4];
            { const bf16_t* qa = proj + ((size_t)tok0 + qbA * 16 + fr) * PROJ_LD + h * 128 + fq * 8; const bf16_t* qb_ = qa + (size_t)16 * PROJ_LD;
#pragma unroll
              for (int dc = 0; dc < 4; ++dc) { qfA[dc] = *(const bf16x8*)(qa + dc * 32); qfB[dc] = *(const bf16x8*)(qb_ + dc * 32); } }
            f32x4 oA[8], oB[8]; float mA, lA, mB, lB; attn_init(oA, mA, lA); attn_init(oB, mB, lB);
#pragma unroll 1
            for (int i = 0; i < 8; ++i) {
                const size_t ktok = (size_t)b * SEQ + (rs + i) * 64;
                const char* kg = (const char*)(proj + ktok * PROJ_LD + 1024 + hg * 512); const char* vg = (const char*)(vt + (size_t)(hg * 512) * VT_LD + ktok);
                u32x4 tk[8];
#pragma unroll
                for (int j = 0; j < 8; ++j) tk[j] = *(const u32x4*)(kg + (size_t)j * (8 * PROJ_LD * 2) + kgo);
                __syncthreads();
#pragma unroll
                for (int j = 0; j < 8; ++j) *(LAS u32x4*)(lds + klo + j * (8 * KSTR)) = tk[j];
                __builtin_amdgcn_sched_barrier(0);
#pragma unroll
                for (int j = 0; j < 8; ++j) tk[j] = *(const u32x4*)(vg + (size_t)j * (64 * VT_LD * 2) + vgo);
#pragma unroll
                for (int j = 0; j < 8; ++j) *(LAS u32x4*)(lds + KT_BYTES + vlo + j * (64 * VSTR_NA)) = tk[j];
                __syncthreads();
                const LAS float* br = rpb + h * 465 + (rs - r + 7 + i) * 31;
                attn_row<true>(oA, mA, lA, qfA, lds + (hh * 64 + w0A + fr) * KSTR + fq * 16, lds + KT_BYTES + (hh * 128 + fr) * VSTR_NA + (w0A + fq * 4) * 2, VSTR_NA, br, qbA * 16 + fr, w0A + fq * 4);
                __builtin_amdgcn_sched_barrier(0);
                attn_row<true>(oB, mB, lB, qfB, lds + (hh * 64 + w0B + fr) * KSTR + fq * 16, lds + KT_BYTES + (hh * 128 + fr) * VSTR_NA + (w0B + fq * 4) * 2, VSTR_NA, br, qbB * 16 + fr, w0B + fq * 4);
                __builtin_amdgcn_sched_barrier(0);
            }
            attn_finish(oA, lA, Y + ((size_t)tok0 + qbA * 16 + fr) * DM + h * 128 + fq * 4);
            attn_finish(oB, lB, Y + ((size_t)tok0 + qbB * 16 + fr) * DM + h * 128 + fq * 4);
        }
    }
    for (int rep = 0; rep < P5_REP_MEM; ++rep) {
        P5_LAUNDER();
        const int hh = wave & 1, qb = wave >> 1;
        const unsigned kgo = (unsigned)((tid >> 5) * 512 + (tid & 31) * 8) * 2u, vgo = (unsigned)((tid >> 4) * 1024 + (tid & 15) * 8) * 2u;
        const unsigned klo = (unsigned)((((tid >> 4) & 1) * 128 + (tid >> 5)) * KSTR + (tid & 15) * 16), vlo = (unsigned)((tid >> 4) * VSTR_MEM + (tid & 15) * 16);
#pragma unroll 1
        for (int hp = 0; hp < 2; ++hp) {
            const int hm = hp * 2 + hh;
            bf16x8 qf[4];
            { const bf16_t* qa = proj + ((size_t)tok0 + qb * 16 + fr) * PROJ_LD + 2560 + hm * 128 + fq * 8;
#pragma unroll
              for (int dc = 0; dc < 4; ++dc) qf[dc] = *(const bf16x8*)(qa + dc * 32); }
            f32x4 o[8]; float m, l; attn_init(o, m, l);
#pragma unroll 1
            for (int kh = 0; kh < 2; ++kh) {
                const char* kg = (const char*)(km + (size_t)(b * 256 + kh * 128) * 512 + hp * 256); const char* vg = (const char*)(vmt + (size_t)(hp * 256) * 1024 + b * 256 + kh * 128);
                u32x4 tk[8];
#pragma unroll
                for (int j = 0; j < 8; ++j) tk[j] = *(const u32x4*)(kg + (size_t)j * (16 * 512 * 2) + kgo);
                __syncthreads();
#pragma unroll
                for (int j = 0; j < 8; ++j) *(LAS u32x4*)(lds + klo + j * (16 * KSTR)) = tk[j];
                __builtin_amdgcn_sched_barrier(0);
#pragma unroll
                for (int j = 0; j < 8; ++j) tk[j] = *(const u32x4*)(vg + (size_t)j * (32 * 1024 * 2) + vgo);
#pragma unroll
                for (int j = 0; j < 8; ++j) *(LAS u32x4*)(lds + KT_BYTES + vlo + j * (32 * VSTR_MEM)) = tk[j];
                __syncthreads();
#pragma unroll 1
                for (int rr = 0; rr < 4; ++rr)
                    attn_row<false>(o, m, l, qf, lds + (hh * 128 + rr * 32 + fr) * KSTR + fq * 16, lds + KT_BYTES + (hh * 128 + fr) * VSTR_MEM + (rr * 32 + fq * 4) * 2, VSTR_MEM, rpb, 0, 0);
            }
            attn_finish(o, l, Y + ((size_t)tok0 + qb * 16 + fr) * DM + 1536 + hm * 128 + fq * 4);
        }
    }
    __threadfence(); __syncthreads(); __threadfence();
    P5_LAUNDER(); (void)fr; (void)fq;
    for (int t = wave; t < 64; t += 8) rescale_row(Y + ((size_t)tok0 + t) * DM, P.in[15], P.in[16], P.in[17], lane);
}

__device__ __forceinline__ void naive_p5(const Ptrs& P, int gw, int ngw, int lane) {
    const bf16_t* proj = (const bf16_t*)(P.ws + WS_PROJ); const bf16_t* vt = (const bf16_t*)(P.ws + WS_VT);
    const bf16_t* km = (const bf16_t*)(P.ws + WS_KM); const bf16_t* vmt = (const bf16_t*)(P.ws + WS_VMT);
    bf16_t* Y = (bf16_t*)(P.ws + WS_XN);
    for (int task = gw; task < MTOK * 16; task += ngw) {
        const int t = task >> 4, sub = task & 15, b = t / SEQ, pos = t % SEQ;
        if (sub < 12) {
            const bool na = sub < 8; const int h = na ? sub : sub - 8;
            const unsigned qw = *(const unsigned*)(proj + (size_t)t * PROJ_LD + (na ? 0 : 2560) + h * 128 + 2 * lane);
            const float q0 = bflo(qw), q1 = bfhi(qw);
            const int r = pos >> 6, c = pos & 63, rs = min(max(r - 4, 0), 56), cs = min(max(c - 8, 0), 48);
            float m = -3.0e38f, l = 0.f, o0 = 0.f, o1 = 0.f;
            const int nk = na ? 128 : 256;
            for (int kk = 0; kk < nk; ++kk) {
                float bias = 0.f; size_t koff, voff;
                if (na) { const int kr = rs + (kk >> 4), kc = cs + (kk & 15), kt = b * SEQ + kr * 64 + kc;
                    koff = (size_t)kt * PROJ_LD + 1024 + h * 128 + 2 * lane; voff = (size_t)(h * 128 + 2 * lane) * VT_LD + kt;
                    bias = P.in[10][(h * 15 + (kr - r + 7)) * 31 + min(max(kc - c, -15), 15) + 15] * LOG2E;
                } else { koff = (size_t)(b * 256 + kk) * 512 + h * 128 + 2 * lane; voff = (size_t)(h * 128 + 2 * lane) * 1024 + b * 256 + kk; }
                const unsigned kw = *(const unsigned*)((na ? proj : km) + koff);
                const float s = wave_sum(q0 * bflo(kw) + q1 * bfhi(kw)) + bias;
                const bf16_t* vb = na ? vt : vmt; const int vl = na ? VT_LD : 1024;
                const float v0 = bf1(vb[voff]), v1 = bf1(vb[voff + vl]);
                const float mn = fmaxf(m, s), al = fexp2(m - mn), p = fexp2(s - mn); m = mn;
                l = l * al + p; o0 = o0 * al + p * v0; o1 = o1 * al + p * v1;
            }
            const float inv = 1.0f / l;
            *(unsigned*)(Y + (size_t)t * DM + (na ? 0 : 1536) + h * 128 + 2 * lane) = pk2(o0 * inv, o1 * inv);
        } else {
            const int g = sub - 12, p = pos & 127, ctok = t - p;
            float a0 = 0.f, a1 = 0.f;
            const float lg0 = P.in[11][g * 128 + 2 * lane], lg1 = P.in[11][g * 128 + 2 * lane + 1], lb0 = P.in[12][g * 128 + 2 * lane], lb1 = P.in[12][g * 128 + 2 * lane + 1];
            for (int q = 0; q < 128; ++q) {
                const float x0 = bf1(vt[(size_t)(1024 + g * 128 + 2 * lane) * VT_LD + ctok + q]), x1 = bf1(vt[(size_t)(1024 + g * 128 + 2 * lane + 1) * VT_LD + ctok + q]);
                const float mu = wave_sum(x0 + x1) * (1.0f / 128), d0 = x0 - mu, d1 = x1 - mu;
                const float rstd = rsqrtf(wave_sum(d0 * d0 + d1 * d1) * (1.0f / 128) + EPS);
                const float w = P.in[13][(size_t)(g * 128 + p) * 128 + q];
                a0 += w * (d0 * rstd * lg0 + lb0); a1 += w * (d1 * rstd * lg1 + lb1);
            }
            const float bs = P.in[14][g * 128 + p];
            const unsigned uw = *(const unsigned*)(proj + (size_t)t * PROJ_LD + 2048 + g * 128 + 2 * lane);
            *(unsigned*)(Y + (size_t)t * DM + 1024 + g * 128 + 2 * lane) = pk2(bflo(uw) * (a0 + bs), bfhi(uw) * (a1 + bs));
        }
    }
}

struct Args { const float* in[25]; float* out; unsigned char* ws; int ph_lo, ph_hi; };

__global__ void __launch_bounds__(512, 2) fwd_kernel(Args a) {
    extern __shared__ __attribute__((aligned(16))) unsigned char smem[];
    LAS unsigned char* lds = (LAS unsigned char*)smem;
    cg::grid_group grid = cg::this_grid();
    const int tid0 = threadIdx.x;
    const int G = gridDim.x, bid = blockIdx.x, ngw = G * 8;
    Ptrs P;
#pragma unroll
    for (int i = 0; i < 25; ++i) P.in[i] = a.in[i];
    P.out = a.out; P.ws = a.ws;
    unsigned char* ws = a.ws;
    bf16_t* XN = (bf16_t*)(ws + WS_XN); bf16_t* H = (bf16_t*)(ws + WS_H); bf16_t* F = (bf16_t*)(ws + WS_F);

    int probe_rep = 0;
    if (PROBE_PH == 99) for (int i = 0; i < PROBE_N; ++i) grid.sync();
    for (int ph = a.ph_lo; ph < a.ph_hi; ++ph) {
        if (ph == 6 && !NAIVE_P5) continue;
        int tid = tid0; asm volatile("" : "+v"(tid));
        const int lane = tid & 63, wave = __builtin_amdgcn_readfirstlane(tid >> 6), gw = bid * 8 + wave;
        const bool is_gemm = (ph == 1 || ph == 2 || ph == 4 || ph == 7 || ph == 9 || ph == 10);
        if (is_gemm) {
            pg8::GP p; p.K = DM; p.G = G; p.c = bid; p.mode = 1; p.ld = DM; p.out = F; p.nM0 = 64; p.nN0 = 8; p.total = 512;
            p.proj = (bf16_t*)(ws + WS_PROJ); p.vt = (bf16_t*)(ws + WS_VT); p.km = (bf16_t*)(ws + WS_KM); p.vmt = (bf16_t*)(ws + WS_VMT);
            const bf16_t* win = (const bf16_t*)(ws + WS_WIN); const bf16_t* wmkv = (const bf16_t*)(ws + WS_WMKV); const bf16_t* memn = (const bf16_t*)(ws + WS_MEMN);
            p.A0 = XN; p.B0 = (const bf16_t*)(ws + WS_WOUT);
            p.A1 = win + (size_t)3072 * DM; p.B1 = XN; p.A2 = memn; p.B2 = wmkv; p.A3 = wmkv + (size_t)512 * DM; p.B3 = memn;
            if (ph == 1 || ph == 9) { p.B0 = (const bf16_t*)(ws + (ph == 1 ? WS_WGU1 : WS_WGU2)); p.nN0 = 44; p.total = 64 * 44; p.mode = 0; p.out = H; }
            else if (ph == 2 || ph == 10) { p.A0 = H; p.B0 = (const bf16_t*)(ws + (ph == 2 ? WS_WD1 : WS_WD2)); p.K = DFF; }
            else if (ph == 4) { p.B0 = win; p.nN0 = 12; p.total = 1168; p.mode = 2; }
#if NAIVE_GEMM
            if (p.mode == 0) simple_gemm_swiglu(p.A0, p.B0, H, gw, ngw, lane);
            else {
                simple_gemm_job(p.A0, p.B0, p.nM0 * 256, p.nN0 * 256, p.K, 0, p.proj, p.vt, p.km, p.vmt, p.mode, p.out, p.ld, gw, ngw, lane);
                if (p.mode == 2) {
                    simple_gemm_job(p.A1, p.B1, 6 * 256, 64 * 256, p.K, 1, p.proj, p.vt, p.km, p.vmt, 2, p.out, p.ld, gw, ngw, lane);
                    simple_gemm_job(p.A2, p.B2, 4 * 256, 2 * 256, p.K, 2, p.proj, p.vt, p.km, p.vmt, 2, p.out, p.ld, gw, ngw, lane);
                    simple_gemm_job(p.A3, p.B3, 2 * 256, 4 * 256, p.K, 3, p.proj, p.vt, p.km, p.vmt, 2, p.out, p.ld, gw, ngw, lane);
                }
            }
#else
            pg8::gemm_phase(lds, p, tid);
#endif
        } else if (ph == 0) {
            LAS float* scr = (LAS float*)(lds + wave * (64 * 65 * 4));
            constexpr int I_GU = 32 * 176, I_D = 88 * 32, I_IN = 32 * 72, I_MKV = 32 * 16, I_OUT = 32 * 32;
            constexpr int NITEMS = 2 * I_GU + 2 * I_D + I_IN + I_MKV + I_OUT;
            for (int it = gw; it < NITEMS; it += ngw) {
                int r = it;
                if (r < I_GU) { const int nb = r % 176; transpose_item(P.in[3], DM, NGU, (bf16_t*)(ws + WS_WGU1), r / 176, nb, map_gu(nb), scr, lane); continue; } r -= I_GU;
                if (r < I_GU) { const int nb = r % 176; transpose_item(P.in[21], DM, NGU, (bf16_t*)(ws + WS_WGU2), r / 176, nb, map_gu(nb), scr, lane); continue; } r -= I_GU;
                if (r < I_D) { const int nb = r % 32; transpose_item(P.in[4], DFF, DM, (bf16_t*)(ws + WS_WD1), r / 32, nb, nb * 64, scr, lane); continue; } r -= I_D;
                if (r < I_D) { const int nb = r % 32; transpose_item(P.in[22], DFF, DM, (bf16_t*)(ws + WS_WD2), r / 32, nb, nb * 64, scr, lane); continue; } r -= I_D;
                if (r < I_IN) { const int nb = r % 72; transpose_item(P.in[8], DM, 4608, (bf16_t*)(ws + WS_WIN), r / 72, nb, map_win(nb), scr, lane); continue; } r -= I_IN;
                if (r < I_MKV) { const int nb = r % 16; transpose_item(P.in[9], DM, 1024, (bf16_t*)(ws + WS_WMKV), r / 16, nb, nb * 64, scr, lane); continue; } r -= I_MKV;
                { const int nb = r % 32; transpose_item(P.in[18], DM, DM, (bf16_t*)(ws + WS_WOUT), r / 32, nb, nb * 64, scr, lane); }
            }
            for (int i = gw * 64 + lane; i < 4 * 128 * 128 / 2; i += ngw * 64) { const float2 v = *(const float2*)(P.in[13] + 2 * i); ((unsigned*)(ws + WS_WSB))[i] = pk2(v.x, v.y); }
            for (int m = gw; m < MTOK; m += ngw) norm_row_bf16(P.in[0] + (size_t)m * DM, P.in[2], XN + (size_t)m * DM, lane);
            for (int m = gw; m < 1024; m += ngw) norm_row_bf16(P.in[1] + (size_t)m * DM, P.in[7], (bf16_t*)(ws + WS_MEMN) + (size_t)m * DM, lane);
        } else if (ph == 3) {
            for (int m = gw; m < MTOK; m += ngw) resid_row<false>(F + (size_t)m * DM, P.in[0] + (size_t)m * DM, P.out + (size_t)m * DM, P.in[5], 0.5f, P.in[6], XN + (size_t)m * DM, nullptr, lane);
        } else if (ph == 8) {
            for (int m = gw; m < MTOK; m += ngw) resid_row<false>(F + (size_t)m * DM, P.out + (size_t)m * DM, P.out + (size_t)m * DM, P.in[19], 1.0f, P.in[20], XN + (size_t)m * DM, nullptr, lane);
        } else if (ph == 11) {
            for (int m = gw; m < MTOK; m += ngw) resid_row<true>(F + (size_t)m * DM, P.out + (size_t)m * DM, nullptr, P.in[23], 0.5f, P.in[24], nullptr, P.out + (size_t)m * DM, lane);
        } else if (ph == 5) {
#if NAIVE_P5
            naive_p5(P, gw, ngw, lane);
#else
            for (int u = bid; u < 256; u += G) p5_unit(P, lds, u, tid, wave);
#endif
        } else if (ph == 6) {
            for (int m = gw; m < MTOK; m += ngw) rescale_row(XN + (size_t)m * DM, P.in[15], P.in[16], P.in[17], lane);
        }
        if (ph + 1 < a.ph_hi) grid.sync();
        if (ph == PROBE_PH && probe_rep < PROBE_N) { ++probe_rep; --ph; }
    }
}

extern "C" void kernel_launch(void* const* d_in, const int* in_sizes, int n_in, void* d_out, int out_size, void* d_ws, size_t ws_size, hipStream_t stream) {
    static int grid = 0;
    if (grid == 0) {
        if (n_in != 25 || out_size != MTOK * DM || ws_size < WS_END) { fprintf(stderr, "kernel_launch: unexpected problem (n_in %d, out %d, ws %zu < %zu)\n", n_in, out_size, ws_size, (size_t)WS_END); grid = -1; return; }
        int dev = 0, cus = 0, per_cu = 0;
        (void)hipGetDevice(&dev);
        (void)hipDeviceGetAttribute(&cus, hipDeviceAttributeMultiprocessorCount, dev);
        (void)hipFuncSetAttribute((const void*)fwd_kernel, hipFuncAttributeMaxDynamicSharedMemorySize, LDS_BYTES);
        (void)hipOccupancyMaxActiveBlocksPerMultiprocessor(&per_cu, (const void*)fwd_kernel, 512, LDS_BYTES);
        if (per_cu < 1) { fprintf(stderr, "kernel_launch: occupancy query says %d blocks per CU\n", per_cu); per_cu = 1; }
        grid = cus * 1;
        (void)hipGetLastError();
    }
    if (grid < 0) return;
    Args a{};
    for (int i = 0; i < 25; ++i) a.in[i] = (const float*)d_in[i];
    a.out = (float*)d_out; a.ws = (unsigned char*)d_ws;
#if MULTI_LAUNCH
    for (int ph = 0; ph < NPHASE; ++ph) {
        if (ph == 6 && !NAIVE_P5) continue;
        a.ph_lo = ph; a.ph_hi = ph + 1;
        hipLaunchKernelGGL(fwd_kernel, dim3(grid), dim3(512), LDS_BYTES, stream, a);
    }
#else
    a.ph_lo = 0; a.ph_hi = NPHASE;
    void* args[] = {&a};
    hipError_t e = hipLaunchCooperativeKernel((const void*)fwd_kernel, dim3(grid), dim3(512), args, LDS_BYTES, stream);
    if (e != hipSuccess) fprintf(stderr, "cooperative launch failed: %s (grid %d)\n", hipGetErrorString(e), grid);
#endif
}
```

```cpp
#include <hip/hip_runtime.h>
#include <hip/hip_cooperative_groups.h>
#include <cstdio>
namespace cg = cooperative_groups;

#ifndef MULTI_LAUNCH
#define MULTI_LAUNCH 0
#endif
#ifndef NAIVE_GEMM
#define NAIVE_GEMM 0
#endif
#ifndef NAIVE_P5
#define NAIVE_P5 0
#endif

#ifndef PROBE_PH
#define PROBE_PH (-1)
#define PROBE_N 0
#endif

#ifndef P5_REP_PRE
#define P5_REP_PRE 1
#define P5_REP_NA 1
#define P5_REP_MEM 1
#define P5_REP_SG 1
#endif
#define LAS __attribute__((address_space(3)))
typedef unsigned short bf16_t;
typedef short bf16x8 __attribute__((ext_vector_type(8)));
typedef float f32x4 __attribute__((ext_vector_type(4)));
typedef unsigned u32x4 __attribute__((ext_vector_type(4)));
typedef unsigned u32x2 __attribute__((ext_vector_type(2)));

constexpr int MTOK = 16384, DM = 2048, DFF = 5632, NGU = 11264, SEQ = 4096;
constexpr int PROJ_LD = 3072, VT_LD = 16384;
constexpr float EPS = 1e-6f;
constexpr float LOG2E = 1.4426950408889634f;
constexpr float QSCALE = 0.08838834764831845f * LOG2E;
constexpr int NPHASE = 12;
constexpr int LDS_BYTES = 156 * 1024;

constexpr size_t WS_WGU1 = 0;
constexpr size_t WS_WD1 = WS_WGU1 + (size_t)NGU * DM * 2;
constexpr size_t WS_WIN = WS_WD1 + (size_t)DM * DFF * 2;
constexpr size_t WS_WMKV = WS_WIN + (size_t)4608 * DM * 2;
constexpr size_t WS_WOUT = WS_WMKV + (size_t)1024 * DM * 2;
constexpr size_t WS_WGU2 = WS_WOUT + (size_t)DM * DM * 2;
constexpr size_t WS_WD2 = WS_WGU2 + (size_t)NGU * DM * 2;
constexpr size_t WS_WSB = WS_WD2 + (size_t)DM * DFF * 2;
constexpr size_t WS_MEMN = WS_WSB + (size_t)4 * 128 * 128 * 2;
constexpr size_t WS_KM = WS_MEMN + (size_t)1024 * DM * 2;
constexpr size_t WS_VMT = WS_KM + (size_t)1024 * 512 * 2;
constexpr size_t WS_XN = WS_VMT + (size_t)512 * 1024 * 2;
constexpr size_t WS_H = WS_XN + (size_t)MTOK * DM * 2;
constexpr size_t WS_PROJ = WS_H;
constexpr size_t WS_VT = WS_H + (size_t)MTOK * PROJ_LD * 2;
constexpr size_t WS_F = WS_H + (size_t)MTOK * DFF * 2;
constexpr size_t WS_END = WS_F + (size_t)MTOK * DM * 2;
static_assert(WS_VT + (size_t)1536 * VT_LD * 2 <= WS_F, "overlay");
constexpr size_t WS_BAR = WS_END;
constexpr size_t WS_TOTAL = WS_BAR + 16384;
static_assert(WS_TOTAL <= (size_t)536870912, "workspace");

__device__ __forceinline__ unsigned pk2(float lo, float hi) { unsigned r; asm("v_cvt_pk_bf16_f32 %0, %1, %2" : "=v"(r) : "v"(lo), "v"(hi)); return r; }
__device__ __forceinline__ float bflo(unsigned u) { return __uint_as_float(u << 16); }
__device__ __forceinline__ float bfhi(unsigned u) { return __uint_as_float(u & 0xffff0000u); }
__device__ __forceinline__ float bf1(bf16_t b) { return __uint_as_float(((unsigned)b) << 16); }
__device__ __forceinline__ float wave_sum(float v) {
#pragma unroll
    for (int o = 1; o < 64; o <<= 1) v += __shfl_xor(v, o);
    return v;
}
__device__ __forceinline__ float fexp2(float x) { return __builtin_amdgcn_exp2f(x); }
__device__ __forceinline__ float frcp(float x) { return __builtin_amdgcn_rcpf(x); }
__device__ __forceinline__ float gelu_tanh(float x) {
    const float t = x * (1.0f + 0.044715f * x * x);
    return x * frcp(1.0f + fexp2(t * (-2.0f * 0.7978845608028654f * LOG2E)));
}
__device__ __forceinline__ float silu_mul(float g, float u) { return g * frcp(1.0f + fexp2(g * (-LOG2E))) * u; }
__device__ __forceinline__ f32x4 mfma16(bf16x8 a, bf16x8 b, f32x4 c) { return __builtin_amdgcn_mfma_f32_16x16x32_bf16(a, b, c, 0, 0, 0); }

struct OutBf {
    bf16_t* base; int ld; int act; float sc;
    __device__ __forceinline__ f32x4 xf(f32x4 v) const {
        v = v * sc;
        if (act) { v.x = gelu_tanh(v.x); v.y = gelu_tanh(v.y); v.z = gelu_tanh(v.z); v.w = gelu_tanh(v.w); }
        return v;
    }
    __device__ __forceinline__ void st4(int row, int col, f32x4 v) const {
        v = xf(v); u32x2 w; w.x = pk2(v.x, v.y); w.y = pk2(v.z, v.w);
        *(u32x2*)(base + (size_t)row * ld + col) = w;
    }
    __device__ __forceinline__ void st8(int row, int col, f32x4 a, f32x4 b) const {
        a = xf(a); b = xf(b); u32x4 w; w.x = pk2(a.x, a.y); w.y = pk2(a.z, a.w); w.z = pk2(b.x, b.y); w.w = pk2(b.z, b.w);
        *(u32x4*)(base + (size_t)row * ld + col) = w;
    }
};
__device__ __forceinline__ OutBf p4_sel(int job, int pm, int pn, bf16_t* proj, bf16_t* vt, bf16_t* km, bf16_t* vmt) {
    OutBf o; o.act = 0; o.sc = 1.0f; o.base = proj; o.ld = PROJ_LD;
    if (job == 0) { if (pn < 4 || pn >= 10) o.sc = QSCALE; else if (pn >= 8) o.act = 1; }
    if (job == 1) { o.base = vt; o.ld = VT_LD; if (pm >= 4) o.act = 1; }
    if (job == 2) { o.base = km; o.ld = 512; }
    if (job == 3) { o.base = vmt; o.ld = 1024; }
    return o;
}

namespace pg8 {
constexpr int BM = 256, BK = 64, HALF = 128, HTB = HALF * BK * 2, STAGE_BYTES = 8 * HTB, NXCD = 8, WGM = 8;
__device__ __forceinline__ int lds_byte(int r, int c) { const int st = (r >> 4) * 2 + (c >> 5), rr = r & 15, cc = c & 31, ob = rr * 64 + cc * 2; return st * 1024 + (ob ^ (((ob >> 9) & 1) << 5)); }
__device__ __forceinline__ void stage_rc(int b, int& R, int& C) { const int st = b / 1024, sb = b % 1024, swz = sb ^ (((sb >> 9) & 1) << 5); R = (st >> 1) * 16 + swz / 64; C = (st & 1) * 32 + (swz % 64) / 2; }
__device__ __forceinline__ int perm32(int rho) { const int n = rho >> 4, i = rho & 15; return 8 * (i >> 2) + 4 * n + (i & 3); }

struct Unit { int pm, pn, job; const bf16_t* A; const bf16_t* B; };
struct GP {
    int K, G, c, mode, ld, nM0, nN0, total;
    bf16_t* out; const bf16_t *A0, *B0, *A1, *B1, *A2, *B2, *A3, *B3; bf16_t *proj, *vt, *km, *vmt;
};
__device__ __forceinline__ bool sched_next(int i, Unit& u, int G, int c, int total, int mode, int nM0, int nN0, const bf16_t* A0, const bf16_t* B0,
                                           const bf16_t* A1, const bf16_t* B1, const bf16_t* A2, const bf16_t* B2, const bf16_t* A3, const bf16_t* B3) {
    const int L = i * G + c; if (L >= total) return false;
    int job = 0, st = 0, nM = nM0, nN = nN0; const bf16_t* pa = A0; const bf16_t* pb = B0;
    if (mode == 2) {
        if (L >= 768) { job = 1; st = 768; nM = 6; nN = 64; pa = A1; pb = B1; }
        if (L >= 1152) { job = 2; st = 1152; nM = 4; nN = 2; pa = A2; pb = B2; }
        if (L >= 1160) { job = 3; st = 1160; nM = 2; nN = 4; pa = A3; pb = B3; }
    }
    int wgid = L - st; const int nwg = nM * nN;
    { const int q = nwg / NXCD, r = nwg % NXCD, xcd = wgid % NXCD, off = wgid / NXCD; wgid = (xcd < r ? xcd * (q + 1) : r * (q + 1) + (xcd - r) * q) + off; }
    const int nig = WGM * nN, gid = wgid / nig, fm = gid * WGM, gsz = (nM - fm) < WGM ? (nM - fm) : WGM;
    u.pm = fm + ((wgid % nig) % gsz); u.pn = (wgid % nig) / gsz; u.job = job; u.A = pa; u.B = pb; return true;
}
__device__ __forceinline__ void epilogue(const f32x4 (&acc)[2][2][4][2], const Unit& u, int wr, int wc, int fr, int fq, int mode, bf16_t* out, int ld, bf16_t* proj, bf16_t* vt, bf16_t* km, bf16_t* vmt) {
    const int row0 = u.pm * BM + wr * 64 + fr, cb = wc * 32 + 8 * fq;
    if (mode == 0) {
#pragma unroll
        for (int ai = 0; ai < 2; ++ai)
#pragma unroll
            for (int m = 0; m < 4; ++m) {
                const f32x4 g0 = acc[ai][0][m][0], g1 = acc[ai][0][m][1], u0 = acc[ai][1][m][0], u1 = acc[ai][1][m][1];
                u32x4 w;
                w.x = pk2(silu_mul(g0.x, u0.x), silu_mul(g0.y, u0.y)); w.y = pk2(silu_mul(g0.z, u0.z), silu_mul(g0.w, u0.w));
                w.z = pk2(silu_mul(g1.x, u1.x), silu_mul(g1.y, u1.y)); w.w = pk2(silu_mul(g1.z, u1.z), silu_mul(g1.w, u1.w));
                *(u32x4*)(out + (size_t)(row0 + ai * HALF + m * 16) * DFF + u.pn * 128 + cb) = w;
            }
    } else {
        OutBf o; o.base = out; o.ld = ld; o.act = 0; o.sc = 1.0f;
        if (mode == 2) o = p4_sel(u.job, u.pm, u.pn, proj, vt, km, vmt);
#pragma unroll
        for (int ai = 0; ai < 2; ++ai)
#pragma unroll
            for (int m = 0; m < 4; ++m)
#pragma unroll
                for (int bj = 0; bj < 2; ++bj)
                    o.st8(row0 + ai * HALF + m * 16, u.pn * BM + bj * HALF + cb, acc[ai][bj][m][0], acc[ai][bj][m][1]);
    }
}

__device__ __forceinline__ void gemm_phase(LAS unsigned char* lds, const GP p, const int tid) {
    const int K = p.K; const size_t tstep = (size_t)256 * K * 2;
#define SNEXT(i, u) sched_next(i, u, p.G, p.c, p.total, p.mode, p.nM0, p.nN0, p.A0, p.B0, p.A1, p.B1, p.A2, p.B2, p.A3, p.B3)
#define APTR(u) ((const char*)(u).A + (size_t)(u).pm * tstep)
#define BPTR(u) ((const char*)(u).B + (size_t)(u).pn * tstep)
    const int wid = __builtin_amdgcn_readfirstlane(tid >> 6), lane = tid & 63, wr = wid >> 2, wc = wid & 3, fr = lane & 15, fq = lane >> 4;
    const int nt = K / BK;
    unsigned voffA[2], voffB[2];
#pragma unroll
    for (int i = 0; i < 2; ++i) { int R, C; stage_rc(tid * 16 + i * 8192, R, C); const int Rb = (R & ~31) + perm32(R & 31);
        voffA[i] = (unsigned)(R * K + C) * 2u; voffB[i] = (unsigned)(Rb * K + C) * 2u; }
    const size_t kstep = (size_t)(BK * 2);
    const size_t hstep = (size_t)HALF * K * 2;
    const unsigned ldsw = (unsigned)wid * 1024u;
    const int aoff = lds_byte(wr * 64 + fr, fq * 8), boff = lds_byte(wc * 32 + fr, fq * 8);
#define PG8_SA(b, h) (((b) * 2 + (h)) * HTB)
#define PG8_SB(b, h) ((4 + (b) * 2 + (h)) * HTB)
#define PG8_STAGE(bufoff, gbase, voff) do { _Pragma("unroll") for (int _i = 0; _i < 2; ++_i) \
        __builtin_amdgcn_global_load_lds((const unsigned*)((const char*)(gbase) + (voff)[_i]), (LAS unsigned*)(lds + (bufoff) + ldsw + _i * 8192), 16, 0, 0); } while (0)
#define PG8_LDA(dst, b, h) do { _Pragma("unroll") for (int m = 0; m < 4; ++m) _Pragma("unroll") for (int k = 0; k < 2; ++k) dst[m][k] = *(const LAS bf16x8*)(lds + PG8_SA(b, h) + aoff + m * 2048 + k * 1024); } while (0)
#define PG8_LDB(dst, b, h) do { _Pragma("unroll") for (int n = 0; n < 2; ++n) _Pragma("unroll") for (int k = 0; k < 2; ++k) dst[n][k] = *(const LAS bf16x8*)(lds + PG8_SB(b, h) + boff + n * 2048 + k * 1024); } while (0)
#define PG8_MMA(ai, bj, At, Bt) do { __builtin_amdgcn_s_setprio(1); _Pragma("unroll") for (int m = 0; m < 4; ++m) _Pragma("unroll") for (int n = 0; n < 2; ++n) _Pragma("unroll") for (int k = 0; k < 2; ++k) \
        acc[ai][bj][m][n] = __builtin_amdgcn_mfma_f32_16x16x32_bf16(Bt[n][k], At[m][k], acc[ai][bj][m][n], 0, 0, 0); __builtin_amdgcn_s_setprio(0); } while (0)
#define PG8_WAIT_V(n) asm volatile("s_waitcnt vmcnt(" #n ")" ::: "memory")
#define PG8_WAIT_L(n) asm volatile("s_waitcnt lgkmcnt(" #n ")" ::: "memory")
#define PG8_BAR __builtin_amdgcn_s_barrier()
#define PG8_SCHED __builtin_amdgcn_sched_barrier(0)
    Unit cur, nxt; int ui = 0;
    if (!SNEXT(0, cur)) return;
    f32x4 acc[2][2][4][2];
#pragma unroll
    for (int a = 0; a < 2; ++a)
#pragma unroll
        for (int b = 0; b < 2; ++b)
#pragma unroll
            for (int m = 0; m < 4; ++m)
#pragma unroll
                for (int n = 0; n < 2; ++n) acc[a][b][m][n] = (f32x4){0.f, 0.f, 0.f, 0.f};
    bf16x8 At[4][2], B0[2][2], B1[2][2];
    const char* cA = APTR(cur); const char* cB = BPTR(cur);
    PG8_STAGE(PG8_SB(0, 0), cB, voffB); PG8_STAGE(PG8_SB(0, 1), cB + hstep, voffB); PG8_STAGE(PG8_SA(0, 0), cA, voffA); PG8_STAGE(PG8_SA(0, 1), cA + hstep, voffA);
    if (wr == 1) PG8_BAR;
    PG8_WAIT_V(2); PG8_BAR;
    PG8_STAGE(PG8_SB(1, 0), cB + kstep, voffB); PG8_STAGE(PG8_SA(1, 0), cA + kstep, voffA); PG8_STAGE(PG8_SB(1, 1), cB + hstep + kstep, voffB);
    PG8_WAIT_V(6); PG8_BAR;
    for (;;) {
        const bool has_next = SNEXT(ui + 1, nxt);
        const char* nA = has_next ? APTR(nxt) : cA; const char* nB = has_next ? BPTR(nxt) : cB;
        for (int t = 0; t < nt; t += 2) {
            const bool last = (t == nt - 2);
            const char* a1 = cA + (size_t)(t + 1) * kstep;
            const char* a2 = last ? nA : cA + (size_t)(t + 2) * kstep; const char* b2 = last ? nB : cB + (size_t)(t + 2) * kstep;
            const char* a3 = a2 + kstep; const char* b3 = b2 + kstep;
            PG8_LDB(B0, 0, 0); PG8_LDB(B1, 0, 1); PG8_SCHED; PG8_LDA(At, 0, 0); PG8_STAGE(PG8_SA(1, 1), a1 + hstep, voffA);
            PG8_WAIT_V(8); PG8_WAIT_L(0); PG8_BAR; PG8_MMA(0, 0, At, B0); PG8_MMA(0, 1, At, B1); PG8_BAR; PG8_SCHED;
            PG8_LDA(At, 0, 1); PG8_STAGE(PG8_SB(0, 0), b2, voffB); PG8_STAGE(PG8_SB(0, 1), b2 + hstep, voffB); PG8_STAGE(PG8_SA(0, 0), a2, voffA);
            PG8_WAIT_V(8); PG8_WAIT_L(0); PG8_BAR; PG8_MMA(1, 0, At, B0); PG8_MMA(1, 1, At, B1); PG8_BAR; PG8_SCHED;
            PG8_LDB(B0, 1, 0); PG8_LDB(B1, 1, 1); PG8_SCHED; PG8_LDA(At, 1, 0); PG8_STAGE(PG8_SA(0, 1), a2 + hstep, voffA);
            PG8_WAIT_V(8); PG8_WAIT_L(0); PG8_BAR; PG8_MMA(0, 0, At, B0); PG8_MMA(0, 1, At, B1); PG8_BAR; PG8_SCHED;
            PG8_LDA(At, 1, 1); PG8_STAGE(PG8_SB(1, 0), b3, voffB); PG8_STAGE(PG8_SB(1, 1), b3 + hstep, voffB); PG8_STAGE(PG8_SA(1, 0), a3, voffA);
            PG8_WAIT_V(8); PG8_WAIT_L(0); PG8_BAR; PG8_MMA(1, 0, At, B0); PG8_MMA(1, 1, At, B1); PG8_BAR; PG8_SCHED;
        }
        if (wr == 0) PG8_BAR;
        epilogue(acc, cur, wr, wc, fr, fq, p.mode, p.out, p.ld, p.proj, p.vt, p.km, p.vmt);
        if (!has_next) break;
#pragma unroll
        for (int a = 0; a < 2; ++a)
#pragma unroll
            for (int b = 0; b < 2; ++b)
#pragma unroll
                for (int m = 0; m < 4; ++m)
#pragma unroll
                    for (int n = 0; n < 2; ++n) acc[a][b][m][n] = (f32x4){0.f, 0.f, 0.f, 0.f};
        cur = nxt; cA = nA; cB = nB; ++ui;
        if (wr == 1) PG8_BAR;
    }
    PG8_WAIT_V(0);
    PG8_BAR;
#undef SNEXT
#undef APTR
#undef BPTR
#undef PG8_SA
#undef PG8_SB
#undef PG8_STAGE
#undef PG8_LDA
#undef PG8_LDB
#undef PG8_MMA
#undef PG8_WAIT_V
#undef PG8_WAIT_L
#undef PG8_BAR
#undef PG8_SCHED
}
}

__device__ __forceinline__ void simple_gemm_job(const bf16_t* A, const bf16_t* Bt, int Mr, int Nc, int K, int job, bf16_t* proj, bf16_t* vt, bf16_t* km, bf16_t* vmt, int mode, bf16_t* out, int ld, int gw, int ngw, int lane) {
    const int fr = lane & 15, fq = lane >> 4, tn = Nc / 64, tiles = (Mr / 64) * tn;
    for (int t = gw; t < tiles; t += ngw) {
        const int row0 = (t / tn) * 64, col0 = (t % tn) * 64;
        f32x4 acc[4][4];
#pragma unroll
        for (int i = 0; i < 4; ++i)
#pragma unroll
            for (int j = 0; j < 4; ++j) acc[i][j] = (f32x4){0.f, 0.f, 0.f, 0.f};
        const bf16_t* ap = A + (size_t)(row0 + fr) * K + fq * 8; const bf16_t* bp = Bt + (size_t)(col0 + fr) * K + fq * 8;
        for (int k = 0; k < K; k += 32) {
            bf16x8 a[4], b[4];
#pragma unroll
            for (int i = 0; i < 4; ++i) { a[i] = *(const bf16x8*)(ap + (size_t)i * 16 * K + k); b[i] = *(const bf16x8*)(bp + (size_t)i * 16 * K + k); }
#pragma unroll
            for (int i = 0; i < 4; ++i)
#pragma unroll
                for (int j = 0; j < 4; ++j) acc[i][j] = mfma16(b[j], a[i], acc[i][j]);
        }
        OutBf o; o.base = out; o.ld = ld; o.act = 0; o.sc = 1.0f; if (mode == 2) o = p4_sel(job, row0 / 256, col0 / 256, proj, vt, km, vmt);
#pragma unroll
        for (int i = 0; i < 4; ++i)
#pragma unroll
            for (int j = 0; j < 4; ++j) o.st4(row0 + i * 16 + fr, col0 + j * 16 + fq * 4, acc[i][j]);
    }
}
__device__ __forceinline__ void simple_gemm_swiglu(const bf16_t* A, const bf16_t* Wt, bf16_t* H, int gw, int ngw, int lane) {
    const int fr = lane & 15, fq = lane >> 4, K = DM, tn = DFF / 32, tiles = (MTOK / 64) * tn;
    for (int t = gw; t < tiles; t += ngw) {
        const int row0 = (t / tn) * 64, h0 = (t % tn) * 32, wrow = 256 * (h0 >> 7) + (h0 & 127);
        f32x4 g[4][2], u[4][2];
#pragma unroll
        for (int i = 0; i < 4; ++i)
#pragma unroll
            for (int j = 0; j < 2; ++j) { g[i][j] = (f32x4){0.f, 0.f, 0.f, 0.f}; u[i][j] = (f32x4){0.f, 0.f, 0.f, 0.f}; }
        const bf16_t* ap = A + (size_t)(row0 + fr) * K + fq * 8; const bf16_t* bp = Wt + (size_t)(wrow + fr) * K + fq * 8;
        for (int k = 0; k < K; k += 32) {
            bf16x8 a[4], bg[2], bu[2];
#pragma unroll
            for (int i = 0; i < 4; ++i) a[i] = *(const bf16x8*)(ap + (size_t)i * 16 * K + k);
#pragma unroll
            for (int j = 0; j < 2; ++j) { bg[j] = *(const bf16x8*)(bp + (size_t)j * 16 * K + k); bu[j] = *(const bf16x8*)(bp + (size_t)(128 + j * 16) * K + k); }
#pragma unroll
            for (int i = 0; i < 4; ++i)
#pragma unroll
                for (int j = 0; j < 2; ++j) { g[i][j] = mfma16(bg[j], a[i], g[i][j]); u[i][j] = mfma16(bu[j], a[i], u[i][j]); }
        }
#pragma unroll
        for (int i = 0; i < 4; ++i)
#pragma unroll
            for (int j = 0; j < 2; ++j) {
                u32x2 w; w.x = pk2(silu_mul(g[i][j].x, u[i][j].x), silu_mul(g[i][j].y, u[i][j].y)); w.y = pk2(silu_mul(g[i][j].z, u[i][j].z), silu_mul(g[i][j].w, u[i][j].w));
                *(u32x2*)(H + (size_t)(row0 + i * 16 + fr) * DFF + h0 + j * 16 + fq * 4) = w;
            }
    }
}

__device__ __forceinline__ void transpose_item(const float* W, int K, int N, bf16_t* WT, int kb, int nbd, int src0, LAS float* scr, int lane) {
    const int k0 = kb * 64;
#pragma unroll 4
    for (int i = 0; i < 16; ++i) {
        const int kk = 4 * i + (lane >> 4);
        const f32x4 v = *(const f32x4*)(W + (size_t)(k0 + kk) * N + src0 + (lane & 15) * 4);
        LAS float* s = scr + kk * 65 + (lane & 15) * 4; s[0] = v.x; s[1] = v.y; s[2] = v.z; s[3] = v.w;
    }
    const int c = lane & 7;
#pragma unroll
    for (int jj = 0; jj < 8; ++jj) {
        const int n = (lane >> 3) + 8 * jj; const LAS float* s = scr + (8 * c) * 65 + n;
        u32x4 o; o.x = pk2(s[0], s[65]); o.y = pk2(s[2 * 65], s[3 * 65]); o.z = pk2(s[4 * 65], s[5 * 65]); o.w = pk2(s[6 * 65], s[7 * 65]);
        *(u32x4*)(WT + (size_t)(nbd * 64 + n) * K + k0 + 8 * c) = o;
    }
}
__device__ __forceinline__ int map_gu(int nb) { const int j = nb >> 2, part = nb & 3; return part < 2 ? 128 * j + 64 * part : DFF + 128 * j + 64 * (part - 2); }
__device__ __forceinline__ int map_win(int nb) { const int n = nb * 64; return n < 2048 ? n : n < 2560 ? n + 1024 : n < 3072 ? n + 1536 : n < 4096 ? n - 1024 : n - 512; }

__device__ __forceinline__ void norm_row_bf16(const float* xr, const float* g, bf16_t* o, int lane) {
    f32x4 v[8]; float s = 0.f;
#pragma unroll
    for (int j = 0; j < 8; ++j) { v[j] = *(const f32x4*)(xr + 256 * j + 4 * lane); s += (v[j].x * v[j].x + v[j].y * v[j].y) + (v[j].z * v[j].z + v[j].w * v[j].w); }
    const float rs = rsqrtf(wave_sum(s) * (1.0f / DM) + EPS);
#pragma unroll
    for (int j = 0; j < 8; ++j) { const f32x4 gv = *(const f32x4*)(g + 256 * j + 4 * lane);
        u32x2 w; w.x = pk2(v[j].x * rs * gv.x, v[j].y * rs * gv.y); w.y = pk2(v[j].z * rs * gv.z, v[j].w * rs * gv.w);
        *(u32x2*)(o + 256 * j + 4 * lane) = w; }
}
template <bool FINAL>
__device__ __forceinline__ void resid_row(const bf16_t* f, const float* hin, float* hout, const float* gpost, float alpha, const float* gnext, bf16_t* xn, float* fin, int lane) {
    f32x4 v[8]; float s = 0.f;
#pragma unroll
    for (int j = 0; j < 8; ++j) { const u32x2 w = *(const u32x2*)(f + 256 * j + 4 * lane); v[j] = (f32x4){bflo(w.x), bfhi(w.x), bflo(w.y), bfhi(w.y)};
        s += (v[j].x * v[j].x + v[j].y * v[j].y) + (v[j].z * v[j].z + v[j].w * v[j].w); }
    const float rs = rsqrtf(wave_sum(s) * (1.0f / DM) + EPS) * alpha;
    float s2 = 0.f;
#pragma unroll
    for (int j = 0; j < 8; ++j) { const f32x4 gv = *(const f32x4*)(gpost + 256 * j + 4 * lane); const f32x4 hv = *(const f32x4*)(hin + 256 * j + 4 * lane);
        v[j] = hv + v[j] * rs * gv; s2 += (v[j].x * v[j].x + v[j].y * v[j].y) + (v[j].z * v[j].z + v[j].w * v[j].w);
        if (!FINAL) *(f32x4*)(hout + 256 * j + 4 * lane) = v[j]; }
    const float rs2 = rsqrtf(wave_sum(s2) * (1.0f / DM) + EPS);
#pragma unroll
    for (int j = 0; j < 8; ++j) { const f32x4 gv = *(const f32x4*)(gnext + 256 * j + 4 * lane); const f32x4 o = v[j] * rs2 * gv;
        if (FINAL) *(f32x4*)(fin + 256 * j + 4 * lane) = o;
        else { u32x2 w; w.x = pk2(o.x, o.y); w.y = pk2(o.z, o.w); *(u32x2*)(xn + 256 * j + 4 * lane) = w; } }
}
__device__ __forceinline__ void rescale_row(bf16_t* y, const float* gna, const float* gsg, const float* gmem, int lane) {
    u32x4 w[4]; float ss[4];
#pragma unroll
    for (int j = 0; j < 4; ++j) { w[j] = *(const u32x4*)(y + 512 * j + 8 * lane);
        const float a0 = bflo(w[j].x), a1 = bfhi(w[j].x), a2 = bflo(w[j].y), a3 = bfhi(w[j].y), a4 = bflo(w[j].z), a5 = bfhi(w[j].z), a6 = bflo(w[j].w), a7 = bfhi(w[j].w);
        ss[j] = (a0 * a0 + a1 * a1) + (a2 * a2 + a3 * a3) + (a4 * a4 + a5 * a5) + (a6 * a6 + a7 * a7); }
    const float rna = rsqrtf(wave_sum(ss[0] + ss[1]) * (1.0f / 1024) + EPS), rsg = rsqrtf(wave_sum(ss[2]) * (1.0f / 512) + EPS), rme = rsqrtf(wave_sum(ss[3]) * (1.0f / 512) + EPS);
#pragma unroll
    for (int j = 0; j < 4; ++j) {
        const float* g = (j < 2 ? gna + 512 * j : j == 2 ? gsg : gmem) + 8 * lane; const float r = j < 2 ? rna : j == 2 ? rsg : rme;
        const f32x4 g0 = *(const f32x4*)g, g1 = *(const f32x4*)(g + 4);
        u32x4 o; o.x = pk2(bflo(w[j].x) * r * g0.x, bfhi(w[j].x) * r * g0.y); o.y = pk2(bflo(w[j].y) * r * g0.z, bfhi(w[j].y) * r * g0.w);
        o.z = pk2(bflo(w[j].z) * r * g1.x, bfhi(w[j].z) * r * g1.y); o.w = pk2(bflo(w[j].w) * r * g1.z, bfhi(w[j].w) * r * g1.w);
        *(u32x4*)(y + 512 * j + 8 * lane) = o; }
}

struct Ptrs {
    const float* in[25]; float* out; unsigned char* ws;
};
constexpr int VVT_LD = 136, KSTR = 272, KT_BYTES = 69632, VSTR_NA = 144, VSTR_MEM = 272, RPB_OFF = 143360;
static_assert(KT_BYTES + 512 * VSTR_NA <= RPB_OFF && KT_BYTES + 256 * VSTR_MEM <= RPB_OFF && 512 * VVT_LD * 2 <= RPB_OFF && RPB_OFF + 8 * 465 * 4 <= LDS_BYTES, "P5 LDS map");

template <bool NA>
__device__ __forceinline__ void attn_row(f32x4 (&o)[8], float& m, float& l, const bf16x8 (&qf)[4], const LAS unsigned char* kp, const LAS unsigned char* vp, const int vstr,
                                         const LAS float* br, const int qc, const int kc0  ) {
    bf16x8 kf[2][4];
#pragma unroll
    for (int a = 0; a < 2; ++a)
#pragma unroll
        for (int dc = 0; dc < 4; ++dc) kf[a][dc] = *(const LAS bf16x8*)(kp + a * 16 * KSTR + dc * 64);
    u32x2 vlo[8], vhi[8];
#pragma unroll
    for (int d = 0; d < 8; ++d) { vlo[d] = *(const LAS u32x2*)(vp + d * 16 * vstr); vhi[d] = *(const LAS u32x2*)(vp + d * 16 * vstr + 32); }
    f32x4 s0 = (f32x4){0.f, 0.f, 0.f, 0.f}, s1 = (f32x4){0.f, 0.f, 0.f, 0.f};
#pragma unroll
    for (int dc = 0; dc < 4; ++dc) { s0 = mfma16(kf[0][dc], qf[dc], s0); s1 = mfma16(kf[1][dc], qf[dc], s1); }
    if (NA) {
        const int cs = min(max(qc - 8, 0), 48);
#pragma unroll
        for (int e = 0; e < 4; ++e) {
            const int k0 = kc0 + e, k1 = kc0 + 16 + e;
            s0[e] = (k0 >= cs && k0 < cs + 16) ? s0[e] + br[min(max(k0 - qc, -15), 15) + 15] : -1.0e30f;
            s1[e] = (k1 >= cs && k1 < cs + 16) ? s1[e] + br[min(max(k1 - qc, -15), 15) + 15] : -1.0e30f;
        }
    }
    float mx = fmaxf(fmaxf(fmaxf(s0.x, s0.y), fmaxf(s0.z, s0.w)), fmaxf(fmaxf(s1.x, s1.y), fmaxf(s1.z, s1.w)));
    mx = fmaxf(mx, __shfl_xor(mx, 16)); mx = fmaxf(mx, __shfl_xor(mx, 32));
    const float mn = fmaxf(m, mx), alpha = fexp2(m - mn); m = mn;
#pragma unroll
    for (int e = 0; e < 4; ++e) { s0[e] = fexp2(s0[e] - mn); s1[e] = fexp2(s1[e] - mn); }
    l = l * alpha + ((s0.x + s0.y) + (s0.z + s0.w)) + ((s1.x + s1.y) + (s1.z + s1.w));
    u32x4 pw; pw.x = pk2(s0.x, s0.y); pw.y = pk2(s0.z, s0.w); pw.z = pk2(s1.x, s1.y); pw.w = pk2(s1.z, s1.w);
    const bf16x8 pb = __builtin_bit_cast(bf16x8, pw);
#pragma unroll
    for (int d = 0; d < 8; ++d) {
        u32x4 vw; vw.x = vlo[d].x; vw.y = vlo[d].y; vw.z = vhi[d].x; vw.w = vhi[d].y;
        o[d] = mfma16(__builtin_bit_cast(bf16x8, vw), pb, o[d] * alpha);
    }
}
__device__ __forceinline__ void attn_init(f32x4 (&o)[8], float& m, float& l) {
#pragma unroll
    for (int d = 0; d < 8; ++d) o[d] = (f32x4){0.f, 0.f, 0.f, 0.f};
    m = -3.0e38f; l = 0.f;
}
__device__ __forceinline__ void attn_finish(const f32x4 (&o)[8], float l, bf16_t* yp) {
    l += __shfl_xor(l, 16); l += __shfl_xor(l, 32);
    const float inv = frcp(l);
#pragma unroll
    for (int d = 0; d < 8; ++d) { u32x2 w; w.x = pk2(o[d].x * inv, o[d].y * inv); w.y = pk2(o[d].z * inv, o[d].w * inv); *(u32x2*)(yp + d * 16) = w; }
}
#define P5_LAUNDER() int tid = tid_in; asm volatile("" : "+v"(tid)); const int lane = tid & 63, fr = lane & 15, fq = lane >> 4
__device__ __forceinline__ void p5_unit(const Ptrs& P, LAS unsigned char* lds, int unit, int tid_in, int wave) {
    const bf16_t* proj = (const bf16_t*)(P.ws + WS_PROJ); const bf16_t* vt = (const bf16_t*)(P.ws + WS_VT);
    const bf16_t* km = (const bf16_t*)(P.ws + WS_KM); const bf16_t* vmt = (const bf16_t*)(P.ws + WS_VMT);
    const bf16_t* wsb = (const bf16_t*)(P.ws + WS_WSB);
    bf16_t* Y = (bf16_t*)(P.ws + WS_XN);
    const int b = unit >> 6, r = unit & 63, tok0 = b * SEQ + r * 64;
    const int rs = min(max(r - 4, 0), 56);
    LAS float* rpb = (LAS float*)(lds + RPB_OFF);
    LAS bf16_t* vvt = (LAS bf16_t*)lds;
    __syncthreads();
    for (int i = tid_in; i < 8 * 15 * 31; i += 512) rpb[i] = P.in[10][i] * LOG2E;
    for (int rep = 0; rep < P5_REP_PRE; ++rep) {
        P5_LAUNDER(); (void)fr; (void)fq;
        const int g = wave & 3, q = (wave >> 2) * 64 + lane, ctok = b * SEQ + (r >> 1) * 128;
        const bf16_t* vs = vt + (size_t)(1024 + g * 128) * VT_LD + ctok + q;
        float s = 0.f, ss = 0.f;
#pragma unroll 16
        for (int c = 0; c < 128; ++c) { const float x = bf1(vs[(size_t)c * VT_LD]); s += x; ss += x * x; }
        const float mu = s * (1.0f / 128), var = fmaxf(ss * (1.0f / 128) - mu * mu, 0.f), rstd = rsqrtf(var + EPS);
        const float* lg = P.in[11] + g * 128; const float* lb = P.in[12] + g * 128;
#pragma unroll 16
        for (int c = 0; c < 128; ++c) { const float x = bf1(vs[(size_t)c * VT_LD]); const float yv = (x - mu) * rstd * lg[c] + lb[c];
            vvt[(g * 128 + c) * VVT_LD + q] = (bf16_t)(pk2(yv, 0.f) & 0xffffu); }
    }
    __syncthreads();
    for (int rep = 0; rep < P5_REP_SG; ++rep) {
        P5_LAUNDER();
        const int g = wave & 3, half = wave >> 2;
#pragma unroll 1
        for (int pb = 0; pb < 2; ++pb) {
            const int pl = half * 32 + pb * 16 + fr, pp = (r & 1) * 64 + pl;
            f32x4 acc[8];
#pragma unroll
            for (int c = 0; c < 8; ++c) acc[c] = (f32x4){0.f, 0.f, 0.f, 0.f};
#pragma unroll
            for (int qc = 0; qc < 4; ++qc) {
                const bf16x8 wf = *(const bf16x8*)(wsb + (size_t)(g * 128 + pp) * 128 + qc * 32 + fq * 8);
#pragma unroll
                for (int c = 0; c < 8; ++c) {
                    const bf16x8 af = *(const LAS bf16x8*)(vvt + (g * 128 + c * 16 + fr) * VVT_LD + qc * 32 + fq * 8);
                    acc[c] = mfma16(af, wf, acc[c]);
                }
            }
            const float bs = P.in[14][g * 128 + pp];
            const bf16_t* up = proj + ((size_t)tok0 + pl) * PROJ_LD + 2048 + g * 128 + fq * 4;
            bf16_t* yp = Y + ((size_t)tok0 + pl) * DM + 1024 + g * 128 + fq * 4;
#pragma unroll
            for (int c = 0; c < 8; ++c) { const u32x2 uw = *(const u32x2*)(up + c * 16);
                u32x2 w; w.x = pk2(bflo(uw.x) * (acc[c].x + bs), bfhi(uw.x) * (acc[c].y + bs)); w.y = pk2(bflo(uw.y) * (acc[c].z + bs), bfhi(uw.y) * (acc[c].w + bs));
                *(u32x2*)(yp + c * 16) = w; }
        }
    }
    for (int rep = 0; rep < P5_REP_NA; ++rep) {
        P5_LAUNDER();
        const int hh = wave & 3, qp = wave >> 2, qbA = 2 * qp, qbB = 2 * qp + 1;
        const int w0A = qp == 0 ? 0 : 24, w0B = qp == 0 ? 8 : 32;
        const unsigned kgo = (unsigned)((tid >> 6) * PROJ_LD + (tid & 63) * 8) * 2u, vgo = (unsigned)((tid >> 3) * VT_LD + (tid & 7) * 8) * 2u;
        const unsigned klo = (unsigned)((((tid >> 4) & 3) * 64 + (tid >> 6)) * KSTR + (tid & 15) * 16), vlo = (unsigned)((tid >> 3) * VSTR_NA + (tid & 7) * 16);
#pragma unroll 1
        for (int hg = 0; hg < 2; ++hg) {
            const int h = hg * 4 + hh;
            bf16x8 qfA[4], qfB[4];
            { const bf16_t* qa = proj + ((size_t)tok0 + qbA * 16 + fr) * PROJ_LD + h * 128 + fq * 8; const bf16_t* qb_ = qa + (size_t)16 * PROJ_LD;
#pragma unroll
              for (int dc = 0; dc < 4; ++dc) { qfA[dc] = *(const bf16x8*)(qa + dc * 32); qfB[dc] = *(const bf16x8*)(qb_ + dc * 32); } }
            f32x4 oA[8], oB[8]; float mA, lA, mB, lB; attn_init(oA, mA, lA); attn_init(oB, mB, lB);
#pragma unroll 1
            for (int i = 0; i < 8; ++i) {
                const size_t ktok = (size_t)b * SEQ + (rs + i) * 64;
                const char* kg = (const char*)(proj + ktok * PROJ_LD + 1024 + hg * 512); const char* vg = (const char*)(vt + (size_t)(hg * 512) * VT_LD + ktok);
                u32x4 tk[8];
#pragma unroll
                for (int j = 0; j < 8; ++j) tk[j] = *(const u32x4*)(kg + (size_t)j * (8 * PROJ_LD * 2) + kgo);
                __syncthreads();
#pragma unroll
                for (int j = 0; j < 8; ++j) *(LAS u32x4*)(lds + klo + j * (8 * KSTR)) = tk[j];
                __builtin_amdgcn_sched_barrier(0);
#pragma unroll
                for (int j = 0; j < 8; ++j) tk[j] = *(const u32x4*)(vg + (size_t)j * (64 * VT_LD * 2) + vgo);
#pragma unroll
                for (int j = 0; j < 8; ++j) *(LAS u32x4*)(lds + KT_BYTES + vlo + j * (64 * VSTR_NA)) = tk[j];
                __syncthreads();
                const LAS float* br = rpb + h * 465 + (rs - r + 7 + i) * 31;
                attn_row<true>(oA, mA, lA, qfA, lds + (hh * 64 + w0A + fr) * KSTR + fq * 16, lds + KT_BYTES + (hh * 128 + fr) * VSTR_NA + (w0A + fq * 4) * 2, VSTR_NA, br, qbA * 16 + fr, w0A + fq * 4);
                __builtin_amdgcn_sched_barrier(0);
                attn_row<true>(oB, mB, lB, qfB, lds + (hh * 64 + w0B + fr) * KSTR + fq * 16, lds + KT_BYTES + (hh * 128 + fr) * VSTR_NA + (w0B + fq * 4) * 2, VSTR_NA, br, qbB * 16 + fr, w0B + fq * 4);
                __builtin_amdgcn_sched_barrier(0);
            }
            attn_finish(oA, lA, Y + ((size_t)tok0 + qbA * 16 + fr) * DM + h * 128 + fq * 4);
            attn_finish(oB, lB, Y + ((size_t)tok0 + qbB * 16 + fr) * DM + h * 128 + fq * 4);
        }
    }
    for (int rep = 0; rep < P5_REP_MEM; ++rep) {
        P5_LAUNDER();
        const int hh = wave & 1, qb = wave >> 1;
        const unsigned kgo = (unsigned)((tid >> 5) * 512 + (tid & 31) * 8) * 2u, vgo = (unsigned)((tid >> 4) * 1024 + (tid & 15) * 8) * 2u;
        const unsigned klo = (unsigned)((((tid >> 4) & 1) * 128 + (tid >> 5)) * KSTR + (tid & 15) * 16), vlo = (unsigned)((tid >> 4) * VSTR_MEM + (tid & 15) * 16);
#pragma unroll 1
        for (int hp = 0; hp < 2; ++hp) {
            const int hm = hp * 2 + hh;
            bf16x8 qf[4];
            { const bf16_t* qa = proj + ((size_t)tok0 + qb * 16 + fr) * PROJ_LD + 2560 + hm * 128 + fq * 8;
#pragma unroll
              for (int dc = 0; dc < 4; ++dc) qf[dc] = *(const bf16x8*)(qa + dc * 32); }
            f32x4 o[8]; float m, l; attn_init(o, m, l);
#pragma unroll 1
            for (int kh = 0; kh < 2; ++kh) {
                const char* kg = (const char*)(km + (size_t)(b * 256 + kh * 128) * 512 + hp * 256); const char* vg = (const char*)(vmt + (size_t)(hp * 256) * 1024 + b * 256 + kh * 128);
                u32x4 tk[8];
#pragma unroll
                for (int j = 0; j < 8; ++j) tk[j] = *(const u32x4*)(kg + (size_t)j * (16 * 512 * 2) + kgo);
                __syncthreads();
#pragma unroll
                for (int j = 0; j < 8; ++j) *(LAS u32x4*)(lds + klo + j * (16 * KSTR)) = tk[j];
                __builtin_amdgcn_sched_barrier(0);
#pragma unroll
                for (int j = 0; j < 8; ++j) tk[j] = *(const u32x4*)(vg + (size_t)j * (32 * 1024 * 2) + vgo);
#pragma unroll
                for (int j = 0; j < 8; ++j) *(LAS u32x4*)(lds + KT_BYTES + vlo + j * (32 * VSTR_MEM)) = tk[j];
                __syncthreads();
#pragma unroll 1
                for (int rr = 0; rr < 4; ++rr)
                    attn_row<false>(o, m, l, qf, lds + (hh * 128 + rr * 32 + fr) * KSTR + fq * 16, lds + KT_BYTES + (hh * 128 + fr) * VSTR_MEM + (rr * 32 + fq * 4) * 2, VSTR_MEM, rpb, 0, 0);
            }
            attn_finish(o, l, Y + ((size_t)tok0 + qb * 16 + fr) * DM + 1536 + hm * 128 + fq * 4);
        }
    }
    __builtin_amdgcn_fence(__ATOMIC_RELEASE, "workgroup"); __syncthreads(); __builtin_amdgcn_fence(__ATOMIC_ACQUIRE, "workgroup");
    P5_LAUNDER(); (void)fr; (void)fq;
    for (int t = wave; t < 64; t += 8) rescale_row(Y + ((size_t)tok0 + t) * DM, P.in[15], P.in[16], P.in[17], lane);
}

__device__ __forceinline__ void naive_p5(const Ptrs& P, int gw, int ngw, int lane) {
    const bf16_t* proj = (const bf16_t*)(P.ws + WS_PROJ); const bf16_t* vt = (const bf16_t*)(P.ws + WS_VT);
    const bf16_t* km = (const bf16_t*)(P.ws + WS_KM); const bf16_t* vmt = (const bf16_t*)(P.ws + WS_VMT);
    bf16_t* Y = (bf16_t*)(P.ws + WS_XN);
    for (int task = gw; task < MTOK * 16; task += ngw) {
        const int t = task >> 4, sub = task & 15, b = t / SEQ, pos = t % SEQ;
        if (sub < 12) {
            const bool na = sub < 8; const int h = na ? sub : sub - 8;
            const unsigned qw = *(const unsigned*)(proj + (size_t)t * PROJ_LD + (na ? 0 : 2560) + h * 128 + 2 * lane);
            const float q0 = bflo(qw), q1 = bfhi(qw);
            const int r = pos >> 6, c = pos & 63, rs = min(max(r - 4, 0), 56), cs = min(max(c - 8, 0), 48);
            float m = -3.0e38f, l = 0.f, o0 = 0.f, o1 = 0.f;
            const int nk = na ? 128 : 256;
            for (int kk = 0; kk < nk; ++kk) {
                float bias = 0.f; size_t koff, voff;
                if (na) { const int kr = rs + (kk >> 4), kc = cs + (kk & 15), kt = b * SEQ + kr * 64 + kc;
                    koff = (size_t)kt * PROJ_LD + 1024 + h * 128 + 2 * lane; voff = (size_t)(h * 128 + 2 * lane) * VT_LD + kt;
                    bias = P.in[10][(h * 15 + (kr - r + 7)) * 31 + min(max(kc - c, -15), 15) + 15] * LOG2E;
                } else { koff = (size_t)(b * 256 + kk) * 512 + h * 128 + 2 * lane; voff = (size_t)(h * 128 + 2 * lane) * 1024 + b * 256 + kk; }
                const unsigned kw = *(const unsigned*)((na ? proj : km) + koff);
                const float s = wave_sum(q0 * bflo(kw) + q1 * bfhi(kw)) + bias;
                const bf16_t* vb = na ? vt : vmt; const int vl = na ? VT_LD : 1024;
                const float v0 = bf1(vb[voff]), v1 = bf1(vb[voff + vl]);
                const float mn = fmaxf(m, s), al = fexp2(m - mn), p = fexp2(s - mn); m = mn;
                l = l * al + p; o0 = o0 * al + p * v0; o1 = o1 * al + p * v1;
            }
            const float inv = 1.0f / l;
            *(unsigned*)(Y + (size_t)t * DM + (na ? 0 : 1536) + h * 128 + 2 * lane) = pk2(o0 * inv, o1 * inv);
        } else {
            const int g = sub - 12, p = pos & 127, ctok = t - p;
            float a0 = 0.f, a1 = 0.f;
            const float lg0 = P.in[11][g * 128 + 2 * lane], lg1 = P.in[11][g * 128 + 2 * lane + 1], lb0 = P.in[12][g * 128 + 2 * lane], lb1 = P.in[12][g * 128 + 2 * lane + 1];
            for (int q = 0; q < 128; ++q) {
                const float x0 = bf1(vt[(size_t)(1024 + g * 128 + 2 * lane) * VT_LD + ctok + q]), x1 = bf1(vt[(size_t)(1024 + g * 128 + 2 * lane + 1) * VT_LD + ctok + q]);
                const float mu = wave_sum(x0 + x1) * (1.0f / 128), d0 = x0 - mu, d1 = x1 - mu;
                const float rstd = rsqrtf(wave_sum(d0 * d0 + d1 * d1) * (1.0f / 128) + EPS);
                const float w = P.in[13][(size_t)(g * 128 + p) * 128 + q];
                a0 += w * (d0 * rstd * lg0 + lb0); a1 += w * (d1 * rstd * lg1 + lb1);
            }
            const float bs = P.in[14][g * 128 + p];
            const unsigned uw = *(const unsigned*)(proj + (size_t)t * PROJ_LD + 2048 + g * 128 + 2 * lane);
            *(unsigned*)(Y + (size_t)t * DM + 1024 + g * 128 + 2 * lane) = pk2(bflo(uw) * (a0 + bs), bfhi(uw) * (a1 + bs));
        }
    }
}

#define XB_TMO      128
#define XB_XCNT(j)  (256  + 64 * (j))
#define XB_XSUB(j)  (1280 + 64 * (j))
#define XB_XGEN(j)  (2304 + 64 * (j))
#define XB_TOP      3328
#define XB_TOPGEN   3392
#define XCD_BAR_WORDS 3456
#define XB_SPIN_CAP (1u << 18)
__device__ __forceinline__ unsigned xb_ld(unsigned* p)              { return __hip_atomic_load(p, __ATOMIC_RELAXED, __HIP_MEMORY_SCOPE_AGENT); }
__device__ __forceinline__ unsigned xb_add(unsigned* p, unsigned v) { return __hip_atomic_fetch_add(p, v, __ATOMIC_RELAXED, __HIP_MEMORY_SCOPE_AGENT); }
__device__ __forceinline__ unsigned xb_xcc_id() { return (unsigned)__builtin_amdgcn_s_getreg((3 << 11) | 20) & 0xFu; }
#define XB_SPIN(cond, bar) do { unsigned _sp = 0; while (cond) { __builtin_amdgcn_s_sleep(1); \
    if ((++_sp & 255u) == 0u) { if (xb_ld(&(bar)[XB_TMO])) break; if (_sp > XB_SPIN_CAP) { atomicAdd(&(bar)[XB_TMO], 1u); break; } } } } while (0)
struct XcdBarrier { unsigned* bar; unsigned x; volatile LAS unsigned* st; };
__device__ __forceinline__ XcdBarrier xcd_barrier_post(unsigned* bar, volatile LAS unsigned* st) {
    XcdBarrier b; b.bar = bar; b.x = xb_xcc_id(); b.st = st;
    if (threadIdx.x == 0) (void)xb_add(&bar[XB_XCNT(b.x)], 1u);
    return b;
}
__device__ __forceinline__ void xcd_barrier_complete(unsigned* bar, unsigned x, unsigned& nloc, unsigned& nx) {
    const unsigned G = gridDim.x * gridDim.y * gridDim.z;
    unsigned sum, cnt, mine, sp = 0u;
    for (;;) {
        sum = 0u; cnt = 0u; mine = 0u;
#pragma unroll
        for (unsigned j = 0; j < 16; ++j) { const unsigned c = xb_ld(&bar[XB_XCNT(j)]); sum += c; cnt += (c > 0u) ? 1u : 0u; mine = (j == x) ? c : mine; }
        if (sum == G) break;
        __builtin_amdgcn_s_sleep(1);
        if ((++sp & 255u) == 0u) { if (xb_ld(&bar[XB_TMO])) break; if (sp > XB_SPIN_CAP) { atomicAdd(&bar[XB_TMO], 1u); break; } }
    }
    nloc = mine > 0u ? mine : 1u; nx = cnt > 0u ? cnt : 1u;
}
__device__ __forceinline__ void xcd_barrier(const XcdBarrier& b) {
    asm volatile("s_waitcnt vmcnt(0)" ::: "memory");
    __syncthreads();
    if (threadIdx.x == 0) {
        unsigned* bar = b.bar;
        __builtin_amdgcn_s_waitcnt(0);
        unsigned nloc = b.st[0], nx = b.st[1];
        if (nloc == 0u) { xcd_barrier_complete(bar, b.x, nloc, nx); b.st[0] = nloc; b.st[1] = nx; }
        const unsigned old = xb_add(&bar[XB_XSUB(b.x)], 1u);
        const unsigned gen = old / nloc;
        if (old + 1u == (gen + 1u) * nloc) {
            __builtin_amdgcn_fence(__ATOMIC_RELEASE, "agent");
            asm volatile("s_waitcnt vmcnt(0)" ::: "memory");
            const unsigned og = xb_add(&bar[XB_TOP], 1u);
            const unsigned tg = og / nx;
            if (og + 1u == (tg + 1u) * nx) xb_add(&bar[XB_TOPGEN], 1u);
            else XB_SPIN(xb_ld(&bar[XB_TOPGEN]) == tg, bar);
            __builtin_amdgcn_fence(__ATOMIC_ACQUIRE, "agent");
            xb_add(&bar[XB_XGEN(b.x)], 1u);
            asm volatile("s_waitcnt vmcnt(0)" ::: "memory");
        } else {
            XB_SPIN(xb_ld(&bar[XB_XGEN(b.x)]) == gen, bar);
            __builtin_amdgcn_fence(__ATOMIC_ACQUIRE, "agent");
            asm volatile("s_waitcnt vmcnt(0)" ::: "memory");
        }
    }
    __syncthreads();
}

struct Args { const float* in[25]; float* out; unsigned char* ws; int ph_lo, ph_hi; };

__global__ void __launch_bounds__(512, 2) fwd_kernel(Args a) {
    extern __shared__ __attribute__((aligned(16))) unsigned char smem[];
    LAS unsigned char* lds = (LAS unsigned char*)smem;
    cg::grid_group grid = cg::this_grid();
    const int tid0 = threadIdx.x;
    const int G = gridDim.x, bid = blockIdx.x, ngw = G * 8;
    Ptrs P;
#pragma unroll
    for (int i = 0; i < 25; ++i) P.in[i] = a.in[i];
    P.out = a.out; P.ws = a.ws;
    unsigned char* ws = a.ws;
    bf16_t* XN = (bf16_t*)(ws + WS_XN); bf16_t* H = (bf16_t*)(ws + WS_H); bf16_t* F = (bf16_t*)(ws + WS_F);

    int probe_rep = 0;
    const bool multi = (a.ph_hi - a.ph_lo) > 1;
    volatile LAS unsigned* xb_st = (volatile LAS unsigned*)(lds + LDS_BYTES - 16);
    XcdBarrier bar; bar.bar = (unsigned*)(ws + WS_BAR); bar.x = 0; bar.st = xb_st;
    if (multi) { if (tid0 == 0) { xb_st[0] = 0u; xb_st[1] = 0u; } __syncthreads(); bar = xcd_barrier_post((unsigned*)(ws + WS_BAR), xb_st); }
    if (a.ph_hi > 1000) grid.sync();
    if (PROBE_PH == 99) for (int i = 0; i < PROBE_N; ++i) xcd_barrier(bar);
    for (int ph = a.ph_lo; ph < a.ph_hi; ++ph) {
        if (ph == 6 && !NAIVE_P5) continue;
        int tid = tid0; asm volatile("" : "+v"(tid));
        const int lane = tid & 63, wave = __builtin_amdgcn_readfirstlane(tid >> 6), gw = bid * 8 + wave;
        const bool is_gemm = (ph == 1 || ph == 2 || ph == 4 || ph == 7 || ph == 9 || ph == 10);
        if (is_gemm) {
            pg8::GP p; p.K = DM; p.G = G; p.c = bid; p.mode = 1; p.ld = DM; p.out = F; p.nM0 = 64; p.nN0 = 8; p.total = 512;
            p.proj = (bf16_t*)(ws + WS_PROJ); p.vt = (bf16_t*)(ws + WS_VT); p.km = (bf16_t*)(ws + WS_KM); p.vmt = (bf16_t*)(ws + WS_VMT);
            const bf16_t* win = (const bf16_t*)(ws + WS_WIN); const bf16_t* wmkv = (const bf16_t*)(ws + WS_WMKV); const bf16_t* memn = (const bf16_t*)(ws + WS_MEMN);
            p.A0 = XN; p.B0 = (const bf16_t*)(ws + WS_WOUT);
            p.A1 = win + (size_t)3072 * DM; p.B1 = XN; p.A2 = memn; p.B2 = wmkv; p.A3 = wmkv + (size_t)512 * DM; p.B3 = memn;
            if (ph == 1 || ph == 9) { p.B0 = (const bf16_t*)(ws + (ph == 1 ? WS_WGU1 : WS_WGU2)); p.nN0 = 44; p.total = 64 * 44; p.mode = 0; p.out = H; }
            else if (ph == 2 || ph == 10) { p.A0 = H; p.B0 = (const bf16_t*)(ws + (ph == 2 ? WS_WD1 : WS_WD2)); p.K = DFF; }
            else if (ph == 4) { p.B0 = win; p.nN0 = 12; p.total = 1168; p.mode = 2; }
#if NAIVE_GEMM
            if (p.mode == 0) simple_gemm_swiglu(p.A0, p.B0, H, gw, ngw, lane);
            else {
                simple_gemm_job(p.A0, p.B0, p.nM0 * 256, p.nN0 * 256, p.K, 0, p.proj, p.vt, p.km, p.vmt, p.mode, p.out, p.ld, gw, ngw, lane);
                if (p.mode == 2) {
                    simple_gemm_job(p.A1, p.B1, 6 * 256, 64 * 256, p.K, 1, p.proj, p.vt, p.km, p.vmt, 2, p.out, p.ld, gw, ngw, lane);
                    simple_gemm_job(p.A2, p.B2, 4 * 256, 2 * 256, p.K, 2, p.proj, p.vt, p.km, p.vmt, 2, p.out, p.ld, gw, ngw, lane);
                    simple_gemm_job(p.A3, p.B3, 2 * 256, 4 * 256, p.K, 3, p.proj, p.vt, p.km, p.vmt, 2, p.out, p.ld, gw, ngw, lane);
                }
            }
#else
            pg8::gemm_phase(lds, p, tid);
#endif
        } else if (ph == 0) {
            LAS float* scr = (LAS float*)(lds + wave * (64 * 65 * 4));
            constexpr int I_GU = 32 * 176, I_D = 88 * 32, I_IN = 32 * 72, I_MKV = 32 * 16, I_OUT = 32 * 32;
            constexpr int NITEMS = 2 * I_GU + 2 * I_D + I_IN + I_MKV + I_OUT;
            for (int it = gw; it < NITEMS; it += ngw) {
                int r = it;
                if (r < I_GU) { const int nb = r % 176; transpose_item(P.in[3], DM, NGU, (bf16_t*)(ws + WS_WGU1), r / 176, nb, map_gu(nb), scr, lane); continue; } r -= I_GU;
                if (r < I_GU) { const int nb = r % 176; transpose_item(P.in[21], DM, NGU, (bf16_t*)(ws + WS_WGU2), r / 176, nb, map_gu(nb), scr, lane); continue; } r -= I_GU;
                if (r < I_D) { const int nb = r % 32; transpose_item(P.in[4], DFF, DM, (bf16_t*)(ws + WS_WD1), r / 32, nb, nb * 64, scr, lane); continue; } r -= I_D;
                if (r < I_D) { const int nb = r % 32; transpose_item(P.in[22], DFF, DM, (bf16_t*)(ws + WS_WD2), r / 32, nb, nb * 64, scr, lane); continue; } r -= I_D;
                if (r < I_IN) { const int nb = r % 72; transpose_item(P.in[8], DM, 4608, (bf16_t*)(ws + WS_WIN), r / 72, nb, map_win(nb), scr, lane); continue; } r -= I_IN;
                if (r < I_MKV) { const int nb = r % 16; transpose_item(P.in[9], DM, 1024, (bf16_t*)(ws + WS_WMKV), r / 16, nb, nb * 64, scr, lane); continue; } r -= I_MKV;
                { const int nb = r % 32; transpose_item(P.in[18], DM, DM, (bf16_t*)(ws + WS_WOUT), r / 32, nb, nb * 64, scr, lane); }
            }
            for (int i = gw * 64 + lane; i < 4 * 128 * 128 / 2; i += ngw * 64) { const float2 v = *(const float2*)(P.in[13] + 2 * i); ((unsigned*)(ws + WS_WSB))[i] = pk2(v.x, v.y); }
            for (int m = gw; m < MTOK; m += ngw) norm_row_bf16(P.in[0] + (size_t)m * DM, P.in[2], XN + (size_t)m * DM, lane);
            for (int m = gw; m < 1024; m += ngw) norm_row_bf16(P.in[1] + (size_t)m * DM, P.in[7], (bf16_t*)(ws + WS_MEMN) + (size_t)m * DM, lane);
        } else if (ph == 3) {
            for (int m = gw; m < MTOK; m += ngw) resid_row<false>(F + (size_t)m * DM, P.in[0] + (size_t)m * DM, P.out + (size_t)m * DM, P.in[5], 0.5f, P.in[6], XN + (size_t)m * DM, nullptr, lane);
        } else if (ph == 8) {
            for (int m = gw; m < MTOK; m += ngw) resid_row<false>(F + (size_t)m * DM, P.out + (size_t)m * DM, P.out + (size_t)m * DM, P.in[19], 1.0f, P.in[20], XN + (size_t)m * DM, nullptr, lane);
        } else if (ph == 11) {
            for (int m = gw; m < MTOK; m += ngw) resid_row<true>(F + (size_t)m * DM, P.out + (size_t)m * DM, nullptr, P.in[23], 0.5f, P.in[24], nullptr, P.out + (size_t)m * DM, lane);
        } else if (ph == 5) {
#if NAIVE_P5
            naive_p5(P, gw, ngw, lane);
#else
            for (int u = bid; u < 256; u += G) p5_unit(P, lds, u, tid, wave);
#endif
        } else if (ph == 6) {
            for (int m = gw; m < MTOK; m += ngw) rescale_row(XN + (size_t)m * DM, P.in[15], P.in[16], P.in[17], lane);
        }
        if (ph + 1 < a.ph_hi) xcd_barrier(bar);
        if (ph == PROBE_PH && probe_rep < PROBE_N) { ++probe_rep; --ph; }
    }
}

extern "C" void kernel_launch(void* const* d_in, const int* in_sizes, int n_in, void* d_out, int out_size, void* d_ws, size_t ws_size, hipStream_t stream) {
    static int grid = 0;
    if (grid == 0) {
        if (n_in != 25 || out_size != MTOK * DM || ws_size < WS_TOTAL) { fprintf(stderr, "kernel_launch: unexpected problem (n_in %d, out %d, ws %zu < %zu)\n", n_in, out_size, ws_size, (size_t)WS_TOTAL); grid = -1; return; }
        int dev = 0, cus = 0, per_cu = 0;
        (void)hipGetDevice(&dev);
        (void)hipDeviceGetAttribute(&cus, hipDeviceAttributeMultiprocessorCount, dev);
        (void)hipFuncSetAttribute((const void*)fwd_kernel, hipFuncAttributeMaxDynamicSharedMemorySize, LDS_BYTES);
        (void)hipOccupancyMaxActiveBlocksPerMultiprocessor(&per_cu, (const void*)fwd_kernel, 512, LDS_BYTES);
        if (per_cu < 1) { fprintf(stderr, "kernel_launch: occupancy query says %d blocks per CU\n", per_cu); per_cu = 1; }
        grid = cus * 1;
        (void)hipGetLastError();
    }
    if (grid < 0) return;
    Args a{};
    for (int i = 0; i < 25; ++i) a.in[i] = (const float*)d_in[i];
    a.out = (float*)d_out; a.ws = (unsigned char*)d_ws;
#if MULTI_LAUNCH
    for (int ph = 0; ph < NPHASE; ++ph) {
        if (ph == 6 && !NAIVE_P5) continue;
        a.ph_lo = ph; a.ph_hi = ph + 1;
        hipLaunchKernelGGL(fwd_kernel, dim3(grid), dim3(512), LDS_BYTES, stream, a);
    }
#else
    a.ph_lo = 0; a.ph_hi = NPHASE;
    (void)hipMemsetAsync((unsigned char*)d_ws + WS_BAR, 0, 16384, stream);
    void* args[] = {&a};
    hipError_t e = hipLaunchCooperativeKernel((const void*)fwd_kernel, dim3(grid), dim3(512), args, LDS_BYTES, stream);
    if (e != hipSuccess) fprintf(stderr, "cooperative launch failed: %s (grid %d)\n", hipGetErrorString(e), grid);
#endif
}
```

```cpp
#include <hip/hip_runtime.h>
#include <hip/hip_cooperative_groups.h>
#include <cstdio>
namespace cg = cooperative_groups;

#ifndef MULTI_LAUNCH
#define MULTI_LAUNCH 0
#endif
#ifndef NAIVE_GEMM
#define NAIVE_GEMM 0
#endif
#ifndef NAIVE_P5
#define NAIVE_P5 0
#endif

#ifndef PROBE_PH
#define PROBE_PH (-1)
#define PROBE_N 0
#endif

#ifndef P5_REP_PRE
#define P5_REP_PRE 1
#define P5_REP_NA 1
#define P5_REP_MEM 1
#define P5_REP_SG 1
#endif
#define LAS __attribute__((address_space(3)))
typedef unsigned short bf16_t;
typedef short bf16x8 __attribute__((ext_vector_type(8)));
typedef float f32x4 __attribute__((ext_vector_type(4)));
typedef unsigned u32x4 __attribute__((ext_vector_type(4)));
typedef unsigned u32x2 __attribute__((ext_vector_type(2)));

constexpr int MTOK = 16384, DM = 2048, DFF = 5632, NGU = 11264, SEQ = 4096;
constexpr int PROJ_LD = 3072, VT_LD = 16384;
constexpr float EPS = 1e-6f;
constexpr float LOG2E = 1.4426950408889634f;
constexpr float QSCALE = 0.08838834764831845f * LOG2E;
constexpr int NPHASE = 12;
constexpr int LDS_BYTES = 156 * 1024;

constexpr size_t WS_WGU1 = 0;
constexpr size_t WS_WD1 = WS_WGU1 + (size_t)NGU * DM * 2;
constexpr size_t WS_WIN = WS_WD1 + (size_t)DM * DFF * 2;
constexpr size_t WS_WMKV = WS_WIN + (size_t)4608 * DM * 2;
constexpr size_t WS_WOUT = WS_WMKV + (size_t)1024 * DM * 2;
constexpr size_t WS_WGU2 = WS_WOUT + (size_t)DM * DM * 2;
constexpr size_t WS_WD2 = WS_WGU2 + (size_t)NGU * DM * 2;
constexpr size_t WS_WSB = WS_WD2 + (size_t)DM * DFF * 2;
constexpr size_t WS_MEMN = WS_WSB + (size_t)4 * 128 * 128 * 2;
constexpr size_t WS_KM = WS_MEMN + (size_t)1024 * DM * 2;
constexpr size_t WS_VMT = WS_KM + (size_t)1024 * 512 * 2;
constexpr size_t WS_XN = WS_VMT + (size_t)512 * 1024 * 2;
constexpr size_t WS_H = WS_XN + (size_t)MTOK * DM * 2;
constexpr size_t WS_PROJ = WS_H;
constexpr size_t WS_VT = WS_H + (size_t)MTOK * PROJ_LD * 2;
constexpr size_t WS_F = WS_H + (size_t)MTOK * DFF * 2;
constexpr size_t WS_END = WS_F + (size_t)MTOK * DM * 2;
static_assert(WS_VT + (size_t)1536 * VT_LD * 2 <= WS_F, "overlay");
constexpr size_t WS_BAR = WS_END;
constexpr size_t WS_TOTAL = WS_BAR + 16384;
static_assert(WS_TOTAL <= (size_t)536870912, "workspace");

__device__ __forceinline__ unsigned pk2(float lo, float hi) { unsigned r; asm("v_cvt_pk_bf16_f32 %0, %1, %2" : "=v"(r) : "v"(lo), "v"(hi)); return r; }
__device__ __forceinline__ float bflo(unsigned u) { return __uint_as_float(u << 16); }
__device__ __forceinline__ float bfhi(unsigned u) { return __uint_as_float(u & 0xffff0000u); }
__device__ __forceinline__ float bf1(bf16_t b) { return __uint_as_float(((unsigned)b) << 16); }
__device__ __forceinline__ float wave_sum(float v) {
#pragma unroll
    for (int o = 1; o < 64; o <<= 1) v += __shfl_xor(v, o);
    return v;
}
__device__ __forceinline__ float fexp2(float x) { return __builtin_amdgcn_exp2f(x); }
__device__ __forceinline__ float frcp(float x) { return __builtin_amdgcn_rcpf(x); }
__device__ __forceinline__ float gelu_tanh(float x) {
    const float t = x * (1.0f + 0.044715f * x * x);
    return x * frcp(1.0f + fexp2(t * (-2.0f * 0.7978845608028654f * LOG2E)));
}
__device__ __forceinline__ float silu_mul(float g, float u) { return g * frcp(1.0f + fexp2(g * (-LOG2E))) * u; }
__device__ __forceinline__ f32x4 mfma16(bf16x8 a, bf16x8 b, f32x4 c) { return __builtin_amdgcn_mfma_f32_16x16x32_bf16(a, b, c, 0, 0, 0); }

struct OutBf {
    bf16_t* base; int ld; int act; float sc;
    __device__ __forceinline__ f32x4 xf(f32x4 v) const {
        v = v * sc;
        if (act) { v.x = gelu_tanh(v.x); v.y = gelu_tanh(v.y); v.z = gelu_tanh(v.z); v.w = gelu_tanh(v.w); }
        return v;
    }
    __device__ __forceinline__ void st4(int row, int col, f32x4 v) const {
        v = xf(v); u32x2 w; w.x = pk2(v.x, v.y); w.y = pk2(v.z, v.w);
        *(u32x2*)(base + (size_t)row * ld + col) = w;
    }
    __device__ __forceinline__ void st8(int row, int col, f32x4 a, f32x4 b) const {
        a = xf(a); b = xf(b); u32x4 w; w.x = pk2(a.x, a.y); w.y = pk2(a.z, a.w); w.z = pk2(b.x, b.y); w.w = pk2(b.z, b.w);
        *(u32x4*)(base + (size_t)row * ld + col) = w;
    }
};
__device__ __forceinline__ OutBf p4_sel(int job, int pm, int pn, bf16_t* proj, bf16_t* vt, bf16_t* km, bf16_t* vmt) {
    OutBf o; o.act = 0; o.sc = 1.0f; o.base = proj; o.ld = PROJ_LD;
    if (job == 0) { if (pn < 4 || pn >= 10) o.sc = QSCALE; else if (pn >= 8) o.act = 1; }
    if (job == 1) { o.base = vt; o.ld = VT_LD; if (pm >= 4) o.act = 1; }
    if (job == 2) { o.base = km; o.ld = 512; }
    if (job == 3) { o.base = vmt; o.ld = 1024; }
    return o;
}

namespace pg8 {
constexpr int BM = 256, BK = 64, HALF = 128, HTB = HALF * BK * 2, STAGE_BYTES = 8 * HTB, NXCD = 8, WGM = 8;
__device__ __forceinline__ int lds_byte(int r, int c) { const int st = (r >> 4) * 2 + (c >> 5), rr = r & 15, cc = c & 31, ob = rr * 64 + cc * 2; return st * 1024 + (ob ^ (((ob >> 9) & 1) << 5)); }
__device__ __forceinline__ void stage_rc(int b, int& R, int& C) { const int st = b / 1024, sb = b % 1024, swz = sb ^ (((sb >> 9) & 1) << 5); R = (st >> 1) * 16 + swz / 64; C = (st & 1) * 32 + (swz % 64) / 2; }
__device__ __forceinline__ int perm32(int rho) { const int n = rho >> 4, i = rho & 15; return 8 * (i >> 2) + 4 * n + (i & 3); }

struct Unit { int pm, pn, job; const bf16_t* A; const bf16_t* B; };
struct GP {
    int K, G, c, mode, ld, nM0, nN0, total;
    bf16_t* out; const bf16_t *A0, *B0, *A1, *B1, *A2, *B2, *A3, *B3; bf16_t *proj, *vt, *km, *vmt;
};
__device__ __forceinline__ bool sched_next(int i, Unit& u, int G, int c, int total, int mode, int nM0, int nN0, const bf16_t* A0, const bf16_t* B0,
                                           const bf16_t* A1, const bf16_t* B1, const bf16_t* A2, const bf16_t* B2, const bf16_t* A3, const bf16_t* B3) {
    const int L = i * G + c; if (L >= total) return false;
    int job = 0, st = 0, nM = nM0, nN = nN0; const bf16_t* pa = A0; const bf16_t* pb = B0;
    if (mode == 2) {
        if (L >= 768) { job = 1; st = 768; nM = 6; nN = 64; pa = A1; pb = B1; }
        if (L >= 1152) { job = 2; st = 1152; nM = 4; nN = 2; pa = A2; pb = B2; }
        if (L >= 1160) { job = 3; st = 1160; nM = 2; nN = 4; pa = A3; pb = B3; }
    }
    int wgid = L - st; const int nwg = nM * nN;
    { const int q = nwg / NXCD, r = nwg % NXCD, xcd = wgid % NXCD, off = wgid / NXCD; wgid = (xcd < r ? xcd * (q + 1) : r * (q + 1) + (xcd - r) * q) + off; }
    const int nig = WGM * nN, gid = wgid / nig, fm = gid * WGM, gsz = (nM - fm) < WGM ? (nM - fm) : WGM;
    u.pm = fm + ((wgid % nig) % gsz); u.pn = (wgid % nig) / gsz; u.job = job; u.A = pa; u.B = pb; return true;
}
__device__ __forceinline__ void epilogue(const f32x4 (&acc)[2][2][4][2], const Unit& u, int wr, int wc, int fr, int fq, int mode, bf16_t* out, int ld, bf16_t* proj, bf16_t* vt, bf16_t* km, bf16_t* vmt) {
    const int row0 = u.pm * BM + wr * 64 + fr, cb = wc * 32 + 8 * fq;
    if (mode == 0) {
#pragma unroll
        for (int ai = 0; ai < 2; ++ai)
#pragma unroll
            for (int m = 0; m < 4; ++m) {
                const f32x4 g0 = acc[ai][0][m][0], g1 = acc[ai][0][m][1], u0 = acc[ai][1][m][0], u1 = acc[ai][1][m][1];
                u32x4 w;
                w.x = pk2(silu_mul(g0.x, u0.x), silu_mul(g0.y, u0.y)); w.y = pk2(silu_mul(g0.z, u0.z), silu_mul(g0.w, u0.w));
                w.z = pk2(silu_mul(g1.x, u1.x), silu_mul(g1.y, u1.y)); w.w = pk2(silu_mul(g1.z, u1.z), silu_mul(g1.w, u1.w));
                *(u32x4*)(out + (size_t)(row0 + ai * HALF + m * 16) * DFF + u.pn * 128 + cb) = w;
            }
    } else {
        OutBf o; o.base = out; o.ld = ld; o.act = 0; o.sc = 1.0f;
        if (mode == 2) o = p4_sel(u.job, u.pm, u.pn, proj, vt, km, vmt);
#pragma unroll
        for (int ai = 0; ai < 2; ++ai)
#pragma unroll
            for (int m = 0; m < 4; ++m)
#pragma unroll
                for (int bj = 0; bj < 2; ++bj)
                    o.st8(row0 + ai * HALF + m * 16, u.pn * BM + bj * HALF + cb, acc[ai][bj][m][0], acc[ai][bj][m][1]);
    }
}

__device__ __forceinline__ void gemm_phase(LAS unsigned char* lds, const GP p, const int tid) {
    const int K = p.K; const size_t tstep = (size_t)256 * K * 2;
#define SNEXT(i, u) sched_next(i, u, p.G, p.c, p.total, p.mode, p.nM0, p.nN0, p.A0, p.B0, p.A1, p.B1, p.A2, p.B2, p.A3, p.B3)
#define APTR(u) ((const char*)(u).A + (size_t)(u).pm * tstep)
#define BPTR(u) ((const char*)(u).B + (size_t)(u).pn * tstep)
    const int wid = __builtin_amdgcn_readfirstlane(tid >> 6), lane = tid & 63, wr = wid >> 2, wc = wid & 3, fr = lane & 15, fq = lane >> 4;
    const int nt = K / BK;
    unsigned voffA[2], voffB[2];
#pragma unroll
    for (int i = 0; i < 2; ++i) { int R, C; stage_rc(tid * 16 + i * 8192, R, C); const int Rb = (R & ~31) + perm32(R & 31);
        voffA[i] = (unsigned)(R * K + C) * 2u; voffB[i] = (unsigned)(Rb * K + C) * 2u; }
    const size_t kstep = (size_t)(BK * 2);
    const size_t hstep = (size_t)HALF * K * 2;
    const unsigned ldsw = (unsigned)wid * 1024u;
    const int aoff = lds_byte(wr * 64 + fr, fq * 8), boff = lds_byte(wc * 32 + fr, fq * 8);
#define PG8_SA(b, h) (((b) * 2 + (h)) * HTB)
#define PG8_SB(b, h) ((4 + (b) * 2 + (h)) * HTB)
#define PG8_STAGE(bufoff, gbase, voff) do { _Pragma("unroll") for (int _i = 0; _i < 2; ++_i) \
        __builtin_amdgcn_global_load_lds((const unsigned*)((const char*)(gbase) + (voff)[_i]), (LAS unsigned*)(lds + (bufoff) + ldsw + _i * 8192), 16, 0, 0); } while (0)
#define PG8_LDA(dst, b, h) do { _Pragma("unroll") for (int m = 0; m < 4; ++m) _Pragma("unroll") for (int k = 0; k < 2; ++k) dst[m][k] = *(const LAS bf16x8*)(lds + PG8_SA(b, h) + aoff + m * 2048 + k * 1024); } while (0)
#define PG8_LDB(dst, b, h) do { _Pragma("unroll") for (int n = 0; n < 2; ++n) _Pragma("unroll") for (int k = 0; k < 2; ++k) dst[n][k] = *(const LAS bf16x8*)(lds + PG8_SB(b, h) + boff + n * 2048 + k * 1024); } while (0)
#define PG8_MMA(ai, bj, At, Bt) do { __builtin_amdgcn_s_setprio(1); _Pragma("unroll") for (int m = 0; m < 4; ++m) _Pragma("unroll") for (int n = 0; n < 2; ++n) _Pragma("unroll") for (int k = 0; k < 2; ++k) \
        acc[ai][bj][m][n] = __builtin_amdgcn_mfma_f32_16x16x32_bf16(Bt[n][k], At[m][k], acc[ai][bj][m][n], 0, 0, 0); __builtin_amdgcn_s_setprio(0); } while (0)
#define PG8_WAIT_V(n) asm volatile("s_waitcnt vmcnt(" #n ")" ::: "memory")
#define PG8_WAIT_L(n) asm volatile("s_waitcnt lgkmcnt(" #n ")" ::: "memory")
#define PG8_BAR __builtin_amdgcn_s_barrier()
#define PG8_SCHED __builtin_amdgcn_sched_barrier(0)
    Unit cur, nxt; int ui = 0;
    if (!SNEXT(0, cur)) return;
    f32x4 acc[2][2][4][2];
#pragma unroll
    for (int a = 0; a < 2; ++a)
#pragma unroll
        for (int b = 0; b < 2; ++b)
#pragma unroll
            for (int m = 0; m < 4; ++m)
#pragma unroll
                for (int n = 0; n < 2; ++n) acc[a][b][m][n] = (f32x4){0.f, 0.f, 0.f, 0.f};
    bf16x8 At[4][2], B0[2][2], B1[2][2];
    const char* cA = APTR(cur); const char* cB = BPTR(cur);
    PG8_STAGE(PG8_SB(0, 0), cB, voffB); PG8_STAGE(PG8_SB(0, 1), cB + hstep, voffB); PG8_STAGE(PG8_SA(0, 0), cA, voffA); PG8_STAGE(PG8_SA(0, 1), cA + hstep, voffA);
    if (wr == 1) PG8_BAR;
    PG8_WAIT_V(2); PG8_BAR;
    PG8_STAGE(PG8_SB(1, 0), cB + kstep, voffB); PG8_STAGE(PG8_SA(1, 0), cA + kstep, voffA); PG8_STAGE(PG8_SB(1, 1), cB + hstep + kstep, voffB);
    PG8_WAIT_V(6); PG8_BAR;
    for (;;) {
        const bool has_next = SNEXT(ui + 1, nxt);
        const char* nA = has_next ? APTR(nxt) : cA; const char* nB = has_next ? BPTR(nxt) : cB;
        for (int t = 0; t < nt; t += 2) {
            const bool last = (t == nt - 2);
            const char* a1 = cA + (size_t)(t + 1) * kstep;
            const char* a2 = last ? nA : cA + (size_t)(t + 2) * kstep; const char* b2 = last ? nB : cB + (size_t)(t + 2) * kstep;
            const char* a3 = a2 + kstep; const char* b3 = b2 + kstep;
            PG8_LDB(B0, 0, 0); PG8_LDB(B1, 0, 1); PG8_SCHED; PG8_LDA(At, 0, 0); PG8_STAGE(PG8_SA(1, 1), a1 + hstep, voffA);
            PG8_WAIT_V(8); PG8_WAIT_L(0); PG8_BAR; PG8_MMA(0, 0, At, B0); PG8_MMA(0, 1, At, B1); PG8_BAR; PG8_SCHED;
            PG8_LDA(At, 0, 1); PG8_STAGE(PG8_SB(0, 0), b2, voffB); PG8_STAGE(PG8_SB(0, 1), b2 + hstep, voffB); PG8_STAGE(PG8_SA(0, 0), a2, voffA);
            PG8_WAIT_V(8); PG8_WAIT_L(0); PG8_BAR; PG8_MMA(1, 0, At, B0); PG8_MMA(1, 1, At, B1); PG8_BAR; PG8_SCHED;
            PG8_LDB(B0, 1, 0); PG8_LDB(B1, 1, 1); PG8_SCHED; PG8_LDA(At, 1, 0); PG8_STAGE(PG8_SA(0, 1), a2 + hstep, voffA);
            PG8_WAIT_V(8); PG8_WAIT_L(0); PG8_BAR; PG8_MMA(0, 0, At, B0); PG8_MMA(0, 1, At, B1); PG8_BAR; PG8_SCHED;
            PG8_LDA(At, 1, 1); PG8_STAGE(PG8_SB(1, 0), b3, voffB); PG8_STAGE(PG8_SB(1, 1), b3 + hstep, voffB); PG8_STAGE(PG8_SA(1, 0), a3, voffA);
            PG8_WAIT_V(8); PG8_WAIT_L(0); PG8_BAR; PG8_MMA(1, 0, At, B0); PG8_MMA(1, 1, At, B1); PG8_BAR; PG8_SCHED;
        }
        if (wr == 0) PG8_BAR;
        epilogue(acc, cur, wr, wc, fr, fq, p.mode, p.out, p.ld, p.proj, p.vt, p.km, p.vmt);
        if (!has_next) break;
#pragma unroll
        for (int a = 0; a < 2; ++a)
#pragma unroll
            for (int b = 0; b < 2; ++b)
#pragma unroll
                for (int m = 0; m < 4; ++m)
#pragma unroll
                    for (int n = 0; n < 2; ++n) acc[a][b][m][n] = (f32x4){0.f, 0.f, 0.f, 0.f};
        cur = nxt; cA = nA; cB = nB; ++ui;
        if (wr == 1) PG8_BAR;
    }
    PG8_WAIT_V(0);
    PG8_BAR;
#undef SNEXT
#undef APTR
#undef BPTR
#undef PG8_SA
#undef PG8_SB
#undef PG8_STAGE
#undef PG8_LDA
#undef PG8_LDB
#undef PG8_MMA
#undef PG8_WAIT_V
#undef PG8_WAIT_L
#undef PG8_BAR
#undef PG8_SCHED
}
}

__device__ __forceinline__ void simple_gemm_job(const bf16_t* A, const bf16_t* Bt, int Mr, int Nc, int K, int job, bf16_t* proj, bf16_t* vt, bf16_t* km, bf16_t* vmt, int mode, bf16_t* out, int ld, int gw, int ngw, int lane) {
    const int fr = lane & 15, fq = lane >> 4, tn = Nc / 64, tiles = (Mr / 64) * tn;
    for (int t = gw; t < tiles; t += ngw) {
        const int row0 = (t / tn) * 64, col0 = (t % tn) * 64;
        f32x4 acc[4][4];
#pragma unroll
        for (int i = 0; i < 4; ++i)
#pragma unroll
            for (int j = 0; j < 4; ++j) acc[i][j] = (f32x4){0.f, 0.f, 0.f, 0.f};
        const bf16_t* ap = A + (size_t)(row0 + fr) * K + fq * 8; const bf16_t* bp = Bt + (size_t)(col0 + fr) * K + fq * 8;
        for (int k = 0; k < K; k += 32) {
            bf16x8 a[4], b[4];
#pragma unroll
            for (int i = 0; i < 4; ++i) { a[i] = *(const bf16x8*)(ap + (size_t)i * 16 * K + k); b[i] = *(const bf16x8*)(bp + (size_t)i * 16 * K + k); }
#pragma unroll
            for (int i = 0; i < 4; ++i)
#pragma unroll
                for (int j = 0; j < 4; ++j) acc[i][j] = mfma16(b[j], a[i], acc[i][j]);
        }
        OutBf o; o.base = out; o.ld = ld; o.act = 0; o.sc = 1.0f; if (mode == 2) o = p4_sel(job, row0 / 256, col0 / 256, proj, vt, km, vmt);
#pragma unroll
        for (int i = 0; i < 4; ++i)
#pragma unroll
            for (int j = 0; j < 4; ++j) o.st4(row0 + i * 16 + fr, col0 + j * 16 + fq * 4, acc[i][j]);
    }
}
__device__ __forceinline__ void simple_gemm_swiglu(const bf16_t* A, const bf16_t* Wt, bf16_t* H, int gw, int ngw, int lane) {
    const int fr = lane & 15, fq = lane >> 4, K = DM, tn = DFF / 32, tiles = (MTOK / 64) * tn;
    for (int t = gw; t < tiles; t += ngw) {
        const int row0 = (t / tn) * 64, h0 = (t % tn) * 32, wrow = 256 * (h0 >> 7) + (h0 & 127);
        f32x4 g[4][2], u[4][2];
#pragma unroll
        for (int i = 0; i < 4; ++i)
#pragma unroll
            for (int j = 0; j < 2; ++j) { g[i][j] = (f32x4){0.f, 0.f, 0.f, 0.f}; u[i][j] = (f32x4){0.f, 0.f, 0.f, 0.f}; }
        const bf16_t* ap = A + (size_t)(row0 + fr) * K + fq * 8; const bf16_t* bp = Wt + (size_t)(wrow + fr) * K + fq * 8;
        for (int k = 0; k < K; k += 32) {
            bf16x8 a[4], bg[2], bu[2];
#pragma unroll
            for (int i = 0; i < 4; ++i) a[i] = *(const bf16x8*)(ap + (size_t)i * 16 * K + k);
#pragma unroll
            for (int j = 0; j < 2; ++j) { bg[j] = *(const bf16x8*)(bp + (size_t)j * 16 * K + k); bu[j] = *(const bf16x8*)(bp + (size_t)(128 + j * 16) * K + k); }
#pragma unroll
            for (int i = 0; i < 4; ++i)
#pragma unroll
                for (int j = 0; j < 2; ++j) { g[i][j] = mfma16(bg[j], a[i], g[i][j]); u[i][j] = mfma16(bu[j], a[i], u[i][j]); }
        }
#pragma unroll
        for (int i = 0; i < 4; ++i)
#pragma unroll
            for (int j = 0; j < 2; ++j) {
                u32x2 w; w.x = pk2(silu_mul(g[i][j].x, u[i][j].x), silu_mul(g[i][j].y, u[i][j].y)); w.y = pk2(silu_mul(g[i][j].z, u[i][j].z), silu_mul(g[i][j].w, u[i][j].w));
                *(u32x2*)(H + (size_t)(row0 + i * 16 + fr) * DFF + h0 + j * 16 + fq * 4) = w;
            }
    }
}

__device__ __forceinline__ void transpose_item(const float* W, int K, int N, bf16_t* WT, int kb, int nbd, int src0, LAS float* scr, int lane) {
    const int k0 = kb * 64;
#pragma unroll 4
    for (int i = 0; i < 16; ++i) {
        const int kk = 4 * i + (lane >> 4);
        const f32x4 v = *(const f32x4*)(W + (size_t)(k0 + kk) * N + src0 + (lane & 15) * 4);
        LAS float* s = scr + kk * 65 + (lane & 15) * 4; s[0] = v.x; s[1] = v.y; s[2] = v.z; s[3] = v.w;
    }
    const int c = lane & 7;
#pragma unroll
    for (int jj = 0; jj < 8; ++jj) {
        const int n = (lane >> 3) + 8 * jj; const LAS float* s = scr + (8 * c) * 65 + n;
        u32x4 o; o.x = pk2(s[0], s[65]); o.y = pk2(s[2 * 65], s[3 * 65]); o.z = pk2(s[4 * 65], s[5 * 65]); o.w = pk2(s[6 * 65], s[7 * 65]);
        *(u32x4*)(WT + (size_t)(nbd * 64 + n) * K + k0 + 8 * c) = o;
    }
}
__device__ __forceinline__ int map_gu(int nb) { const int j = nb >> 2, part = nb & 3; return part < 2 ? 128 * j + 64 * part : DFF + 128 * j + 64 * (part - 2); }
__device__ __forceinline__ int map_win(int nb) { const int n = nb * 64; return n < 2048 ? n : n < 2560 ? n + 1024 : n < 3072 ? n + 1536 : n < 4096 ? n - 1024 : n - 512; }

__device__ __forceinline__ void norm_row_bf16(const float* xr, const float* g, bf16_t* o, int lane) {
    f32x4 v[8]; float s = 0.f;
#pragma unroll
    for (int j = 0; j < 8; ++j) { v[j] = *(const f32x4*)(xr + 256 * j + 4 * lane); s += (v[j].x * v[j].x + v[j].y * v[j].y) + (v[j].z * v[j].z + v[j].w * v[j].w); }
    const float rs = rsqrtf(wave_sum(s) * (1.0f / DM) + EPS);
#pragma unroll
    for (int j = 0; j < 8; ++j) { const f32x4 gv = *(const f32x4*)(g + 256 * j + 4 * lane);
        u32x2 w; w.x = pk2(v[j].x * rs * gv.x, v[j].y * rs * gv.y); w.y = pk2(v[j].z * rs * gv.z, v[j].w * rs * gv.w);
        *(u32x2*)(o + 256 * j + 4 * lane) = w; }
}
template <bool FINAL, bool HIN_F32>
__device__ __forceinline__ void resid_row(const bf16_t* f, const void* hin, bf16_t* hout, const float* gpost, float alpha, const float* gnext, bf16_t* xn, float* fin, int lane) {
    f32x4 v[8]; float s = 0.f;
#pragma unroll
    for (int j = 0; j < 8; ++j) { const u32x2 w = *(const u32x2*)(f + 256 * j + 4 * lane); v[j] = (f32x4){bflo(w.x), bfhi(w.x), bflo(w.y), bfhi(w.y)};
        s += (v[j].x * v[j].x + v[j].y * v[j].y) + (v[j].z * v[j].z + v[j].w * v[j].w); }
    f32x4 hv[8];
#pragma unroll
    for (int j = 0; j < 8; ++j) {
        if (HIN_F32) hv[j] = *(const f32x4*)((const float*)hin + 256 * j + 4 * lane);
        else { const u32x2 w = *(const u32x2*)((const bf16_t*)hin + 256 * j + 4 * lane); hv[j] = (f32x4){bflo(w.x), bfhi(w.x), bflo(w.y), bfhi(w.y)}; } }
    const float rs = rsqrtf(wave_sum(s) * (1.0f / DM) + EPS) * alpha;
    float s2 = 0.f;
#pragma unroll
    for (int j = 0; j < 8; ++j) { const f32x4 gv = *(const f32x4*)(gpost + 256 * j + 4 * lane);
        v[j] = hv[j] + v[j] * rs * gv; s2 += (v[j].x * v[j].x + v[j].y * v[j].y) + (v[j].z * v[j].z + v[j].w * v[j].w); }
    const float rs2 = rsqrtf(wave_sum(s2) * (1.0f / DM) + EPS);
#pragma unroll
    for (int j = 0; j < 8; ++j) { const f32x4 gv = *(const f32x4*)(gnext + 256 * j + 4 * lane); const f32x4 o = v[j] * rs2 * gv;
        if (FINAL) *(f32x4*)(fin + 256 * j + 4 * lane) = o;
        else { u32x2 w; w.x = pk2(o.x, o.y); w.y = pk2(o.z, o.w); *(u32x2*)(xn + 256 * j + 4 * lane) = w;
               u32x2 hw; hw.x = pk2(v[j].x, v[j].y); hw.y = pk2(v[j].z, v[j].w); *(u32x2*)(hout + 256 * j + 4 * lane) = hw; } }
}
__device__ __forceinline__ void rescale_row(bf16_t* y, const float* gna, const float* gsg, const float* gmem, int lane) {
    u32x4 w[4]; float ss[4];
#pragma unroll
    for (int j = 0; j < 4; ++j) { w[j] = *(const u32x4*)(y + 512 * j + 8 * lane);
        const float a0 = bflo(w[j].x), a1 = bfhi(w[j].x), a2 = bflo(w[j].y), a3 = bfhi(w[j].y), a4 = bflo(w[j].z), a5 = bfhi(w[j].z), a6 = bflo(w[j].w), a7 = bfhi(w[j].w);
        ss[j] = (a0 * a0 + a1 * a1) + (a2 * a2 + a3 * a3) + (a4 * a4 + a5 * a5) + (a6 * a6 + a7 * a7); }
    const float rna = rsqrtf(wave_sum(ss[0] + ss[1]) * (1.0f / 1024) + EPS), rsg = rsqrtf(wave_sum(ss[2]) * (1.0f / 512) + EPS), rme = rsqrtf(wave_sum(ss[3]) * (1.0f / 512) + EPS);
#pragma unroll
    for (int j = 0; j < 4; ++j) {
        const float* g = (j < 2 ? gna + 512 * j : j == 2 ? gsg : gmem) + 8 * lane; const float r = j < 2 ? rna : j == 2 ? rsg : rme;
        const f32x4 g0 = *(const f32x4*)g, g1 = *(const f32x4*)(g + 4);
        u32x4 o; o.x = pk2(bflo(w[j].x) * r * g0.x, bfhi(w[j].x) * r * g0.y); o.y = pk2(bflo(w[j].y) * r * g0.z, bfhi(w[j].y) * r * g0.w);
        o.z = pk2(bflo(w[j].z) * r * g1.x, bfhi(w[j].z) * r * g1.y); o.w = pk2(bflo(w[j].w) * r * g1.z, bfhi(w[j].w) * r * g1.w);
        *(u32x4*)(y + 512 * j + 8 * lane) = o; }
}

struct Ptrs {
    const float* in[25]; float* out; unsigned char* ws;
};
constexpr int VVT_LD = 136, KSTR = 272, KT_BYTES = 69632, VSTR_NA = 144, VSTR_MEM = 272, RPB_OFF = 143360;
static_assert(KT_BYTES + 512 * VSTR_NA <= RPB_OFF && KT_BYTES + 256 * VSTR_MEM <= RPB_OFF && 512 * VVT_LD * 2 <= RPB_OFF && RPB_OFF + 8 * 465 * 4 <= LDS_BYTES, "P5 LDS map");

template <bool NA>
__device__ __forceinline__ void attn_row(f32x4 (&o)[8], float& m, float& l, const bf16x8 (&qf)[4], const LAS unsigned char* kp, const LAS unsigned char* vp, const int vstr,
                                         const LAS float* br, const int qc, const int kc0  ) {
    bf16x8 kf[2][4];
#pragma unroll
    for (int a = 0; a < 2; ++a)
#pragma unroll
        for (int dc = 0; dc < 4; ++dc) kf[a][dc] = *(const LAS bf16x8*)(kp + a * 16 * KSTR + dc * 64);
    f32x4 s0 = (f32x4){0.f, 0.f, 0.f, 0.f}, s1 = (f32x4){0.f, 0.f, 0.f, 0.f};
#pragma unroll
    for (int dc = 0; dc < 4; ++dc) { s0 = mfma16(kf[0][dc], qf[dc], s0); s1 = mfma16(kf[1][dc], qf[dc], s1); }
    __builtin_amdgcn_sched_barrier(0);
    u32x2 vlo[8], vhi[8];
#pragma unroll
    for (int d = 0; d < 8; ++d) { vlo[d] = *(const LAS u32x2*)(vp + d * 16 * vstr); vhi[d] = *(const LAS u32x2*)(vp + d * 16 * vstr + 32); }
    if (NA) {
        const int cs = min(max(qc - 8, 0), 48);
#pragma unroll
        for (int e = 0; e < 4; ++e) {
            const int k0 = kc0 + e, k1 = kc0 + 16 + e;
            s0[e] = (k0 >= cs && k0 < cs + 16) ? s0[e] + br[min(max(k0 - qc, -15), 15) + 15] : -1.0e30f;
            s1[e] = (k1 >= cs && k1 < cs + 16) ? s1[e] + br[min(max(k1 - qc, -15), 15) + 15] : -1.0e30f;
        }
    }
    float mx = fmaxf(fmaxf(fmaxf(s0.x, s0.y), fmaxf(s0.z, s0.w)), fmaxf(fmaxf(s1.x, s1.y), fmaxf(s1.z, s1.w)));
    mx = fmaxf(mx, __shfl_xor(mx, 16)); mx = fmaxf(mx, __shfl_xor(mx, 32));
    const float mn = fmaxf(m, mx), alpha = fexp2(m - mn); m = mn;
#pragma unroll
    for (int e = 0; e < 4; ++e) { s0[e] = fexp2(s0[e] - mn); s1[e] = fexp2(s1[e] - mn); }
    l = l * alpha + ((s0.x + s0.y) + (s0.z + s0.w)) + ((s1.x + s1.y) + (s1.z + s1.w));
    u32x4 pw; pw.x = pk2(s0.x, s0.y); pw.y = pk2(s0.z, s0.w); pw.z = pk2(s1.x, s1.y); pw.w = pk2(s1.z, s1.w);
    const bf16x8 pb = __builtin_bit_cast(bf16x8, pw);
#pragma unroll
    for (int d = 0; d < 8; ++d) {
        u32x4 vw; vw.x = vlo[d].x; vw.y = vlo[d].y; vw.z = vhi[d].x; vw.w = vhi[d].y;
        o[d] = mfma16(__builtin_bit_cast(bf16x8, vw), pb, o[d] * alpha);
    }
}
__device__ __forceinline__ void attn_init(f32x4 (&o)[8], float& m, float& l) {
#pragma unroll
    for (int d = 0; d < 8; ++d) o[d] = (f32x4){0.f, 0.f, 0.f, 0.f};
    m = -3.0e38f; l = 0.f;
}
__device__ __forceinline__ void attn_finish(const f32x4 (&o)[8], float l, bf16_t* yp) {
    l += __shfl_xor(l, 16); l += __shfl_xor(l, 32);
    const float inv = frcp(l);
#pragma unroll
    for (int d = 0; d < 8; ++d) { u32x2 w; w.x = pk2(o[d].x * inv, o[d].y * inv); w.y = pk2(o[d].z * inv, o[d].w * inv); *(u32x2*)(yp + d * 16) = w; }
}
#define P5_LAUNDER() int tid = tid_in; asm volatile("" : "+v"(tid)); const int lane = tid & 63, fr = lane & 15, fq = lane >> 4
__device__ __forceinline__ void p5_unit(const Ptrs& P, LAS unsigned char* lds, int unit, int tid_in, int wave) {
    const bf16_t* proj = (const bf16_t*)(P.ws + WS_PROJ); const bf16_t* vt = (const bf16_t*)(P.ws + WS_VT);
    const bf16_t* km = (const bf16_t*)(P.ws + WS_KM); const bf16_t* vmt = (const bf16_t*)(P.ws + WS_VMT);
    const bf16_t* wsb = (const bf16_t*)(P.ws + WS_WSB);
    bf16_t* Y = (bf16_t*)(P.ws + WS_XN);
    const int b = unit >> 6, r = unit & 63, tok0 = b * SEQ + r * 64;
    const int rs = min(max(r - 4, 0), 56);
    LAS float* rpb = (LAS float*)(lds + RPB_OFF);
    LAS bf16_t* vvt = (LAS bf16_t*)lds;
    __syncthreads();
    for (int i = tid_in; i < 8 * 15 * 31; i += 512) rpb[i] = P.in[10][i] * LOG2E;
    for (int rep = 0; rep < P5_REP_PRE; ++rep) {
        P5_LAUNDER(); (void)fr; (void)fq;
        const int g = wave & 3, q = (wave >> 2) * 64 + lane, ctok = b * SEQ + (r >> 1) * 128;
        const bf16_t* vs = vt + (size_t)(1024 + g * 128) * VT_LD + ctok + q;
        float s = 0.f, ss = 0.f;
        LAS bf16_t* vq = vvt + (g * 128) * VVT_LD + q;
#pragma unroll 32
        for (int c = 0; c < 128; ++c) { const bf16_t xb = vs[(size_t)c * VT_LD]; const float x = bf1(xb); s += x; ss += x * x; vq[c * VVT_LD] = xb; }
        const float mu = s * (1.0f / 128), var = fmaxf(ss * (1.0f / 128) - mu * mu, 0.f), rstd = rsqrtf(var + EPS);
        const float* lg = P.in[11] + g * 128; const float* lb = P.in[12] + g * 128;
#pragma unroll 16
        for (int c = 0; c < 128; ++c) { const float x = bf1(vq[c * VVT_LD]); const float yv = (x - mu) * rstd * lg[c] + lb[c];
            vq[c * VVT_LD] = (bf16_t)(pk2(yv, 0.f) & 0xffffu); }
    }
    __syncthreads();
    for (int rep = 0; rep < P5_REP_SG; ++rep) {
        P5_LAUNDER();
        const int g = wave & 3, half = wave >> 2;
#pragma unroll 1
        for (int pb = 0; pb < 2; ++pb) {
            const int pl = half * 32 + pb * 16 + fr, pp = (r & 1) * 64 + pl;
            f32x4 acc[8];
#pragma unroll
            for (int c = 0; c < 8; ++c) acc[c] = (f32x4){0.f, 0.f, 0.f, 0.f};
#pragma unroll
            for (int qc = 0; qc < 4; ++qc) {
                const bf16x8 wf = *(const bf16x8*)(wsb + (size_t)(g * 128 + pp) * 128 + qc * 32 + fq * 8);
#pragma unroll
                for (int c = 0; c < 8; ++c) {
                    const bf16x8 af = *(const LAS bf16x8*)(vvt + (g * 128 + c * 16 + fr) * VVT_LD + qc * 32 + fq * 8);
                    acc[c] = mfma16(af, wf, acc[c]);
                }
            }
            const float bs = P.in[14][g * 128 + pp];
            const bf16_t* up = proj + ((size_t)tok0 + pl) * PROJ_LD + 2048 + g * 128 + fq * 4;
            bf16_t* yp = Y + ((size_t)tok0 + pl) * DM + 1024 + g * 128 + fq * 4;
#pragma unroll
            for (int c = 0; c < 8; ++c) { const u32x2 uw = *(const u32x2*)(up + c * 16);
                u32x2 w; w.x = pk2(bflo(uw.x) * (acc[c].x + bs), bfhi(uw.x) * (acc[c].y + bs)); w.y = pk2(bflo(uw.y) * (acc[c].z + bs), bfhi(uw.y) * (acc[c].w + bs));
                *(u32x2*)(yp + c * 16) = w; }
        }
    }
    for (int rep = 0; rep < P5_REP_NA; ++rep) {
        P5_LAUNDER();
        const int hh = wave & 3, qp = wave >> 2, qbA = 2 * qp, qbB = 2 * qp + 1;
        const int w0A = qp == 0 ? 0 : 24, w0B = qp == 0 ? 8 : 32;
        const unsigned kgo = (unsigned)((tid >> 6) * PROJ_LD + (tid & 63) * 8) * 2u, vgo = (unsigned)((tid >> 3) * VT_LD + (tid & 7) * 8) * 2u;
        const unsigned klo = (unsigned)((((tid >> 4) & 3) * 64 + (tid >> 6)) * KSTR + (tid & 15) * 16), vlo = (unsigned)((tid >> 3) * VSTR_NA + (tid & 7) * 16);
        bf16x8 qfA[4], qfB[4];
        f32x4 oA[8], oB[8]; float mA, lA, mB, lB;
        u32x4 tk[8];
        {   const size_t ktok = (size_t)b * SEQ + rs * 64;
            const char* kg = (const char*)(proj + ktok * PROJ_LD + 1024);
#pragma unroll
            for (int j = 0; j < 8; ++j) tk[j] = *(const u32x4*)(kg + (size_t)j * (8 * PROJ_LD * 2) + kgo); }
#pragma unroll 1
        for (int st = 0; st < 16; ++st) {
            const int hg = st >> 3, i = st & 7, h = hg * 4 + hh;
            if (i == 0) {
                const bf16_t* qa = proj + ((size_t)tok0 + qbA * 16 + fr) * PROJ_LD + h * 128 + fq * 8; const bf16_t* qb_ = qa + (size_t)16 * PROJ_LD;
#pragma unroll
                for (int dc = 0; dc < 4; ++dc) { qfA[dc] = *(const bf16x8*)(qa + dc * 32); qfB[dc] = *(const bf16x8*)(qb_ + dc * 32); }
                attn_init(oA, mA, lA); attn_init(oB, mB, lB);
            }
            {   u32x4 tv[8];
                const char* vg = (const char*)(vt + (size_t)(hg * 512) * VT_LD + (size_t)b * SEQ + (rs + i) * 64);
#pragma unroll
                for (int j = 0; j < 8; ++j) tv[j] = *(const u32x4*)(vg + (size_t)j * (64 * VT_LD * 2) + vgo);
                __syncthreads();
#pragma unroll
                for (int j = 0; j < 8; ++j) *(LAS u32x4*)(lds + klo + j * (8 * KSTR)) = tk[j];
#pragma unroll
                for (int j = 0; j < 8; ++j) *(LAS u32x4*)(lds + KT_BYTES + vlo + j * (64 * VSTR_NA)) = tv[j]; }
            __syncthreads();
            {   const int sn = st < 15 ? st + 1 : 15, hgn = sn >> 3, in_ = sn & 7;
                const char* kg = (const char*)(proj + ((size_t)b * SEQ + (rs + in_) * 64) * PROJ_LD + 1024 + hgn * 512);
#pragma unroll
                for (int j = 0; j < 8; ++j) tk[j] = *(const u32x4*)(kg + (size_t)j * (8 * PROJ_LD * 2) + kgo); }
            __builtin_amdgcn_sched_barrier(0);
            const LAS float* br = rpb + h * 465 + (rs - r + 7 + i) * 31;
            attn_row<true>(oA, mA, lA, qfA, lds + (hh * 64 + w0A + fr) * KSTR + fq * 16, lds + KT_BYTES + (hh * 128 + fr) * VSTR_NA + (w0A + fq * 4) * 2, VSTR_NA, br, qbA * 16 + fr, w0A + fq * 4);
            __builtin_amdgcn_sched_barrier(0);
            attn_row<true>(oB, mB, lB, qfB, lds + (hh * 64 + w0B + fr) * KSTR + fq * 16, lds + KT_BYTES + (hh * 128 + fr) * VSTR_NA + (w0B + fq * 4) * 2, VSTR_NA, br, qbB * 16 + fr, w0B + fq * 4);
            __builtin_amdgcn_sched_barrier(0);
            if (i == 7) {
                attn_finish(oA, lA, Y + ((size_t)tok0 + qbA * 16 + fr) * DM + h * 128 + fq * 4);
                attn_finish(oB, lB, Y + ((size_t)tok0 + qbB * 16 + fr) * DM + h * 128 + fq * 4);
            }
        }
    }
    for (int rep = 0; rep < P5_REP_MEM; ++rep) {
        P5_LAUNDER();
        const int hh = wave & 1, qb = wave >> 1;
        const unsigned kgo = (unsigned)((tid >> 5) * 512 + (tid & 31) * 8) * 2u, vgo = (unsigned)((tid >> 4) * 1024 + (tid & 15) * 8) * 2u;
        const unsigned klo = (unsigned)((((tid >> 4) & 1) * 128 + (tid >> 5)) * KSTR + (tid & 15) * 16), vlo = (unsigned)((tid >> 4) * VSTR_MEM + (tid & 15) * 16);
#pragma unroll 1
        for (int hp = 0; hp < 2; ++hp) {
            const int hm = hp * 2 + hh;
            bf16x8 qf[4];
            { const bf16_t* qa = proj + ((size_t)tok0 + qb * 16 + fr) * PROJ_LD + 2560 + hm * 128 + fq * 8;
#pragma unroll
              for (int dc = 0; dc < 4; ++dc) qf[dc] = *(const bf16x8*)(qa + dc * 32); }
            f32x4 o[8]; float m, l; attn_init(o, m, l);
#pragma unroll 1
            for (int kh = 0; kh < 2; ++kh) {
                const char* kg = (const char*)(km + (size_t)(b * 256 + kh * 128) * 512 + hp * 256); const char* vg = (const char*)(vmt + (size_t)(hp * 256) * 1024 + b * 256 + kh * 128);
                u32x4 tk[8];
#pragma unroll
                for (int j = 0; j < 8; ++j) tk[j] = *(const u32x4*)(kg + (size_t)j * (16 * 512 * 2) + kgo);
                __syncthreads();
#pragma unroll
                for (int j = 0; j < 8; ++j) *(LAS u32x4*)(lds + klo + j * (16 * KSTR)) = tk[j];
                __builtin_amdgcn_sched_barrier(0);
#pragma unroll
                for (int j = 0; j < 8; ++j) tk[j] = *(const u32x4*)(vg + (size_t)j * (32 * 1024 * 2) + vgo);
#pragma unroll
                for (int j = 0; j < 8; ++j) *(LAS u32x4*)(lds + KT_BYTES + vlo + j * (32 * VSTR_MEM)) = tk[j];
                __syncthreads();
#pragma unroll 1
                for (int rr = 0; rr < 4; ++rr)
                    attn_row<false>(o, m, l, qf, lds + (hh * 128 + rr * 32 + fr) * KSTR + fq * 16, lds + KT_BYTES + (hh * 128 + fr) * VSTR_MEM + (rr * 32 + fq * 4) * 2, VSTR_MEM, rpb, 0, 0);
            }
            attn_finish(o, l, Y + ((size_t)tok0 + qb * 16 + fr) * DM + 1536 + hm * 128 + fq * 4);
        }
    }
    __builtin_amdgcn_fence(__ATOMIC_RELEASE, "workgroup"); __syncthreads(); __builtin_amdgcn_fence(__ATOMIC_ACQUIRE, "workgroup");
    P5_LAUNDER(); (void)fr; (void)fq;
    for (int t = wave; t < 64; t += 8) rescale_row(Y + ((size_t)tok0 + t) * DM, P.in[15], P.in[16], P.in[17], lane);
}

__device__ __forceinline__ void naive_p5(const Ptrs& P, int gw, int ngw, int lane) {
    const bf16_t* proj = (const bf16_t*)(P.ws + WS_PROJ); const bf16_t* vt = (const bf16_t*)(P.ws + WS_VT);
    const bf16_t* km = (const bf16_t*)(P.ws + WS_KM); const bf16_t* vmt = (const bf16_t*)(P.ws + WS_VMT);
    bf16_t* Y = (bf16_t*)(P.ws + WS_XN);
    for (int task = gw; task < MTOK * 16; task += ngw) {
        const int t = task >> 4, sub = task & 15, b = t / SEQ, pos = t % SEQ;
        if (sub < 12) {
            const bool na = sub < 8; const int h = na ? sub : sub - 8;
            const unsigned qw = *(const unsigned*)(proj + (size_t)t * PROJ_LD + (na ? 0 : 2560) + h * 128 + 2 * lane);
            const float q0 = bflo(qw), q1 = bfhi(qw);
            const int r = pos >> 6, c = pos & 63, rs = min(max(r - 4, 0), 56), cs = min(max(c - 8, 0), 48);
            float m = -3.0e38f, l = 0.f, o0 = 0.f, o1 = 0.f;
            const int nk = na ? 128 : 256;
            for (int kk = 0; kk < nk; ++kk) {
                float bias = 0.f; size_t koff, voff;
                if (na) { const int kr = rs + (kk >> 4), kc = cs + (kk & 15), kt = b * SEQ + kr * 64 + kc;
                    koff = (size_t)kt * PROJ_LD + 1024 + h * 128 + 2 * lane; voff = (size_t)(h * 128 + 2 * lane) * VT_LD + kt;
                    bias = P.in[10][(h * 15 + (kr - r + 7)) * 31 + min(max(kc - c, -15), 15) + 15] * LOG2E;
                } else { koff = (size_t)(b * 256 + kk) * 512 + h * 128 + 2 * lane; voff = (size_t)(h * 128 + 2 * lane) * 1024 + b * 256 + kk; }
                const unsigned kw = *(const unsigned*)((na ? proj : km) + koff);
                const float s = wave_sum(q0 * bflo(kw) + q1 * bfhi(kw)) + bias;
                const bf16_t* vb = na ? vt : vmt; const int vl = na ? VT_LD : 1024;
                const float v0 = bf1(vb[voff]), v1 = bf1(vb[voff + vl]);
                const float mn = fmaxf(m, s), al = fexp2(m - mn), p = fexp2(s - mn); m = mn;
                l = l * al + p; o0 = o0 * al + p * v0; o1 = o1 * al + p * v1;
            }
            const float inv = 1.0f / l;
            *(unsigned*)(Y + (size_t)t * DM + (na ? 0 : 1536) + h * 128 + 2 * lane) = pk2(o0 * inv, o1 * inv);
        } else {
            const int g = sub - 12, p = pos & 127, ctok = t - p;
            float a0 = 0.f, a1 = 0.f;
            const float lg0 = P.in[11][g * 128 + 2 * lane], lg1 = P.in[11][g * 128 + 2 * lane + 1], lb0 = P.in[12][g * 128 + 2 * lane], lb1 = P.in[12][g * 128 + 2 * lane + 1];
            for (int q = 0; q < 128; ++q) {
                const float x0 = bf1(vt[(size_t)(1024 + g * 128 + 2 * lane) * VT_LD + ctok + q]), x1 = bf1(vt[(size_t)(1024 + g * 128 + 2 * lane + 1) * VT_LD + ctok + q]);
                const float mu = wave_sum(x0 + x1) * (1.0f / 128), d0 = x0 - mu, d1 = x1 - mu;
                const float rstd = rsqrtf(wave_sum(d0 * d0 + d1 * d1) * (1.0f / 128) + EPS);
                const float w = P.in[13][(size_t)(g * 128 + p) * 128 + q];
                a0 += w * (d0 * rstd * lg0 + lb0); a1 += w * (d1 * rstd * lg1 + lb1);
            }
            const float bs = P.in[14][g * 128 + p];
            const unsigned uw = *(const unsigned*)(proj + (size_t)t * PROJ_LD + 2048 + g * 128 + 2 * lane);
            *(unsigned*)(Y + (size_t)t * DM + 1024 + g * 128 + 2 * lane) = pk2(bflo(uw) * (a0 + bs), bfhi(uw) * (a1 + bs));
        }
    }
}

#define XB_TMO      128
#define XB_XCNT(j)  (256  + 64 * (j))
#define XB_XSUB(j)  (1280 + 64 * (j))
#define XB_XGEN(j)  (2304 + 64 * (j))
#define XB_TOP      3328
#define XB_TOPGEN   3392
#define XCD_BAR_WORDS 3456
#define XB_SPIN_CAP (1u << 18)
__device__ __forceinline__ unsigned xb_ld(unsigned* p)              { return __hip_atomic_load(p, __ATOMIC_RELAXED, __HIP_MEMORY_SCOPE_AGENT); }
__device__ __forceinline__ unsigned xb_add(unsigned* p, unsigned v) { return __hip_atomic_fetch_add(p, v, __ATOMIC_RELAXED, __HIP_MEMORY_SCOPE_AGENT); }
__device__ __forceinline__ unsigned xb_xcc_id() { return (unsigned)__builtin_amdgcn_s_getreg((3 << 11) | 20) & 0xFu; }
#define XB_SPIN(cond, bar) do { unsigned _sp = 0; while (cond) { __builtin_amdgcn_s_sleep(1); \
    if ((++_sp & 255u) == 0u) { if (xb_ld(&(bar)[XB_TMO])) break; if (_sp > XB_SPIN_CAP) { atomicAdd(&(bar)[XB_TMO], 1u); break; } } } } while (0)
struct XcdBarrier { unsigned* bar; unsigned x; volatile LAS unsigned* st; };
__device__ __forceinline__ XcdBarrier xcd_barrier_post(unsigned* bar, volatile LAS unsigned* st) {
    XcdBarrier b; b.bar = bar; b.x = xb_xcc_id(); b.st = st;
    if (threadIdx.x == 0) (void)xb_add(&bar[XB_XCNT(b.x)], 1u);
    return b;
}
__device__ __forceinline__ void xcd_barrier_complete(unsigned* bar, unsigned x, unsigned& nloc, unsigned& nx) {
    const unsigned G = gridDim.x * gridDim.y * gridDim.z;
    unsigned sum, cnt, mine, sp = 0u;
    for (;;) {
        sum = 0u; cnt = 0u; mine = 0u;
#pragma unroll
        for (unsigned j = 0; j < 16; ++j) { const unsigned c = xb_ld(&bar[XB_XCNT(j)]); sum += c; cnt += (c > 0u) ? 1u : 0u; mine = (j == x) ? c : mine; }
        if (sum == G) break;
        __builtin_amdgcn_s_sleep(1);
        if ((++sp & 255u) == 0u) { if (xb_ld(&bar[XB_TMO])) break; if (sp > XB_SPIN_CAP) { atomicAdd(&bar[XB_TMO], 1u); break; } }
    }
    nloc = mine > 0u ? mine : 1u; nx = cnt > 0u ? cnt : 1u;
}
__device__ __forceinline__ void xcd_barrier(const XcdBarrier& b) {
    asm volatile("s_waitcnt vmcnt(0)" ::: "memory");
    __syncthreads();
    if (threadIdx.x == 0) {
        unsigned* bar = b.bar;
        __builtin_amdgcn_s_waitcnt(0);
        unsigned nloc = b.st[0], nx = b.st[1];
        if (nloc == 0u) { xcd_barrier_complete(bar, b.x, nloc, nx); b.st[0] = nloc; b.st[1] = nx; }
        const unsigned old = xb_add(&bar[XB_XSUB(b.x)], 1u);
        const unsigned gen = old / nloc;
        if (old + 1u == (gen + 1u) * nloc) {
            __builtin_amdgcn_fence(__ATOMIC_RELEASE, "agent");
            asm volatile("s_waitcnt vmcnt(0)" ::: "memory");
            const unsigned og = xb_add(&bar[XB_TOP], 1u);
            const unsigned tg = og / nx;
            if (og + 1u == (tg + 1u) * nx) xb_add(&bar[XB_TOPGEN], 1u);
            else XB_SPIN(xb_ld(&bar[XB_TOPGEN]) == tg, bar);
            __builtin_amdgcn_fence(__ATOMIC_ACQUIRE, "agent");
            xb_add(&bar[XB_XGEN(b.x)], 1u);
            asm volatile("s_waitcnt vmcnt(0)" ::: "memory");
        } else {
            XB_SPIN(xb_ld(&bar[XB_XGEN(b.x)]) == gen, bar);
            __builtin_amdgcn_fence(__ATOMIC_ACQUIRE, "agent");
            asm volatile("s_waitcnt vmcnt(0)" ::: "memory");
        }
    }
    __syncthreads();
}

struct Args { const float* in[25]; float* out; unsigned char* ws; int ph_lo, ph_hi; };

__global__ void __launch_bounds__(512, 2) fwd_kernel(Args a) {
    extern __shared__ __attribute__((aligned(16))) unsigned char smem[];
    LAS unsigned char* lds = (LAS unsigned char*)smem;
    cg::grid_group grid = cg::this_grid();
    const int wave0 = __builtin_amdgcn_readfirstlane((int)threadIdx.x >> 6);
    const int G = gridDim.x, bid = blockIdx.x, ngw = G * 8;
    Ptrs P;
#pragma unroll
    for (int i = 0; i < 25; ++i) P.in[i] = a.in[i];
    P.out = a.out; P.ws = a.ws;
    unsigned char* ws = a.ws;
    bf16_t* XN = (bf16_t*)(ws + WS_XN); bf16_t* H = (bf16_t*)(ws + WS_H); bf16_t* F = (bf16_t*)(ws + WS_F);

    int probe_rep = 0;
    const bool multi = (a.ph_hi - a.ph_lo) > 1;
    volatile LAS unsigned* xb_st = (volatile LAS unsigned*)(lds + LDS_BYTES - 16);
    XcdBarrier bar; bar.bar = (unsigned*)(ws + WS_BAR); bar.x = 0; bar.st = xb_st;
    if (multi) { if (threadIdx.x == 0) { xb_st[0] = 0u; xb_st[1] = 0u; } __syncthreads(); bar = xcd_barrier_post((unsigned*)(ws + WS_BAR), xb_st); }
    if (a.ph_hi > 1000) grid.sync();
    if (PROBE_PH == 99) for (int i = 0; i < PROBE_N; ++i) xcd_barrier(bar);
    for (int ph = a.ph_lo; ph < a.ph_hi; ++ph) {
        if (ph == 6 && !NAIVE_P5) continue;
        int tid = wave0 * 64 + (int)__builtin_amdgcn_mbcnt_hi(~0u, __builtin_amdgcn_mbcnt_lo(~0u, 0u)); asm volatile("" : "+v"(tid));
        const int lane = tid & 63, wave = __builtin_amdgcn_readfirstlane(tid >> 6), gw = bid * 8 + wave;
        const bool is_gemm = (ph == 1 || ph == 2 || ph == 4 || ph == 7 || ph == 9 || ph == 10);
        if (is_gemm) {
            pg8::GP p; p.K = DM; p.G = G; p.c = bid; p.mode = 1; p.ld = DM; p.out = F; p.nM0 = 64; p.nN0 = 8; p.total = 512;
            p.proj = (bf16_t*)(ws + WS_PROJ); p.vt = (bf16_t*)(ws + WS_VT); p.km = (bf16_t*)(ws + WS_KM); p.vmt = (bf16_t*)(ws + WS_VMT);
            const bf16_t* win = (const bf16_t*)(ws + WS_WIN); const bf16_t* wmkv = (const bf16_t*)(ws + WS_WMKV); const bf16_t* memn = (const bf16_t*)(ws + WS_MEMN);
            p.A0 = XN; p.B0 = (const bf16_t*)(ws + WS_WOUT);
            p.A1 = win + (size_t)3072 * DM; p.B1 = XN; p.A2 = memn; p.B2 = wmkv; p.A3 = wmkv + (size_t)512 * DM; p.B3 = memn;
            if (ph == 1 || ph == 9) { p.B0 = (const bf16_t*)(ws + (ph == 1 ? WS_WGU1 : WS_WGU2)); p.nN0 = 44; p.total = 64 * 44; p.mode = 0; p.out = H; }
            else if (ph == 2 || ph == 10) { p.A0 = H; p.B0 = (const bf16_t*)(ws + (ph == 2 ? WS_WD1 : WS_WD2)); p.K = DFF; }
            else if (ph == 4) { p.B0 = win; p.nN0 = 12; p.total = 1168; p.mode = 2; }
#if NAIVE_GEMM
            if (p.mode == 0) simple_gemm_swiglu(p.A0, p.B0, H, gw, ngw, lane);
            else {
                simple_gemm_job(p.A0, p.B0, p.nM0 * 256, p.nN0 * 256, p.K, 0, p.proj, p.vt, p.km, p.vmt, p.mode, p.out, p.ld, gw, ngw, lane);
                if (p.mode == 2) {
                    simple_gemm_job(p.A1, p.B1, 6 * 256, 64 * 256, p.K, 1, p.proj, p.vt, p.km, p.vmt, 2, p.out, p.ld, gw, ngw, lane);
                    simple_gemm_job(p.A2, p.B2, 4 * 256, 2 * 256, p.K, 2, p.proj, p.vt, p.km, p.vmt, 2, p.out, p.ld, gw, ngw, lane);
                    simple_gemm_job(p.A3, p.B3, 2 * 256, 4 * 256, p.K, 3, p.proj, p.vt, p.km, p.vmt, 2, p.out, p.ld, gw, ngw, lane);
                }
            }
#else
            pg8::gemm_phase(lds, p, tid);
#endif
        } else if (ph == 0) {
            LAS float* scr = (LAS float*)(lds + wave * (64 * 65 * 4));
            constexpr int I_GU = 32 * 176, I_D = 88 * 32, I_IN = 32 * 72, I_MKV = 32 * 16, I_OUT = 32 * 32;
            constexpr int NITEMS = 2 * I_GU + 2 * I_D + I_IN + I_MKV + I_OUT;
            for (int it = gw; it < NITEMS; it += ngw) {
                int r = it;
                if (r < I_GU) { const int nb = r % 176; transpose_item(P.in[3], DM, NGU, (bf16_t*)(ws + WS_WGU1), r / 176, nb, map_gu(nb), scr, lane); continue; } r -= I_GU;
                if (r < I_GU) { const int nb = r % 176; transpose_item(P.in[21], DM, NGU, (bf16_t*)(ws + WS_WGU2), r / 176, nb, map_gu(nb), scr, lane); continue; } r -= I_GU;
                if (r < I_D) { const int nb = r % 32; transpose_item(P.in[4], DFF, DM, (bf16_t*)(ws + WS_WD1), r / 32, nb, nb * 64, scr, lane); continue; } r -= I_D;
                if (r < I_D) { const int nb = r % 32; transpose_item(P.in[22], DFF, DM, (bf16_t*)(ws + WS_WD2), r / 32, nb, nb * 64, scr, lane); continue; } r -= I_D;
                if (r < I_IN) { const int nb = r % 72; transpose_item(P.in[8], DM, 4608, (bf16_t*)(ws + WS_WIN), r / 72, nb, map_win(nb), scr, lane); continue; } r -= I_IN;
                if (r < I_MKV) { const int nb = r % 16; transpose_item(P.in[9], DM, 1024, (bf16_t*)(ws + WS_WMKV), r / 16, nb, nb * 64, scr, lane); continue; } r -= I_MKV;
                { const int nb = r % 32; transpose_item(P.in[18], DM, DM, (bf16_t*)(ws + WS_WOUT), r / 32, nb, nb * 64, scr, lane); }
            }
            for (int i = gw * 64 + lane; i < 4 * 128 * 128 / 2; i += ngw * 64) { const float2 v = *(const float2*)(P.in[13] + 2 * i); ((unsigned*)(ws + WS_WSB))[i] = pk2(v.x, v.y); }
            for (int m = gw; m < MTOK; m += ngw) norm_row_bf16(P.in[0] + (size_t)m * DM, P.in[2], XN + (size_t)m * DM, lane);
            for (int m = gw; m < 1024; m += ngw) norm_row_bf16(P.in[1] + (size_t)m * DM, P.in[7], (bf16_t*)(ws + WS_MEMN) + (size_t)m * DM, lane);
        } else if (ph == 3) {
            for (int m = gw; m < MTOK; m += ngw) resid_row<false, true>(F + (size_t)m * DM, P.in[0] + (size_t)m * DM, (bf16_t*)(P.out + (size_t)m * DM), P.in[5], 0.5f, P.in[6], XN + (size_t)m * DM, nullptr, lane);
        } else if (ph == 8) {
            for (int m = gw; m < MTOK; m += ngw) resid_row<false, false>(F + (size_t)m * DM, P.out + (size_t)m * DM, (bf16_t*)(P.out + (size_t)m * DM), P.in[19], 1.0f, P.in[20], XN + (size_t)m * DM, nullptr, lane);
        } else if (ph == 11) {
            for (int m = gw; m < MTOK; m += ngw) resid_row<true, false>(F + (size_t)m * DM, P.out + (size_t)m * DM, nullptr, P.in[23], 0.5f, P.in[24], nullptr, P.out + (size_t)m * DM, lane);
        } else if (ph == 5) {
#if NAIVE_P5
            naive_p5(P, gw, ngw, lane);
#else
            for (int u = bid; u < 256; u += G) p5_unit(P, lds, u, tid, wave);
#endif
        } else if (ph == 6) {
            for (int m = gw; m < MTOK; m += ngw) rescale_row(XN + (size_t)m * DM, P.in[15], P.in[16], P.in[17], lane);
        }
        if (ph + 1 < a.ph_hi) xcd_barrier(bar);
        if (ph == PROBE_PH && probe_rep < PROBE_N) { ++probe_rep; --ph; }
    }
}

extern "C" void kernel_launch(void* const* d_in, const int* in_sizes, int n_in, void* d_out, int out_size, void* d_ws, size_t ws_size, hipStream_t stream) {
    static int grid = 0;
    if (grid == 0) {
        if (n_in != 25 || out_size != MTOK * DM || ws_size < WS_TOTAL) { fprintf(stderr, "kernel_launch: unexpected problem (n_in %d, out %d, ws %zu < %zu)\n", n_in, out_size, ws_size, (size_t)WS_TOTAL); grid = -1; return; }
        int dev = 0, cus = 0, per_cu = 0;
        (void)hipGetDevice(&dev);
        (void)hipDeviceGetAttribute(&cus, hipDeviceAttributeMultiprocessorCount, dev);
        (void)hipFuncSetAttribute((const void*)fwd_kernel, hipFuncAttributeMaxDynamicSharedMemorySize, LDS_BYTES);
        (void)hipOccupancyMaxActiveBlocksPerMultiprocessor(&per_cu, (const void*)fwd_kernel, 512, LDS_BYTES);
        if (per_cu < 1) { fprintf(stderr, "kernel_launch: occupancy query says %d blocks per CU\n", per_cu); per_cu = 1; }
        grid = cus * 1;
        (void)hipGetLastError();
    }
    if (grid < 0) return;
    Args a{};
    for (int i = 0; i < 25; ++i) a.in[i] = (const float*)d_in[i];
    a.out = (float*)d_out; a.ws = (unsigned char*)d_ws;
#if MULTI_LAUNCH
    for (int ph = 0; ph < NPHASE; ++ph) {
        if (ph == 6 && !NAIVE_P5) continue;
        a.ph_lo = ph; a.ph_hi = ph + 1;
        hipLaunchKernelGGL(fwd_kernel, dim3(grid), dim3(512), LDS_BYTES, stream, a);
    }
#else
    a.ph_lo = 0; a.ph_hi = NPHASE;
    (void)hipMemsetAsync((unsigned char*)d_ws + WS_BAR, 0, 16384, stream);
    void* args[] = {&a};
    hipError_t e = hipLaunchCooperativeKernel((const void*)fwd_kernel, dim3(grid), dim3(512), args, LDS_BYTES, stream);
    if (e != hipSuccess) fprintf(stderr, "cooperative launch failed: %s (grid %d)\n", hipGetErrorString(e), grid);
#endif
}
```

```cpp
#include <hip/hip_runtime.h>
#include <hip/hip_cooperative_groups.h>
#include <cstdio>
namespace cg = cooperative_groups;

#ifndef MULTI_LAUNCH
#define MULTI_LAUNCH 0
#endif
#ifndef NAIVE_GEMM
#define NAIVE_GEMM 0
#endif
#ifndef NAIVE_P5
#define NAIVE_P5 0
#endif

#ifndef PROBE_PH
#define PROBE_PH (-1)
#define PROBE_N 0
#endif

#ifndef P5_REP_PRE
#define P5_REP_PRE 1
#define P5_REP_NA 1
#define P5_REP_MEM 1
#define P5_REP_SG 1
#endif
#define LAS __attribute__((address_space(3)))
typedef unsigned short bf16_t;
typedef short bf16x8 __attribute__((ext_vector_type(8)));
typedef float f32x4 __attribute__((ext_vector_type(4)));
typedef unsigned u32x4 __attribute__((ext_vector_type(4)));
typedef unsigned u32x2 __attribute__((ext_vector_type(2)));

constexpr int MTOK = 16384, DM = 2048, DFF = 5632, NGU = 11264, SEQ = 4096;
constexpr int PROJ_LD = 3072, VT_LD = 16384;
constexpr float EPS = 1e-6f;
constexpr float LOG2E = 1.4426950408889634f;
constexpr float QSCALE = 0.08838834764831845f * LOG2E;
constexpr int NPHASE = 12;
constexpr int LDS_BYTES = 156 * 1024;

constexpr size_t WS_WGU1 = 0;
constexpr size_t WS_WD1 = WS_WGU1 + (size_t)NGU * DM * 2;
constexpr size_t WS_WIN = WS_WD1 + (size_t)DM * DFF * 2;
constexpr size_t WS_WMKV = WS_WIN + (size_t)4608 * DM * 2;
constexpr size_t WS_WOUT = WS_WMKV + (size_t)1024 * DM * 2;
constexpr size_t WS_WGU2 = WS_WOUT + (size_t)DM * DM * 2;
constexpr size_t WS_WD2 = WS_WGU2 + (size_t)NGU * DM * 2;
constexpr size_t WS_WSB = WS_WD2 + (size_t)DM * DFF * 2;
constexpr size_t WS_MEMN = WS_WSB + (size_t)4 * 128 * 128 * 2;
constexpr size_t WS_KM = WS_MEMN + (size_t)1024 * DM * 2;
constexpr size_t WS_VMT = WS_KM + (size_t)1024 * 512 * 2;
constexpr size_t WS_XN = WS_VMT + (size_t)512 * 1024 * 2;
constexpr size_t WS_H = WS_XN + (size_t)MTOK * DM * 2;
constexpr size_t WS_PROJ = WS_H;
constexpr size_t WS_VT = WS_H + (size_t)MTOK * PROJ_LD * 2;
constexpr size_t WS_F = WS_H + (size_t)MTOK * DFF * 2;
constexpr size_t WS_END = WS_F + (size_t)MTOK * DM * 2;
static_assert(WS_VT + (size_t)1536 * VT_LD * 2 <= WS_F, "overlay");
constexpr size_t WS_BAR = WS_END;
constexpr size_t WS_TOTAL = WS_BAR + 16384;
static_assert(WS_TOTAL <= (size_t)536870912, "workspace");

__device__ __forceinline__ unsigned pk2(float lo, float hi) { unsigned r; asm("v_cvt_pk_bf16_f32 %0, %1, %2" : "=v"(r) : "v"(lo), "v"(hi)); return r; }
__device__ __forceinline__ float bflo(unsigned u) { return __uint_as_float(u << 16); }
__device__ __forceinline__ float bfhi(unsigned u) { return __uint_as_float(u & 0xffff0000u); }
__device__ __forceinline__ float bf1(bf16_t b) { return __uint_as_float(((unsigned)b) << 16); }
__device__ __forceinline__ float wave_sum(float v) {
#pragma unroll
    for (int o = 1; o < 64; o <<= 1) v += __shfl_xor(v, o);
    return v;
}
__device__ __forceinline__ float fexp2(float x) { return __builtin_amdgcn_exp2f(x); }
__device__ __forceinline__ float frcp(float x) { return __builtin_amdgcn_rcpf(x); }
__device__ __forceinline__ float gelu_tanh(float x) {
    const float t = x * (1.0f + 0.044715f * x * x);
    return x * frcp(1.0f + fexp2(t * (-2.0f * 0.7978845608028654f * LOG2E)));
}
__device__ __forceinline__ float silu_mul(float g, float u) { return g * frcp(1.0f + fexp2(g * (-LOG2E))) * u; }
__device__ __forceinline__ f32x4 mfma16(bf16x8 a, bf16x8 b, f32x4 c) { return __builtin_amdgcn_mfma_f32_16x16x32_bf16(a, b, c, 0, 0, 0); }

struct OutBf {
    bf16_t* base; int ld; int act; float sc;
    __device__ __forceinline__ f32x4 xf(f32x4 v) const {
        v = v * sc;
        if (act) { v.x = gelu_tanh(v.x); v.y = gelu_tanh(v.y); v.z = gelu_tanh(v.z); v.w = gelu_tanh(v.w); }
        return v;
    }
    __device__ __forceinline__ void st4(int row, int col, f32x4 v) const {
        v = xf(v); u32x2 w; w.x = pk2(v.x, v.y); w.y = pk2(v.z, v.w);
        *(u32x2*)(base + (size_t)row * ld + col) = w;
    }
    __device__ __forceinline__ void st8(int row, int col, f32x4 a, f32x4 b) const {
        a = xf(a); b = xf(b); u32x4 w; w.x = pk2(a.x, a.y); w.y = pk2(a.z, a.w); w.z = pk2(b.x, b.y); w.w = pk2(b.z, b.w);
        *(u32x4*)(base + (size_t)row * ld + col) = w;
    }
};
__device__ __forceinline__ OutBf p4_sel(int job, int pm, int pn, bf16_t* proj, bf16_t* vt, bf16_t* km, bf16_t* vmt) {
    OutBf o; o.act = 0; o.sc = 1.0f; o.base = proj; o.ld = PROJ_LD;
    if (job == 0) { if (pn < 4 || pn >= 10) o.sc = QSCALE; else if (pn >= 8) o.act = 1; }
    if (job == 1) { o.base = vt; o.ld = VT_LD; if (pm >= 4) o.act = 1; }
    if (job == 2) { o.base = km; o.ld = 512; }
    if (job == 3) { o.base = vmt; o.ld = 1024; }
    return o;
}

namespace pg8 {
constexpr int BM = 256, BK = 64, HALF = 128, HTB = HALF * BK * 2, STAGE_BYTES = 8 * HTB, NXCD = 8, WGM = 8;
__device__ __forceinline__ int lds_byte(int r, int c) { const int st = (r >> 4) * 2 + (c >> 5), rr = r & 15, cc = c & 31, ob = rr * 64 + cc * 2; return st * 1024 + (ob ^ (((ob >> 9) & 1) << 5)); }
__device__ __forceinline__ void stage_rc(int b, int& R, int& C) { const int st = b / 1024, sb = b % 1024, swz = sb ^ (((sb >> 9) & 1) << 5); R = (st >> 1) * 16 + swz / 64; C = (st & 1) * 32 + (swz % 64) / 2; }
__device__ __forceinline__ int perm32(int rho) { const int n = rho >> 4, i = rho & 15; return 8 * (i >> 2) + 4 * n + (i & 3); }

struct Unit { int pm, pn, job; const bf16_t* A; const bf16_t* B; };
struct GP {
    int K, G, c, mode, ld, nM0, nN0, total;
    bf16_t* out; const bf16_t *A0, *B0, *A1, *B1, *A2, *B2, *A3, *B3; bf16_t *proj, *vt, *km, *vmt;
};
__device__ __forceinline__ bool sched_next(int i, Unit& u, int G, int c, int total, int mode, int nM0, int nN0, const bf16_t* A0, const bf16_t* B0,
                                           const bf16_t* A1, const bf16_t* B1, const bf16_t* A2, const bf16_t* B2, const bf16_t* A3, const bf16_t* B3) {
    const int L = i * G + c; if (L >= total) return false;
    int job = 0, st = 0, nM = nM0, nN = nN0; const bf16_t* pa = A0; const bf16_t* pb = B0;
    if (mode == 2) {
        if (L >= 768) { job = 1; st = 768; nM = 6; nN = 64; pa = A1; pb = B1; }
        if (L >= 1152) { job = 2; st = 1152; nM = 4; nN = 2; pa = A2; pb = B2; }
        if (L >= 1160) { job = 3; st = 1160; nM = 2; nN = 4; pa = A3; pb = B3; }
    }
    int wgid = L - st; const int nwg = nM * nN;
    { const int q = nwg / NXCD, r = nwg % NXCD, xcd = wgid % NXCD, off = wgid / NXCD; wgid = (xcd < r ? xcd * (q + 1) : r * (q + 1) + (xcd - r) * q) + off; }
    const int nig = WGM * nN, gid = wgid / nig, fm = gid * WGM, gsz = (nM - fm) < WGM ? (nM - fm) : WGM;
    u.pm = fm + ((wgid % nig) % gsz); u.pn = (wgid % nig) / gsz; u.job = job; u.A = pa; u.B = pb; return true;
}
__device__ __forceinline__ void epilogue(const f32x4 (&acc)[2][2][4][2], const Unit& u, int wr, int wc, int fr, int fq, int mode, bf16_t* out, int ld, bf16_t* proj, bf16_t* vt, bf16_t* km, bf16_t* vmt) {
    const int row0 = u.pm * BM + wr * 64 + fr, cb = wc * 32 + 8 * fq;
    if (mode == 0) {
#pragma unroll
        for (int ai = 0; ai < 2; ++ai)
#pragma unroll
            for (int m = 0; m < 4; ++m) {
                const f32x4 g0 = acc[ai][0][m][0], g1 = acc[ai][0][m][1], u0 = acc[ai][1][m][0], u1 = acc[ai][1][m][1];
                u32x4 w;
                w.x = pk2(silu_mul(g0.x, u0.x), silu_mul(g0.y, u0.y)); w.y = pk2(silu_mul(g0.z, u0.z), silu_mul(g0.w, u0.w));
                w.z = pk2(silu_mul(g1.x, u1.x), silu_mul(g1.y, u1.y)); w.w = pk2(silu_mul(g1.z, u1.z), silu_mul(g1.w, u1.w));
                *(u32x4*)(out + (size_t)(row0 + ai * HALF + m * 16) * DFF + u.pn * 128 + cb) = w;
            }
    } else {
        OutBf o; o.base = out; o.ld = ld; o.act = 0; o.sc = 1.0f;
        if (mode == 2) o = p4_sel(u.job, u.pm, u.pn, proj, vt, km, vmt);
#pragma unroll
        for (int ai = 0; ai < 2; ++ai)
#pragma unroll
            for (int m = 0; m < 4; ++m)
#pragma unroll
                for (int bj = 0; bj < 2; ++bj)
                    o.st8(row0 + ai * HALF + m * 16, u.pn * BM + bj * HALF + cb, acc[ai][bj][m][0], acc[ai][bj][m][1]);
    }
}

__device__ __forceinline__ void gemm_phase(LAS unsigned char* lds, const GP p, const int tid) {
    const int K = p.K; const size_t tstep = (size_t)256 * K * 2;
#define SNEXT(i, u) sched_next(i, u, p.G, p.c, p.total, p.mode, p.nM0, p.nN0, p.A0, p.B0, p.A1, p.B1, p.A2, p.B2, p.A3, p.B3)
#define APTR(u) ((const char*)(u).A + (size_t)(u).pm * tstep)
#define BPTR(u) ((const char*)(u).B + (size_t)(u).pn * tstep)
    const int wid = __builtin_amdgcn_readfirstlane(tid >> 6), lane = tid & 63, wr = wid >> 2, wc = wid & 3, fr = lane & 15, fq = lane >> 4;
    const int nt = K / BK;
    unsigned voffA[2], voffB[2];
#pragma unroll
    for (int i = 0; i < 2; ++i) { int R, C; stage_rc(tid * 16 + i * 8192, R, C); const int Rb = (R & ~31) + perm32(R & 31);
        voffA[i] = (unsigned)(R * K + C) * 2u; voffB[i] = (unsigned)(Rb * K + C) * 2u; }
    const size_t kstep = (size_t)(BK * 2);
    const size_t hstep = (size_t)HALF * K * 2;
    const unsigned ldsw = (unsigned)wid * 1024u;
    const int aoff = lds_byte(wr * 64 + fr, fq * 8), boff = lds_byte(wc * 32 + fr, fq * 8);
#define PG8_SA(b, h) (((b) * 2 + (h)) * HTB)
#define PG8_SB(b, h) ((4 + (b) * 2 + (h)) * HTB)
#define PG8_STAGE(bufoff, gbase, voff) do { _Pragma("unroll") for (int _i = 0; _i < 2; ++_i) \
        __builtin_amdgcn_global_load_lds((const unsigned*)((const char*)(gbase) + (voff)[_i]), (LAS unsigned*)(lds + (bufoff) + ldsw + _i * 8192), 16, 0, 0); } while (0)
#define PG8_LDA(dst, b, h) do { _Pragma("unroll") for (int m = 0; m < 4; ++m) _Pragma("unroll") for (int k = 0; k < 2; ++k) dst[m][k] = *(const LAS bf16x8*)(lds + PG8_SA(b, h) + aoff + m * 2048 + k * 1024); } while (0)
#define PG8_LDB(dst, b, h) do { _Pragma("unroll") for (int n = 0; n < 2; ++n) _Pragma("unroll") for (int k = 0; k < 2; ++k) dst[n][k] = *(const LAS bf16x8*)(lds + PG8_SB(b, h) + boff + n * 2048 + k * 1024); } while (0)
#define PG8_MMA(ai, bj, At, Bt) do { __builtin_amdgcn_s_setprio(1); _Pragma("unroll") for (int m = 0; m < 4; ++m) _Pragma("unroll") for (int n = 0; n < 2; ++n) _Pragma("unroll") for (int k = 0; k < 2; ++k) \
        acc[ai][bj][m][n] = __builtin_amdgcn_mfma_f32_16x16x32_bf16(Bt[n][k], At[m][k], acc[ai][bj][m][n], 0, 0, 0); __builtin_amdgcn_s_setprio(0); } while (0)
#define PG8_WAIT_V(n) asm volatile("s_waitcnt vmcnt(" #n ")" ::: "memory")
#define PG8_WAIT_L(n) asm volatile("s_waitcnt lgkmcnt(" #n ")" ::: "memory")
#define PG8_BAR __builtin_amdgcn_s_barrier()
#define PG8_SCHED __builtin_amdgcn_sched_barrier(0)
    Unit cur, nxt; int ui = 0;
    if (!SNEXT(0, cur)) return;
    f32x4 acc[2][2][4][2];
#pragma unroll
    for (int a = 0; a < 2; ++a)
#pragma unroll
        for (int b = 0; b < 2; ++b)
#pragma unroll
            for (int m = 0; m < 4; ++m)
#pragma unroll
                for (int n = 0; n < 2; ++n) acc[a][b][m][n] = (f32x4){0.f, 0.f, 0.f, 0.f};
    bf16x8 At[4][2], B0[2][2], B1[2][2];
    const char* cA = APTR(cur); const char* cB = BPTR(cur);
    PG8_STAGE(PG8_SB(0, 0), cB, voffB); PG8_STAGE(PG8_SB(0, 1), cB + hstep, voffB); PG8_STAGE(PG8_SA(0, 0), cA, voffA); PG8_STAGE(PG8_SA(0, 1), cA + hstep, voffA);
    if (wr == 1) PG8_BAR;
    PG8_WAIT_V(2); PG8_BAR;
    PG8_STAGE(PG8_SB(1, 0), cB + kstep, voffB); PG8_STAGE(PG8_SA(1, 0), cA + kstep, voffA); PG8_STAGE(PG8_SB(1, 1), cB + hstep + kstep, voffB);
    PG8_WAIT_V(6); PG8_BAR;
    for (;;) {
        const bool has_next = SNEXT(ui + 1, nxt);
        const char* nA = has_next ? APTR(nxt) : cA; const char* nB = has_next ? BPTR(nxt) : cB;
        for (int t = 0; t < nt; t += 2) {
            const bool last = (t == nt - 2);
            const char* a1 = cA + (size_t)(t + 1) * kstep;
            const char* a2 = last ? nA : cA + (size_t)(t + 2) * kstep; const char* b2 = last ? nB : cB + (size_t)(t + 2) * kstep;
            const char* a3 = a2 + kstep; const char* b3 = b2 + kstep;
            PG8_LDB(B0, 0, 0); PG8_LDB(B1, 0, 1); PG8_SCHED; PG8_LDA(At, 0, 0); PG8_STAGE(PG8_SA(1, 1), a1 + hstep, voffA);
            PG8_WAIT_V(8); PG8_WAIT_L(0); PG8_BAR; PG8_MMA(0, 0, At, B0); PG8_MMA(0, 1, At, B1); PG8_BAR; PG8_SCHED;
            PG8_LDA(At, 0, 1); PG8_STAGE(PG8_SB(0, 0), b2, voffB); PG8_STAGE(PG8_SB(0, 1), b2 + hstep, voffB); PG8_STAGE(PG8_SA(0, 0), a2, voffA);
            PG8_WAIT_V(8); PG8_WAIT_L(0); PG8_BAR; PG8_MMA(1, 0, At, B0); PG8_MMA(1, 1, At, B1); PG8_BAR; PG8_SCHED;
            PG8_LDB(B0, 1, 0); PG8_LDB(B1, 1, 1); PG8_SCHED; PG8_LDA(At, 1, 0); PG8_STAGE(PG8_SA(0, 1), a2 + hstep, voffA);
            PG8_WAIT_V(8); PG8_WAIT_L(0); PG8_BAR; PG8_MMA(0, 0, At, B0); PG8_MMA(0, 1, At, B1); PG8_BAR; PG8_SCHED;
            PG8_LDA(At, 1, 1); PG8_STAGE(PG8_SB(1, 0), b3, voffB); PG8_STAGE(PG8_SB(1, 1), b3 + hstep, voffB); PG8_STAGE(PG8_SA(1, 0), a3, voffA);
            PG8_WAIT_V(8); PG8_WAIT_L(0); PG8_BAR; PG8_MMA(1, 0, At, B0); PG8_MMA(1, 1, At, B1); PG8_BAR; PG8_SCHED;
        }
        if (wr == 0) PG8_BAR;
        epilogue(acc, cur, wr, wc, fr, fq, p.mode, p.out, p.ld, p.proj, p.vt, p.km, p.vmt);
        if (!has_next) break;
#pragma unroll
        for (int a = 0; a < 2; ++a)
#pragma unroll
            for (int b = 0; b < 2; ++b)
#pragma unroll
                for (int m = 0; m < 4; ++m)
#pragma unroll
                    for (int n = 0; n < 2; ++n) acc[a][b][m][n] = (f32x4){0.f, 0.f, 0.f, 0.f};
        cur = nxt; cA = nA; cB = nB; ++ui;
        if (wr == 1) PG8_BAR;
    }
    PG8_WAIT_V(0);
    PG8_BAR;
#undef SNEXT
#undef APTR
#undef BPTR
#undef PG8_SA
#undef PG8_SB
#undef PG8_STAGE
#undef PG8_LDA
#undef PG8_LDB
#undef PG8_MMA
#undef PG8_WAIT_V
#undef PG8_WAIT_L
#undef PG8_BAR
#undef PG8_SCHED
}
}

__device__ __forceinline__ void simple_gemm_job(const bf16_t* A, const bf16_t* Bt, int Mr, int Nc, int K, int job, bf16_t* proj, bf16_t* vt, bf16_t* km, bf16_t* vmt, int mode, bf16_t* out, int ld, int gw, int ngw, int lane) {
    const int fr = lane & 15, fq = lane >> 4, tn = Nc / 64, tiles = (Mr / 64) * tn;
    for (int t = gw; t < tiles; t += ngw) {
        const int row0 = (t / tn) * 64, col0 = (t % tn) * 64;
        f32x4 acc[4][4];
#pragma unroll
        for (int i = 0; i < 4; ++i)
#pragma unroll
            for (int j = 0; j < 4; ++j) acc[i][j] = (f32x4){0.f, 0.f, 0.f, 0.f};
        const bf16_t* ap = A + (size_t)(row0 + fr) * K + fq * 8; const bf16_t* bp = Bt + (size_t)(col0 + fr) * K + fq * 8;
        for (int k = 0; k < K; k += 32) {
            bf16x8 a[4], b[4];
#pragma unroll
            for (int i = 0; i < 4; ++i) { a[i] = *(const bf16x8*)(ap + (size_t)i * 16 * K + k); b[i] = *(const bf16x8*)(bp + (size_t)i * 16 * K + k); }
#pragma unroll
            for (int i = 0; i < 4; ++i)
#pragma unroll
                for (int j = 0; j < 4; ++j) acc[i][j] = mfma16(b[j], a[i], acc[i][j]);
        }
        OutBf o; o.base = out; o.ld = ld; o.act = 0; o.sc = 1.0f; if (mode == 2) o = p4_sel(job, row0 / 256, col0 / 256, proj, vt, km, vmt);
#pragma unroll
        for (int i = 0; i < 4; ++i)
#pragma unroll
            for (int j = 0; j < 4; ++j) o.st4(row0 + i * 16 + fr, col0 + j * 16 + fq * 4, acc[i][j]);
    }
}
__device__ __forceinline__ void simple_gemm_swiglu(const bf16_t* A, const bf16_t* Wt, bf16_t* H, int gw, int ngw, int lane) {
    const int fr = lane & 15, fq = lane >> 4, K = DM, tn = DFF / 32, tiles = (MTOK / 64) * tn;
    for (int t = gw; t < tiles; t += ngw) {
        const int row0 = (t / tn) * 64, h0 = (t % tn) * 32, wrow = 256 * (h0 >> 7) + (h0 & 127);
        f32x4 g[4][2], u[4][2];
#pragma unroll
        for (int i = 0; i < 4; ++i)
#pragma unroll
            for (int j = 0; j < 2; ++j) { g[i][j] = (f32x4){0.f, 0.f, 0.f, 0.f}; u[i][j] = (f32x4){0.f, 0.f, 0.f, 0.f}; }
        const bf16_t* ap = A + (size_t)(row0 + fr) * K + fq * 8; const bf16_t* bp = Wt + (size_t)(wrow + fr) * K + fq * 8;
        for (int k = 0; k < K; k += 32) {
            bf16x8 a[4], bg[2], bu[2];
#pragma unroll
            for (int i = 0; i < 4; ++i) a[i] = *(const bf16x8*)(ap + (size_t)i * 16 * K + k);
#pragma unroll
            for (int j = 0; j < 2; ++j) { bg[j] = *(const bf16x8*)(bp + (size_t)j * 16 * K + k); bu[j] = *(const bf16x8*)(bp + (size_t)(128 + j * 16) * K + k); }
#pragma unroll
            for (int i = 0; i < 4; ++i)
#pragma unroll
                for (int j = 0; j < 2; ++j) { g[i][j] = mfma16(bg[j], a[i], g[i][j]); u[i][j] = mfma16(bu[j], a[i], u[i][j]); }
        }
#pragma unroll
        for (int i = 0; i < 4; ++i)
#pragma unroll
            for (int j = 0; j < 2; ++j) {
                u32x2 w; w.x = pk2(silu_mul(g[i][j].x, u[i][j].x), silu_mul(g[i][j].y, u[i][j].y)); w.y = pk2(silu_mul(g[i][j].z, u[i][j].z), silu_mul(g[i][j].w, u[i][j].w));
                *(u32x2*)(H + (size_t)(row0 + i * 16 + fr) * DFF + h0 + j * 16 + fq * 4) = w;
            }
    }
}

__device__ __forceinline__ void transpose_item(const float* W, int K, int N, bf16_t* WT, int kb, int nbd, int src0, LAS float* scr, int lane) {
    const int k0 = kb * 64;
    const float* wp = W + (size_t)(k0 + (lane >> 4)) * N + src0 + (lane & 15) * 4;
    f32x4 v[16];
#pragma unroll
    for (int i = 0; i < 16; ++i) v[i] = *(const f32x4*)(wp + (size_t)(4 * i) * N);
#pragma unroll
    for (int i = 0; i < 16; ++i) { LAS float* s = scr + (4 * i + (lane >> 4)) * 65 + (lane & 15) * 4; s[0] = v[i].x; s[1] = v[i].y; s[2] = v[i].z; s[3] = v[i].w; }
    const int c = lane & 7;
#pragma unroll
    for (int jj = 0; jj < 8; ++jj) {
        const int n = (lane >> 3) + 8 * jj; const LAS float* s = scr + (8 * c) * 65 + n;
        u32x4 o; o.x = pk2(s[0], s[65]); o.y = pk2(s[2 * 65], s[3 * 65]); o.z = pk2(s[4 * 65], s[5 * 65]); o.w = pk2(s[6 * 65], s[7 * 65]);
        *(u32x4*)(WT + (size_t)(nbd * 64 + n) * K + k0 + 8 * c) = o;
    }
}
__device__ __forceinline__ int map_gu(int nb) { const int j = nb >> 2, part = nb & 3; return part < 2 ? 128 * j + 64 * part : DFF + 128 * j + 64 * (part - 2); }
__device__ __forceinline__ int map_win(int nb) { const int n = nb * 64; return n < 2048 ? n : n < 2560 ? n + 1024 : n < 3072 ? n + 1536 : n < 4096 ? n - 1024 : n - 512; }

__device__ __forceinline__ void norm_row_bf16(const float* xr, const float* g, bf16_t* o, int lane) {
    f32x4 v[8]; float s = 0.f;
#pragma unroll
    for (int j = 0; j < 8; ++j) { v[j] = *(const f32x4*)(xr + 256 * j + 4 * lane); s += (v[j].x * v[j].x + v[j].y * v[j].y) + (v[j].z * v[j].z + v[j].w * v[j].w); }
    const float rs = rsqrtf(wave_sum(s) * (1.0f / DM) + EPS);
#pragma unroll
    for (int j = 0; j < 8; ++j) { const f32x4 gv = *(const f32x4*)(g + 256 * j + 4 * lane);
        u32x2 w; w.x = pk2(v[j].x * rs * gv.x, v[j].y * rs * gv.y); w.y = pk2(v[j].z * rs * gv.z, v[j].w * rs * gv.w);
        *(u32x2*)(o + 256 * j + 4 * lane) = w; }
}
template <bool FINAL, bool HIN_F32>
__device__ __forceinline__ void resid_row(const bf16_t* f, const void* hin, bf16_t* hout, const float* gpost, float alpha, const float* gnext, bf16_t* xn, float* fin, int lane) {
    f32x4 v[8]; float s = 0.f;
#pragma unroll
    for (int j = 0; j < 8; ++j) { const u32x2 w = *(const u32x2*)(f + 256 * j + 4 * lane); v[j] = (f32x4){bflo(w.x), bfhi(w.x), bflo(w.y), bfhi(w.y)};
        s += (v[j].x * v[j].x + v[j].y * v[j].y) + (v[j].z * v[j].z + v[j].w * v[j].w); }
    f32x4 hv[8];
#pragma unroll
    for (int j = 0; j < 8; ++j) {
        if (HIN_F32) hv[j] = *(const f32x4*)((const float*)hin + 256 * j + 4 * lane);
        else { const u32x2 w = *(const u32x2*)((const bf16_t*)hin + 256 * j + 4 * lane); hv[j] = (f32x4){bflo(w.x), bfhi(w.x), bflo(w.y), bfhi(w.y)}; } }
    const float rs = rsqrtf(wave_sum(s) * (1.0f / DM) + EPS) * alpha;
    float s2 = 0.f;
#pragma unroll
    for (int j = 0; j < 8; ++j) { const f32x4 gv = *(const f32x4*)(gpost + 256 * j + 4 * lane);
        v[j] = hv[j] + v[j] * rs * gv; s2 += (v[j].x * v[j].x + v[j].y * v[j].y) + (v[j].z * v[j].z + v[j].w * v[j].w); }
    const float rs2 = rsqrtf(wave_sum(s2) * (1.0f / DM) + EPS);
#pragma unroll
    for (int j = 0; j < 8; ++j) { const f32x4 gv = *(const f32x4*)(gnext + 256 * j + 4 * lane); const f32x4 o = v[j] * rs2 * gv;
        if (FINAL) *(f32x4*)(fin + 256 * j + 4 * lane) = o;
        else { u32x2 w; w.x = pk2(o.x, o.y); w.y = pk2(o.z, o.w); *(u32x2*)(xn + 256 * j + 4 * lane) = w;
               u32x2 hw; hw.x = pk2(v[j].x, v[j].y); hw.y = pk2(v[j].z, v[j].w); *(u32x2*)(hout + 256 * j + 4 * lane) = hw; } }
}
__device__ __forceinline__ void rescale_row(bf16_t* y, const float* gna, const float* gsg, const float* gmem, int lane) {
    u32x4 w[4]; float ss[4];
#pragma unroll
    for (int j = 0; j < 4; ++j) { w[j] = *(const u32x4*)(y + 512 * j + 8 * lane);
        const float a0 = bflo(w[j].x), a1 = bfhi(w[j].x), a2 = bflo(w[j].y), a3 = bfhi(w[j].y), a4 = bflo(w[j].z), a5 = bfhi(w[j].z), a6 = bflo(w[j].w), a7 = bfhi(w[j].w);
        ss[j] = (a0 * a0 + a1 * a1) + (a2 * a2 + a3 * a3) + (a4 * a4 + a5 * a5) + (a6 * a6 + a7 * a7); }
    const float rna = rsqrtf(wave_sum(ss[0] + ss[1]) * (1.0f / 1024) + EPS), rsg = rsqrtf(wave_sum(ss[2]) * (1.0f / 512) + EPS), rme = rsqrtf(wave_sum(ss[3]) * (1.0f / 512) + EPS);
#pragma unroll
    for (int j = 0; j < 4; ++j) {
        const float* g = (j < 2 ? gna + 512 * j : j == 2 ? gsg : gmem) + 8 * lane; const float r = j < 2 ? rna : j == 2 ? rsg : rme;
        const f32x4 g0 = *(const f32x4*)g, g1 = *(const f32x4*)(g + 4);
        u32x4 o; o.x = pk2(bflo(w[j].x) * r * g0.x, bfhi(w[j].x) * r * g0.y); o.y = pk2(bflo(w[j].y) * r * g0.z, bfhi(w[j].y) * r * g0.w);
        o.z = pk2(bflo(w[j].z) * r * g1.x, bfhi(w[j].z) * r * g1.y); o.w = pk2(bflo(w[j].w) * r * g1.z, bfhi(w[j].w) * r * g1.w);
        *(u32x4*)(y + 512 * j + 8 * lane) = o; }
}

struct Ptrs {
    const float* in[25]; float* out; unsigned char* ws;
};
constexpr int VVT_LD = 136, KSTR = 272, KT_BYTES = 69632, VSTR_NA = 144, VSTR_MEM = 272, RPB_OFF = 143360;
static_assert(KT_BYTES + 512 * VSTR_NA <= RPB_OFF && KT_BYTES + 256 * VSTR_MEM <= RPB_OFF && 512 * VVT_LD * 2 <= RPB_OFF && RPB_OFF + 8 * 465 * 4 <= LDS_BYTES, "P5 LDS map");

template <bool NA>
__device__ __forceinline__ void attn_row(f32x4 (&o)[8], float& m, float& l, const bf16x8 (&qf)[4], const LAS unsigned char* kp, const LAS unsigned char* vp, const int vstr,
                                         const LAS float* br, const int qc, const int kc0  ) {
    bf16x8 kf[2][4];
#pragma unroll
    for (int a = 0; a < 2; ++a)
#pragma unroll
        for (int dc = 0; dc < 4; ++dc) kf[a][dc] = *(const LAS bf16x8*)(kp + a * 16 * KSTR + dc * 64);
    f32x4 s0 = (f32x4){0.f, 0.f, 0.f, 0.f}, s1 = (f32x4){0.f, 0.f, 0.f, 0.f};
#pragma unroll
    for (int dc = 0; dc < 4; ++dc) { s0 = mfma16(kf[0][dc], qf[dc], s0); s1 = mfma16(kf[1][dc], qf[dc], s1); }
    __builtin_amdgcn_sched_barrier(0);
    u32x2 vlo[8], vhi[8];
#pragma unroll
    for (int d = 0; d < 8; ++d) { vlo[d] = *(const LAS u32x2*)(vp + d * 16 * vstr); vhi[d] = *(const LAS u32x2*)(vp + d * 16 * vstr + 32); }
    if (NA) {
        const int cs = min(max(qc - 8, 0), 48);
#pragma unroll
        for (int e = 0; e < 4; ++e) {
            const int k0 = kc0 + e, k1 = kc0 + 16 + e;
            s0[e] = (k0 >= cs && k0 < cs + 16) ? s0[e] + br[min(max(k0 - qc, -15), 15) + 15] : -1.0e30f;
            s1[e] = (k1 >= cs && k1 < cs + 16) ? s1[e] + br[min(max(k1 - qc, -15), 15) + 15] : -1.0e30f;
        }
    }
    float mx = fmaxf(fmaxf(fmaxf(s0.x, s0.y), fmaxf(s0.z, s0.w)), fmaxf(fmaxf(s1.x, s1.y), fmaxf(s1.z, s1.w)));
    mx = fmaxf(mx, __shfl_xor(mx, 16)); mx = fmaxf(mx, __shfl_xor(mx, 32));
    const float mn = fmaxf(m, mx), alpha = fexp2(m - mn); m = mn;
#pragma unroll
    for (int e = 0; e < 4; ++e) { s0[e] = fexp2(s0[e] - mn); s1[e] = fexp2(s1[e] - mn); }
    l = l * alpha + ((s0.x + s0.y) + (s0.z + s0.w)) + ((s1.x + s1.y) + (s1.z + s1.w));
    u32x4 pw; pw.x = pk2(s0.x, s0.y); pw.y = pk2(s0.z, s0.w); pw.z = pk2(s1.x, s1.y); pw.w = pk2(s1.z, s1.w);
    const bf16x8 pb = __builtin_bit_cast(bf16x8, pw);
#pragma unroll
    for (int d = 0; d < 8; ++d) {
        u32x4 vw; vw.x = vlo[d].x; vw.y = vlo[d].y; vw.z = vhi[d].x; vw.w = vhi[d].y;
        o[d] = mfma16(__builtin_bit_cast(bf16x8, vw), pb, o[d] * alpha);
    }
}
__device__ __forceinline__ void attn_init(f32x4 (&o)[8], float& m, float& l) {
#pragma unroll
    for (int d = 0; d < 8; ++d) o[d] = (f32x4){0.f, 0.f, 0.f, 0.f};
    m = -3.0e38f; l = 0.f;
}
__device__ __forceinline__ void attn_finish(const f32x4 (&o)[8], float l, bf16_t* yp) {
    l += __shfl_xor(l, 16); l += __shfl_xor(l, 32);
    const float inv = frcp(l);
#pragma unroll
    for (int d = 0; d < 8; ++d) { u32x2 w; w.x = pk2(o[d].x * inv, o[d].y * inv); w.y = pk2(o[d].z * inv, o[d].w * inv); *(u32x2*)(yp + d * 16) = w; }
}
#define P5_LAUNDER() int tid = tid_in; asm volatile("" : "+v"(tid)); const int lane = tid & 63, fr = lane & 15, fq = lane >> 4
__device__ __forceinline__ void p5_unit(const Ptrs& P, LAS unsigned char* lds, int unit, int tid_in, int wave) {
    const bf16_t* proj = (const bf16_t*)(P.ws + WS_PROJ); const bf16_t* vt = (const bf16_t*)(P.ws + WS_VT);
    const bf16_t* km = (const bf16_t*)(P.ws + WS_KM); const bf16_t* vmt = (const bf16_t*)(P.ws + WS_VMT);
    const bf16_t* wsb = (const bf16_t*)(P.ws + WS_WSB);
    bf16_t* Y = (bf16_t*)(P.ws + WS_XN);
    const int b = unit >> 6, r = unit & 63, tok0 = b * SEQ + r * 64;
    const int rs = min(max(r - 4, 0), 56);
    LAS float* rpb = (LAS float*)(lds + RPB_OFF);
    LAS bf16_t* vvt = (LAS bf16_t*)lds;
    __syncthreads();
    for (int i = tid_in; i < 8 * 15 * 31; i += 512) rpb[i] = P.in[10][i] * LOG2E;
    for (int rep = 0; rep < P5_REP_PRE; ++rep) {
        P5_LAUNDER(); (void)fr; (void)fq;
        const int g = wave & 3, q = (wave >> 2) * 64 + lane, ctok = b * SEQ + (r >> 1) * 128;
        const bf16_t* vs = vt + (size_t)(1024 + g * 128) * VT_LD + ctok + q;
        float s = 0.f, ss = 0.f;
        LAS bf16_t* vq = vvt + (g * 128) * VVT_LD + q;
#pragma unroll 32
        for (int c = 0; c < 128; ++c) { const bf16_t xb = vs[(size_t)c * VT_LD]; const float x = bf1(xb); s += x; ss += x * x; vq[c * VVT_LD] = xb; }
        const float mu = s * (1.0f / 128), var = fmaxf(ss * (1.0f / 128) - mu * mu, 0.f), rstd = rsqrtf(var + EPS);
        const float* lg = P.in[11] + g * 128; const float* lb = P.in[12] + g * 128;
#pragma unroll 16
        for (int c = 0; c < 128; ++c) { const float x = bf1(vq[c * VVT_LD]); const float yv = (x - mu) * rstd * lg[c] + lb[c];
            vq[c * VVT_LD] = (bf16_t)(pk2(yv, 0.f) & 0xffffu); }
    }
    __syncthreads();
    for (int rep = 0; rep < P5_REP_SG; ++rep) {
        P5_LAUNDER();
        const int g = wave & 3, half = wave >> 2;
#pragma unroll 1
        for (int pb = 0; pb < 2; ++pb) {
            const int pl = half * 32 + pb * 16 + fr, pp = (r & 1) * 64 + pl;
            f32x4 acc[8];
#pragma unroll
            for (int c = 0; c < 8; ++c) acc[c] = (f32x4){0.f, 0.f, 0.f, 0.f};
#pragma unroll
            for (int qc = 0; qc < 4; ++qc) {
                const bf16x8 wf = *(const bf16x8*)(wsb + (size_t)(g * 128 + pp) * 128 + qc * 32 + fq * 8);
#pragma unroll
                for (int c = 0; c < 8; ++c) {
                    const bf16x8 af = *(const LAS bf16x8*)(vvt + (g * 128 + c * 16 + fr) * VVT_LD + qc * 32 + fq * 8);
                    acc[c] = mfma16(af, wf, acc[c]);
                }
            }
            const float bs = P.in[14][g * 128 + pp];
            const bf16_t* up = proj + ((size_t)tok0 + pl) * PROJ_LD + 2048 + g * 128 + fq * 4;
            bf16_t* yp = Y + ((size_t)tok0 + pl) * DM + 1024 + g * 128 + fq * 4;
#pragma unroll
            for (int c = 0; c < 8; ++c) { const u32x2 uw = *(const u32x2*)(up + c * 16);
                u32x2 w; w.x = pk2(bflo(uw.x) * (acc[c].x + bs), bfhi(uw.x) * (acc[c].y + bs)); w.y = pk2(bflo(uw.y) * (acc[c].z + bs), bfhi(uw.y) * (acc[c].w + bs));
                *(u32x2*)(yp + c * 16) = w; }
        }
    }
    for (int rep = 0; rep < P5_REP_NA; ++rep) {
        P5_LAUNDER();
        const int hh = wave & 3, qp = wave >> 2, qbA = 2 * qp, qbB = 2 * qp + 1;
        const int w0A = qp == 0 ? 0 : 24, w0B = qp == 0 ? 8 : 32;
        const unsigned kgo = (unsigned)((tid >> 6) * PROJ_LD + (tid & 63) * 8) * 2u, vgo = (unsigned)((tid >> 3) * VT_LD + (tid & 7) * 8) * 2u;
        const unsigned klo = (unsigned)((((tid >> 4) & 3) * 64 + (tid >> 6)) * KSTR + (tid & 15) * 16), vlo = (unsigned)((tid >> 3) * VSTR_NA + (tid & 7) * 16);
        bf16x8 qfA[4], qfB[4];
        f32x4 oA[8], oB[8]; float mA, lA, mB, lB;
        u32x4 tk[8];
        {   const size_t ktok = (size_t)b * SEQ + rs * 64;
            const char* kg = (const char*)(proj + ktok * PROJ_LD + 1024);
#pragma unroll
            for (int j = 0; j < 8; ++j) tk[j] = *(const u32x4*)(kg + (size_t)j * (8 * PROJ_LD * 2) + kgo); }
#pragma unroll 1
        for (int st = 0; st < 16; ++st) {
            const int hg = st >> 3, i = st & 7, h = hg * 4 + hh;
            if (i == 0) {
                const bf16_t* qa = proj + ((size_t)tok0 + qbA * 16 + fr) * PROJ_LD + h * 128 + fq * 8; const bf16_t* qb_ = qa + (size_t)16 * PROJ_LD;
#pragma unroll
                for (int dc = 0; dc < 4; ++dc) { qfA[dc] = *(const bf16x8*)(qa + dc * 32); qfB[dc] = *(const bf16x8*)(qb_ + dc * 32); }
                attn_init(oA, mA, lA); attn_init(oB, mB, lB);
            }
            {   u32x4 tv[8];
                const char* vg = (const char*)(vt + (size_t)(hg * 512) * VT_LD + (size_t)b * SEQ + (rs + i) * 64);
#pragma unroll
                for (int j = 0; j < 8; ++j) tv[j] = *(const u32x4*)(vg + (size_t)j * (64 * VT_LD * 2) + vgo);
                __syncthreads();
#pragma unroll
                for (int j = 0; j < 8; ++j) *(LAS u32x4*)(lds + klo + j * (8 * KSTR)) = tk[j];
#pragma unroll
                for (int j = 0; j < 8; ++j) *(LAS u32x4*)(lds + KT_BYTES + vlo + j * (64 * VSTR_NA)) = tv[j]; }
            __syncthreads();
            {   const int sn = st < 15 ? st + 1 : 15, hgn = sn >> 3, in_ = sn & 7;
                const char* kg = (const char*)(proj + ((size_t)b * SEQ + (rs + in_) * 64) * PROJ_LD + 1024 + hgn * 512);
#pragma unroll
                for (int j = 0; j < 8; ++j) tk[j] = *(const u32x4*)(kg + (size_t)j * (8 * PROJ_LD * 2) + kgo); }
            __builtin_amdgcn_sched_barrier(0);
            const LAS float* br = rpb + h * 465 + (rs - r + 7 + i) * 31;
            attn_row<true>(oA, mA, lA, qfA, lds + (hh * 64 + w0A + fr) * KSTR + fq * 16, lds + KT_BYTES + (hh * 128 + fr) * VSTR_NA + (w0A + fq * 4) * 2, VSTR_NA, br, qbA * 16 + fr, w0A + fq * 4);
            __builtin_amdgcn_sched_barrier(0);
            attn_row<true>(oB, mB, lB, qfB, lds + (hh * 64 + w0B + fr) * KSTR + fq * 16, lds + KT_BYTES + (hh * 128 + fr) * VSTR_NA + (w0B + fq * 4) * 2, VSTR_NA, br, qbB * 16 + fr, w0B + fq * 4);
            __builtin_amdgcn_sched_barrier(0);
            if (i == 7) {
                attn_finish(oA, lA, Y + ((size_t)tok0 + qbA * 16 + fr) * DM + h * 128 + fq * 4);
                attn_finish(oB, lB, Y + ((size_t)tok0 + qbB * 16 + fr) * DM + h * 128 + fq * 4);
            }
        }
    }
    for (int rep = 0; rep < P5_REP_MEM; ++rep) {
        P5_LAUNDER();
        const int hh = wave & 1, qb = wave >> 1;
        const unsigned kgo = (unsigned)((tid >> 5) * 512 + (tid & 31) * 8) * 2u, vgo = (unsigned)((tid >> 4) * 1024 + (tid & 15) * 8) * 2u;
        const unsigned klo = (unsigned)((((tid >> 4) & 1) * 128 + (tid >> 5)) * KSTR + (tid & 15) * 16), vlo = (unsigned)((tid >> 4) * VSTR_MEM + (tid & 15) * 16);
#pragma unroll 1
        for (int hp = 0; hp < 2; ++hp) {
            const int hm = hp * 2 + hh;
            bf16x8 qf[4];
            { const bf16_t* qa = proj + ((size_t)tok0 + qb * 16 + fr) * PROJ_LD + 2560 + hm * 128 + fq * 8;
#pragma unroll
              for (int dc = 0; dc < 4; ++dc) qf[dc] = *(const bf16x8*)(qa + dc * 32); }
            f32x4 o[8]; float m, l; attn_init(o, m, l);
#pragma unroll 1
            for (int kh = 0; kh < 2; ++kh) {
                const char* kg = (const char*)(km + (size_t)(b * 256 + kh * 128) * 512 + hp * 256); const char* vg = (const char*)(vmt + (size_t)(hp * 256) * 1024 + b * 256 + kh * 128);
                u32x4 tk[8];
#pragma unroll
                for (int j = 0; j < 8; ++j) tk[j] = *(const u32x4*)(kg + (size_t)j * (16 * 512 * 2) + kgo);
                __syncthreads();
#pragma unroll
                for (int j = 0; j < 8; ++j) *(LAS u32x4*)(lds + klo + j * (16 * KSTR)) = tk[j];
                __builtin_amdgcn_sched_barrier(0);
#pragma unroll
                for (int j = 0; j < 8; ++j) tk[j] = *(const u32x4*)(vg + (size_t)j * (32 * 1024 * 2) + vgo);
#pragma unroll
                for (int j = 0; j < 8; ++j) *(LAS u32x4*)(lds + KT_BYTES + vlo + j * (32 * VSTR_MEM)) = tk[j];
                __syncthreads();
#pragma unroll 1
                for (int rr = 0; rr < 4; ++rr)
                    attn_row<false>(o, m, l, qf, lds + (hh * 128 + rr * 32 + fr) * KSTR + fq * 16, lds + KT_BYTES + (hh * 128 + fr) * VSTR_MEM + (rr * 32 + fq * 4) * 2, VSTR_MEM, rpb, 0, 0);
            }
            attn_finish(o, l, Y + ((size_t)tok0 + qb * 16 + fr) * DM + 1536 + hm * 128 + fq * 4);
        }
    }
    __builtin_amdgcn_fence(__ATOMIC_RELEASE, "workgroup"); __syncthreads(); __builtin_amdgcn_fence(__ATOMIC_ACQUIRE, "workgroup");
    P5_LAUNDER(); (void)fr; (void)fq;
    for (int t = wave; t < 64; t += 8) rescale_row(Y + ((size_t)tok0 + t) * DM, P.in[15], P.in[16], P.in[17], lane);
}

__device__ __forceinline__ void naive_p5(const Ptrs& P, int gw, int ngw, int lane) {
    const bf16_t* proj = (const bf16_t*)(P.ws + WS_PROJ); const bf16_t* vt = (const bf16_t*)(P.ws + WS_VT);
    const bf16_t* km = (const bf16_t*)(P.ws + WS_KM); const bf16_t* vmt = (const bf16_t*)(P.ws + WS_VMT);
    bf16_t* Y = (bf16_t*)(P.ws + WS_XN);
    for (int task = gw; task < MTOK * 16; task += ngw) {
        const int t = task >> 4, sub = task & 15, b = t / SEQ, pos = t % SEQ;
        if (sub < 12) {
            const bool na = sub < 8; const int h = na ? sub : sub - 8;
            const unsigned qw = *(const unsigned*)(proj + (size_t)t * PROJ_LD + (na ? 0 : 2560) + h * 128 + 2 * lane);
            const float q0 = bflo(qw), q1 = bfhi(qw);
            const int r = pos >> 6, c = pos & 63, rs = min(max(r - 4, 0), 56), cs = min(max(c - 8, 0), 48);
            float m = -3.0e38f, l = 0.f, o0 = 0.f, o1 = 0.f;
            const int nk = na ? 128 : 256;
            for (int kk = 0; kk < nk; ++kk) {
                float bias = 0.f; size_t koff, voff;
                if (na) { const int kr = rs + (kk >> 4), kc = cs + (kk & 15), kt = b * SEQ + kr * 64 + kc;
                    koff = (size_t)kt * PROJ_LD + 1024 + h * 128 + 2 * lane; voff = (size_t)(h * 128 + 2 * lane) * VT_LD + kt;
                    bias = P.in[10][(h * 15 + (kr - r + 7)) * 31 + min(max(kc - c, -15), 15) + 15] * LOG2E;
                } else { koff = (size_t)(b * 256 + kk) * 512 + h * 128 + 2 * lane; voff = (size_t)(h * 128 + 2 * lane) * 1024 + b * 256 + kk; }
                const unsigned kw = *(const unsigned*)((na ? proj : km) + koff);
                const float s = wave_sum(q0 * bflo(kw) + q1 * bfhi(kw)) + bias;
                const bf16_t* vb = na ? vt : vmt; const int vl = na ? VT_LD : 1024;
                const float v0 = bf1(vb[voff]), v1 = bf1(vb[voff + vl]);
                const float mn = fmaxf(m, s), al = fexp2(m - mn), p = fexp2(s - mn); m = mn;
                l = l * al + p; o0 = o0 * al + p * v0; o1 = o1 * al + p * v1;
            }
            const float inv = 1.0f / l;
            *(unsigned*)(Y + (size_t)t * DM + (na ? 0 : 1536) + h * 128 + 2 * lane) = pk2(o0 * inv, o1 * inv);
        } else {
            const int g = sub - 12, p = pos & 127, ctok = t - p;
            float a0 = 0.f, a1 = 0.f;
            const float lg0 = P.in[11][g * 128 + 2 * lane], lg1 = P.in[11][g * 128 + 2 * lane + 1], lb0 = P.in[12][g * 128 + 2 * lane], lb1 = P.in[12][g * 128 + 2 * lane + 1];
            for (int q = 0; q < 128; ++q) {
                const float x0 = bf1(vt[(size_t)(1024 + g * 128 + 2 * lane) * VT_LD + ctok + q]), x1 = bf1(vt[(size_t)(1024 + g * 128 + 2 * lane + 1) * VT_LD + ctok + q]);
                const float mu = wave_sum(x0 + x1) * (1.0f / 128), d0 = x0 - mu, d1 = x1 - mu;
                const float rstd = rsqrtf(wave_sum(d0 * d0 + d1 * d1) * (1.0f / 128) + EPS);
                const float w = P.in[13][(size_t)(g * 128 + p) * 128 + q];
                a0 += w * (d0 * rstd * lg0 + lb0); a1 += w * (d1 * rstd * lg1 + lb1);
            }
            const float bs = P.in[14][g * 128 + p];
            const unsigned uw = *(const unsigned*)(proj + (size_t)t * PROJ_LD + 2048 + g * 128 + 2 * lane);
            *(unsigned*)(Y + (size_t)t * DM + 1024 + g * 128 + 2 * lane) = pk2(bflo(uw) * (a0 + bs), bfhi(uw) * (a1 + bs));
        }
    }
}

#define XB_TMO      128
#define XB_XCNT(j)  (256  + 64 * (j))
#define XB_XSUB(j)  (1280 + 64 * (j))
#define XB_XGEN(j)  (2304 + 64 * (j))
#define XB_TOP      3328
#define XB_TOPGEN   3392
#define XCD_BAR_WORDS 3456
#define XB_SPIN_CAP (1u << 18)
__device__ __forceinline__ unsigned xb_ld(unsigned* p)              { return __hip_atomic_load(p, __ATOMIC_RELAXED, __HIP_MEMORY_SCOPE_AGENT); }
__device__ __forceinline__ unsigned xb_add(unsigned* p, unsigned v) { return __hip_atomic_fetch_add(p, v, __ATOMIC_RELAXED, __HIP_MEMORY_SCOPE_AGENT); }
__device__ __forceinline__ unsigned xb_xcc_id() { return (unsigned)__builtin_amdgcn_s_getreg((3 << 11) | 20) & 0xFu; }
#define XB_SPIN(cond, bar) do { unsigned _sp = 0; while (cond) { __builtin_amdgcn_s_sleep(1); \
    if ((++_sp & 255u) == 0u) { if (xb_ld(&(bar)[XB_TMO])) break; if (_sp > XB_SPIN_CAP) { atomicAdd(&(bar)[XB_TMO], 1u); break; } } } } while (0)
struct XcdBarrier { unsigned* bar; unsigned x; volatile LAS unsigned* st; };
__device__ __forceinline__ XcdBarrier xcd_barrier_post(unsigned* bar, volatile LAS unsigned* st) {
    XcdBarrier b; b.bar = bar; b.x = xb_xcc_id(); b.st = st;
    if (threadIdx.x == 0) (void)xb_add(&bar[XB_XCNT(b.x)], 1u);
    return b;
}
__device__ __forceinline__ void xcd_barrier_complete(unsigned* bar, unsigned x, unsigned& nloc, unsigned& nx) {
    const unsigned G = gridDim.x * gridDim.y * gridDim.z;
    unsigned sum, cnt, mine, sp = 0u;
    for (;;) {
        sum = 0u; cnt = 0u; mine = 0u;
#pragma unroll
        for (unsigned j = 0; j < 16; ++j) { const unsigned c = xb_ld(&bar[XB_XCNT(j)]); sum += c; cnt += (c > 0u) ? 1u : 0u; mine = (j == x) ? c : mine; }
        if (sum == G) break;
        __builtin_amdgcn_s_sleep(1);
        if ((++sp & 255u) == 0u) { if (xb_ld(&bar[XB_TMO])) break; if (sp > XB_SPIN_CAP) { atomicAdd(&bar[XB_TMO], 1u); break; } }
    }
    nloc = mine > 0u ? mine : 1u; nx = cnt > 0u ? cnt : 1u;
}
__device__ __forceinline__ void xcd_barrier(const XcdBarrier& b) {
    asm volatile("s_waitcnt vmcnt(0)" ::: "memory");
    __syncthreads();
    if (threadIdx.x == 0) {
        unsigned* bar = b.bar;
        __builtin_amdgcn_s_waitcnt(0);
        unsigned nloc = b.st[0], nx = b.st[1];
        if (nloc == 0u) { xcd_barrier_complete(bar, b.x, nloc, nx); b.st[0] = nloc; b.st[1] = nx; }
        const unsigned old = xb_add(&bar[XB_XSUB(b.x)], 1u);
        const unsigned gen = old / nloc;
        if (old + 1u == (gen + 1u) * nloc) {
            __builtin_amdgcn_fence(__ATOMIC_RELEASE, "agent");
            asm volatile("s_waitcnt vmcnt(0)" ::: "memory");
            const unsigned og = xb_add(&bar[XB_TOP], 1u);
            const unsigned tg = og / nx;
            if (og + 1u == (tg + 1u) * nx) xb_add(&bar[XB_TOPGEN], 1u);
            else XB_SPIN(xb_ld(&bar[XB_TOPGEN]) == tg, bar);
            __builtin_amdgcn_fence(__ATOMIC_ACQUIRE, "agent");
            xb_add(&bar[XB_XGEN(b.x)], 1u);
            asm volatile("s_waitcnt vmcnt(0)" ::: "memory");
        } else {
            XB_SPIN(xb_ld(&bar[XB_XGEN(b.x)]) == gen, bar);
            __builtin_amdgcn_fence(__ATOMIC_ACQUIRE, "agent");
            asm volatile("s_waitcnt vmcnt(0)" ::: "memory");
        }
    }
    __syncthreads();
}

struct Args { const float* in[25]; float* out; unsigned char* ws; int ph_lo, ph_hi; };

__global__ void __launch_bounds__(512, 2) fwd_kernel(Args a) {
    extern __shared__ __attribute__((aligned(16))) unsigned char smem[];
    LAS unsigned char* lds = (LAS unsigned char*)smem;
    cg::grid_group grid = cg::this_grid();
    const int wave0 = __builtin_amdgcn_readfirstlane((int)threadIdx.x >> 6);
    const int G = gridDim.x, bid = blockIdx.x, ngw = G * 8;
    Ptrs P;
#pragma unroll
    for (int i = 0; i < 25; ++i) P.in[i] = a.in[i];
    P.out = a.out; P.ws = a.ws;
    unsigned char* ws = a.ws;
    bf16_t* XN = (bf16_t*)(ws + WS_XN); bf16_t* H = (bf16_t*)(ws + WS_H); bf16_t* F = (bf16_t*)(ws + WS_F);

    int probe_rep = 0;
    const bool multi = (a.ph_hi - a.ph_lo) > 1;
    volatile LAS unsigned* xb_st = (volatile LAS unsigned*)(lds + LDS_BYTES - 16);
    XcdBarrier bar; bar.bar = (unsigned*)(ws + WS_BAR); bar.x = 0; bar.st = xb_st;
    if (multi) { if (threadIdx.x == 0) { xb_st[0] = 0u; xb_st[1] = 0u; } __syncthreads(); bar = xcd_barrier_post((unsigned*)(ws + WS_BAR), xb_st); }
    if (a.ph_hi > 1000) grid.sync();
    if (PROBE_PH == 99) for (int i = 0; i < PROBE_N; ++i) xcd_barrier(bar);
    for (int ph = a.ph_lo; ph < a.ph_hi; ++ph) {
        if (ph == 6 && !NAIVE_P5) continue;
        int tid = wave0 * 64 + (int)__builtin_amdgcn_mbcnt_hi(~0u, __builtin_amdgcn_mbcnt_lo(~0u, 0u)); asm volatile("" : "+v"(tid));
        const int lane = tid & 63, wave = __builtin_amdgcn_readfirstlane(tid >> 6), gw = bid * 8 + wave;
        const bool is_gemm = (ph == 1 || ph == 2 || ph == 4 || ph == 7 || ph == 9 || ph == 10);
        if (is_gemm) {
            pg8::GP p; p.K = DM; p.G = G; p.c = bid; p.mode = 1; p.ld = DM; p.out = F; p.nM0 = 64; p.nN0 = 8; p.total = 512;
            p.proj = (bf16_t*)(ws + WS_PROJ); p.vt = (bf16_t*)(ws + WS_VT); p.km = (bf16_t*)(ws + WS_KM); p.vmt = (bf16_t*)(ws + WS_VMT);
            const bf16_t* win = (const bf16_t*)(ws + WS_WIN); const bf16_t* wmkv = (const bf16_t*)(ws + WS_WMKV); const bf16_t* memn = (const bf16_t*)(ws + WS_MEMN);
            p.A0 = XN; p.B0 = (const bf16_t*)(ws + WS_WOUT);
            p.A1 = win + (size_t)3072 * DM; p.B1 = XN; p.A2 = memn; p.B2 = wmkv; p.A3 = wmkv + (size_t)512 * DM; p.B3 = memn;
            if (ph == 1 || ph == 9) { p.B0 = (const bf16_t*)(ws + (ph == 1 ? WS_WGU1 : WS_WGU2)); p.nN0 = 44; p.total = 64 * 44; p.mode = 0; p.out = H; }
            else if (ph == 2 || ph == 10) { p.A0 = H; p.B0 = (const bf16_t*)(ws + (ph == 2 ? WS_WD1 : WS_WD2)); p.K = DFF; }
            else if (ph == 4) { p.B0 = win; p.nN0 = 12; p.total = 1168; p.mode = 2; }
#if NAIVE_GEMM
            if (p.mode == 0) simple_gemm_swiglu(p.A0, p.B0, H, gw, ngw, lane);
            else {
                simple_gemm_job(p.A0, p.B0, p.nM0 * 256, p.nN0 * 256, p.K, 0, p.proj, p.vt, p.km, p.vmt, p.mode, p.out, p.ld, gw, ngw, lane);
                if (p.mode == 2) {
                    simple_gemm_job(p.A1, p.B1, 6 * 256, 64 * 256, p.K, 1, p.proj, p.vt, p.km, p.vmt, 2, p.out, p.ld, gw, ngw, lane);
                    simple_gemm_job(p.A2, p.B2, 4 * 256, 2 * 256, p.K, 2, p.proj, p.vt, p.km, p.vmt, 2, p.out, p.ld, gw, ngw, lane);
                    simple_gemm_job(p.A3, p.B3, 2 * 256, 4 * 256, p.K, 3, p.proj, p.vt, p.km, p.vmt, 2, p.out, p.ld, gw, ngw, lane);
                }
            }
#else
            pg8::gemm_phase(lds, p, tid);
#endif
        } else if (ph == 0) {
            LAS float* scr = (LAS float*)(lds + wave * (64 * 65 * 4));
            constexpr int I_GU = 32 * 176, I_D = 88 * 32, I_IN = 32 * 72, I_MKV = 32 * 16, I_OUT = 32 * 32;
            constexpr int NITEMS = 2 * I_GU + 2 * I_D + I_IN + I_MKV + I_OUT;
            for (int it = gw; it < NITEMS; it += ngw) {
                int r = it;
                if (r < I_GU) { const int nb = r % 176; transpose_item(P.in[3], DM, NGU, (bf16_t*)(ws + WS_WGU1), r / 176, nb, map_gu(nb), scr, lane); continue; } r -= I_GU;
                if (r < I_GU) { const int nb = r % 176; transpose_item(P.in[21], DM, NGU, (bf16_t*)(ws + WS_WGU2), r / 176, nb, map_gu(nb), scr, lane); continue; } r -= I_GU;
                if (r < I_D) { const int nb = r % 32; transpose_item(P.in[4], DFF, DM, (bf16_t*)(ws + WS_WD1), r / 32, nb, nb * 64, scr, lane); continue; } r -= I_D;
                if (r < I_D) { const int nb = r % 32; transpose_item(P.in[22], DFF, DM, (bf16_t*)(ws + WS_WD2), r / 32, nb, nb * 64, scr, lane); continue; } r -= I_D;
                if (r < I_IN) { const int nb = r % 72; transpose_item(P.in[8], DM, 4608, (bf16_t*)(ws + WS_WIN), r / 72, nb, map_win(nb), scr, lane); continue; } r -= I_IN;
                if (r < I_MKV) { const int nb = r % 16; transpose_item(P.in[9], DM, 1024, (bf16_t*)(ws + WS_WMKV), r / 16, nb, nb * 64, scr, lane); continue; } r -= I_MKV;
                { const int nb = r % 32; transpose_item(P.in[18], DM, DM, (bf16_t*)(ws + WS_WOUT), r / 32, nb, nb * 64, scr, lane); }
            }
            for (int i = gw * 64 + lane; i < 4 * 128 * 128 / 2; i += ngw * 64) { const float2 v = *(const float2*)(P.in[13] + 2 * i); ((unsigned*)(ws + WS_WSB))[i] = pk2(v.x, v.y); }
            for (int m = gw; m < MTOK; m += ngw) norm_row_bf16(P.in[0] + (size_t)m * DM, P.in[2], XN + (size_t)m * DM, lane);
            for (int m = gw; m < 1024; m += ngw) norm_row_bf16(P.in[1] + (size_t)m * DM, P.in[7], (bf16_t*)(ws + WS_MEMN) + (size_t)m * DM, lane);
        } else if (ph == 3) {
            for (int m = gw; m < MTOK; m += ngw) resid_row<false, true>(F + (size_t)m * DM, P.in[0] + (size_t)m * DM, (bf16_t*)(P.out + (size_t)m * DM), P.in[5], 0.5f, P.in[6], XN + (size_t)m * DM, nullptr, lane);
        } else if (ph == 8) {
            for (int m = gw; m < MTOK; m += ngw) resid_row<false, false>(F + (size_t)m * DM, P.out + (size_t)m * DM, (bf16_t*)(P.out + (size_t)m * DM), P.in[19], 1.0f, P.in[20], XN + (size_t)m * DM, nullptr, lane);
        } else if (ph == 11) {
            for (int m = gw; m < MTOK; m += ngw) resid_row<true, false>(F + (size_t)m * DM, P.out + (size_t)m * DM, nullptr, P.in[23], 0.5f, P.in[24], nullptr, P.out + (size_t)m * DM, lane);
        } else if (ph == 5) {
#if NAIVE_P5
            naive_p5(P, gw, ngw, lane);
#else
            for (int u = bid; u < 256; u += G) p5_unit(P, lds, u, tid, wave);
#endif
        } else if (ph == 6) {
            for (int m = gw; m < MTOK; m += ngw) rescale_row(XN + (size_t)m * DM, P.in[15], P.in[16], P.in[17], lane);
        }
        if (ph + 1 < a.ph_hi) xcd_barrier(bar);
        if (ph == PROBE_PH && probe_rep < PROBE_N) { ++probe_rep; --ph; }
    }
}

extern "C" void kernel_launch(void* const* d_in, const int* in_sizes, int n_in, void* d_out, int out_size, void* d_ws, size_t ws_size, hipStream_t stream) {
    static int grid = 0;
    if (grid == 0) {
        if (n_in != 25 || out_size != MTOK * DM || ws_size < WS_TOTAL) { fprintf(stderr, "kernel_launch: unexpected problem (n_in %d, out %d, ws %zu < %zu)\n", n_in, out_size, ws_size, (size_t)WS_TOTAL); grid = -1; return; }
        int dev = 0, cus = 0, per_cu = 0;
        (void)hipGetDevice(&dev);
        (void)hipDeviceGetAttribute(&cus, hipDeviceAttributeMultiprocessorCount, dev);
        (void)hipFuncSetAttribute((const void*)fwd_kernel, hipFuncAttributeMaxDynamicSharedMemorySize, LDS_BYTES);
        (void)hipOccupancyMaxActiveBlocksPerMultiprocessor(&per_cu, (const void*)fwd_kernel, 512, LDS_BYTES);
        if (per_cu < 1) { fprintf(stderr, "kernel_launch: occupancy query says %d blocks per CU\n", per_cu); per_cu = 1; }
        grid = cus * 1;
        (void)hipGetLastError();
    }
    if (grid < 0) return;
    Args a{};
    for (int i = 0; i < 25; ++i) a.in[i] = (const float*)d_in[i];
    a.out = (float*)d_out; a.ws = (unsigned char*)d_ws;
#if MULTI_LAUNCH
    for (int ph = 0; ph < NPHASE; ++ph) {
        if (ph == 6 && !NAIVE_P5) continue;
        a.ph_lo = ph; a.ph_hi = ph + 1;
        hipLaunchKernelGGL(fwd_kernel, dim3(grid), dim3(512), LDS_BYTES, stream, a);
    }
#else
    a.ph_lo = 0; a.ph_hi = NPHASE;
    (void)hipMemsetAsync((unsigned char*)d_ws + WS_BAR, 0, 16384, stream);
    void* args[] = {&a};
    hipError_t e = hipLaunchCooperativeKernel((const void*)fwd_kernel, dim3(grid), dim3(512), args, LDS_BYTES, stream);
    if (e != hipSuccess) fprintf(stderr, "cooperative launch failed: %s (grid %d)\n", hipGetErrorString(e), grid);
#endif
}
```

```cpp
#include <hip/hip_runtime.h>
#include <hip/hip_cooperative_groups.h>
#include <cstdio>
namespace cg = cooperative_groups;

#ifndef MULTI_LAUNCH
#define MULTI_LAUNCH 0
#endif
#ifndef NAIVE_GEMM
#define NAIVE_GEMM 0
#endif
#ifndef NAIVE_P5
#define NAIVE_P5 0
#endif

#ifndef PROBE_PH
#define PROBE_PH (-1)
#define PROBE_N 0
#endif

#ifndef P5_REP_PRE
#define P5_REP_PRE 1
#define P5_REP_NA 1
#define P5_REP_MEM 1
#define P5_REP_SG 1
#endif
#define LAS __attribute__((address_space(3)))
typedef unsigned short bf16_t;
typedef short bf16x8 __attribute__((ext_vector_type(8)));
typedef float f32x4 __attribute__((ext_vector_type(4)));
typedef unsigned u32x4 __attribute__((ext_vector_type(4)));
typedef unsigned u32x2 __attribute__((ext_vector_type(2)));

constexpr int MTOK = 16384, DM = 2048, DFF = 5632, NGU = 11264, SEQ = 4096;
constexpr int PROJ_LD = 3072, VT_LD = 16384;
constexpr float EPS = 1e-6f;
constexpr float LOG2E = 1.4426950408889634f;
constexpr float QSCALE = 0.08838834764831845f * LOG2E;
constexpr int NPHASE = 12;
constexpr int LDS_BYTES = 156 * 1024;

constexpr size_t WS_WGU1 = 0;
constexpr size_t WS_WD1 = WS_WGU1 + (size_t)NGU * DM * 2;
constexpr size_t WS_WIN = WS_WD1 + (size_t)DM * DFF * 2;
constexpr size_t WS_WMKV = WS_WIN + (size_t)4608 * DM * 2;
constexpr size_t WS_WOUT = WS_WMKV + (size_t)1024 * DM * 2;
constexpr size_t WS_WGU2 = WS_WOUT + (size_t)DM * DM * 2;
constexpr size_t WS_WD2 = WS_WGU2 + (size_t)NGU * DM * 2;
constexpr size_t WS_WSB = WS_WD2 + (size_t)DM * DFF * 2;
constexpr size_t WS_MEMN = WS_WSB + (size_t)4 * 128 * 128 * 2;
constexpr size_t WS_KM = WS_MEMN + (size_t)1024 * DM * 2;
constexpr size_t WS_VMT = WS_KM + (size_t)1024 * 512 * 2;
constexpr size_t WS_XN = WS_VMT + (size_t)512 * 1024 * 2;
constexpr size_t WS_H = WS_XN + (size_t)MTOK * DM * 2;
constexpr size_t WS_PROJ = WS_H;
constexpr size_t WS_VT = WS_H + (size_t)MTOK * PROJ_LD * 2;
constexpr size_t WS_F = WS_H + (size_t)MTOK * DFF * 2;
constexpr size_t WS_END = WS_F + (size_t)MTOK * DM * 2;
static_assert(WS_VT + (size_t)1536 * VT_LD * 2 <= WS_F, "overlay");
constexpr size_t WS_BAR = WS_END;
constexpr size_t WS_RS = WS_BAR + 16384;
constexpr size_t WS_TOTAL = WS_RS + (size_t)MTOK * 4;
static_assert(WS_TOTAL <= (size_t)536870912, "workspace");

__device__ __forceinline__ unsigned pk2(float lo, float hi) { unsigned r; asm("v_cvt_pk_bf16_f32 %0, %1, %2" : "=v"(r) : "v"(lo), "v"(hi)); return r; }
__device__ __forceinline__ float bflo(unsigned u) { return __uint_as_float(u << 16); }
__device__ __forceinline__ float bfhi(unsigned u) { return __uint_as_float(u & 0xffff0000u); }
__device__ __forceinline__ float bf1(bf16_t b) { return __uint_as_float(((unsigned)b) << 16); }
__device__ __forceinline__ float wave_sum(float v) {
#pragma unroll
    for (int o = 1; o < 64; o <<= 1) v += __shfl_xor(v, o);
    return v;
}
__device__ __forceinline__ float fexp2(float x) { return __builtin_amdgcn_exp2f(x); }
__device__ __forceinline__ float frcp(float x) { return __builtin_amdgcn_rcpf(x); }
__device__ __forceinline__ float gelu_tanh(float x) {
    const float t = x * (1.0f + 0.044715f * x * x);
    return x * frcp(1.0f + fexp2(t * (-2.0f * 0.7978845608028654f * LOG2E)));
}
__device__ __forceinline__ float silu_mul(float g, float u) { return g * frcp(1.0f + fexp2(g * (-LOG2E))) * u; }
__device__ __forceinline__ f32x4 mfma16(bf16x8 a, bf16x8 b, f32x4 c) { return __builtin_amdgcn_mfma_f32_16x16x32_bf16(a, b, c, 0, 0, 0); }

struct OutBf {
    bf16_t* base; int ld; int act; float sc;
    __device__ __forceinline__ f32x4 xf(f32x4 v) const {
        v = v * sc;
        if (act) { v.x = gelu_tanh(v.x); v.y = gelu_tanh(v.y); v.z = gelu_tanh(v.z); v.w = gelu_tanh(v.w); }
        return v;
    }
    __device__ __forceinline__ void st4(int row, int col, f32x4 v) const {
        v = xf(v); u32x2 w; w.x = pk2(v.x, v.y); w.y = pk2(v.z, v.w);
        *(u32x2*)(base + (size_t)row * ld + col) = w;
    }
    __device__ __forceinline__ void st8(int row, int col, f32x4 a, f32x4 b) const {
        a = xf(a); b = xf(b); u32x4 w; w.x = pk2(a.x, a.y); w.y = pk2(a.z, a.w); w.z = pk2(b.x, b.y); w.w = pk2(b.z, b.w);
        *(u32x4*)(base + (size_t)row * ld + col) = w;
    }
};
__device__ __forceinline__ OutBf p4_sel(int job, int pm, int pn, bf16_t* proj, bf16_t* vt, bf16_t* km, bf16_t* vmt) {
    OutBf o; o.act = 0; o.sc = 1.0f; o.base = proj; o.ld = PROJ_LD;
    if (job == 0) { if (pn < 4 || pn >= 10) o.sc = QSCALE; else if (pn >= 8) o.act = 1; }
    if (job == 1) { o.base = vt; o.ld = VT_LD; if (pm >= 4) o.act = 1; }
    if (job == 2) { o.base = km; o.ld = 512; }
    if (job == 3) { o.base = vmt; o.ld = 1024; }
    return o;
}

namespace pg8 {
constexpr int BM = 256, BK = 64, HALF = 128, HTB = HALF * BK * 2, STAGE_BYTES = 8 * HTB, NXCD = 8, WGM = 8;
__device__ __forceinline__ int lds_byte(int r, int c) { const int st = (r >> 4) * 2 + (c >> 5), rr = r & 15, cc = c & 31, ob = rr * 64 + cc * 2; return st * 1024 + (ob ^ (((ob >> 9) & 1) << 5)); }
__device__ __forceinline__ void stage_rc(int b, int& R, int& C) { const int st = b / 1024, sb = b % 1024, swz = sb ^ (((sb >> 9) & 1) << 5); R = (st >> 1) * 16 + swz / 64; C = (st & 1) * 32 + (swz % 64) / 2; }
__device__ __forceinline__ int perm32(int rho) { const int n = rho >> 4, i = rho & 15; return 8 * (i >> 2) + 4 * n + (i & 3); }

struct Unit { int pm, pn, job; const bf16_t* A; const bf16_t* B; };
struct GP {
    int K, G, c, mode, ld, nM0, nN0, total;
    bf16_t* out; const bf16_t *A0, *B0, *A1, *B1, *A2, *B2, *A3, *B3; bf16_t *proj, *vt, *km, *vmt; const float* rs;
};
__device__ __forceinline__ bool sched_next(int i, Unit& u, int G, int c, int total, int mode, int nM0, int nN0, const bf16_t* A0, const bf16_t* B0,
                                           const bf16_t* A1, const bf16_t* B1, const bf16_t* A2, const bf16_t* B2, const bf16_t* A3, const bf16_t* B3) {
    const int L = i * G + c; if (L >= total) return false;
    int job = 0, st = 0, nM = nM0, nN = nN0; const bf16_t* pa = A0; const bf16_t* pb = B0;
    if (mode == 2) {
        if (L >= 768) { job = 1; st = 768; nM = 6; nN = 64; pa = A1; pb = B1; }
        if (L >= 1152) { job = 2; st = 1152; nM = 4; nN = 2; pa = A2; pb = B2; }
        if (L >= 1160) { job = 3; st = 1160; nM = 2; nN = 4; pa = A3; pb = B3; }
    }
    int wgid = L - st; const int nwg = nM * nN;
    { const int q = nwg / NXCD, r = nwg % NXCD, xcd = wgid % NXCD, off = wgid / NXCD; wgid = (xcd < r ? xcd * (q + 1) : r * (q + 1) + (xcd - r) * q) + off; }
    const int nig = WGM * nN, gid = wgid / nig, fm = gid * WGM, gsz = (nM - fm) < WGM ? (nM - fm) : WGM;
    u.pm = fm + ((wgid % nig) % gsz); u.pn = (wgid % nig) / gsz; u.job = job; u.A = pa; u.B = pb; return true;
}
__device__ __forceinline__ void epilogue(const f32x4 (&acc)[2][2][4][2], const Unit& u, int wr, int wc, int fr, int fq, int mode, bf16_t* out, int ld, bf16_t* proj, bf16_t* vt, bf16_t* km, bf16_t* vmt, const float* rs) {
    const int row0 = u.pm * BM + wr * 64 + fr, cb = wc * 32 + 8 * fq;
    if (mode == 0) {
#pragma unroll
        for (int ai = 0; ai < 2; ++ai)
#pragma unroll
            for (int m = 0; m < 4; ++m) {
                const float r = rs[row0 + ai * HALF + m * 16];
                const f32x4 g0 = acc[ai][0][m][0] * r, g1 = acc[ai][0][m][1] * r, u0 = acc[ai][1][m][0] * r, u1 = acc[ai][1][m][1] * r;
                u32x4 w;
                w.x = pk2(silu_mul(g0.x, u0.x), silu_mul(g0.y, u0.y)); w.y = pk2(silu_mul(g0.z, u0.z), silu_mul(g0.w, u0.w));
                w.z = pk2(silu_mul(g1.x, u1.x), silu_mul(g1.y, u1.y)); w.w = pk2(silu_mul(g1.z, u1.z), silu_mul(g1.w, u1.w));
                *(u32x4*)(out + (size_t)(row0 + ai * HALF + m * 16) * DFF + u.pn * 128 + cb) = w;
            }
    } else {
        OutBf o; o.base = out; o.ld = ld; o.act = 0; o.sc = 1.0f;
        if (mode == 2) o = p4_sel(u.job, u.pm, u.pn, proj, vt, km, vmt);
        const bool rowsc = (mode == 2 && u.job == 0), colsc = (mode == 2 && u.job == 1);
        f32x4 c0[2], c1[2];
#pragma unroll
        for (int bj = 0; bj < 2; ++bj) { c0[bj] = (f32x4){1.f, 1.f, 1.f, 1.f}; c1[bj] = c0[bj];
            if (colsc) { const float* cp = rs + u.pn * BM + bj * HALF + cb; c0[bj] = *(const f32x4*)cp; c1[bj] = *(const f32x4*)(cp + 4); } }
#pragma unroll
        for (int ai = 0; ai < 2; ++ai)
#pragma unroll
            for (int m = 0; m < 4; ++m) {
                const float r = rowsc ? rs[row0 + ai * HALF + m * 16] : 1.0f;
#pragma unroll
                for (int bj = 0; bj < 2; ++bj)
                    o.st8(row0 + ai * HALF + m * 16, u.pn * BM + bj * HALF + cb, acc[ai][bj][m][0] * c0[bj] * r, acc[ai][bj][m][1] * c1[bj] * r);
            }
    }
}

__device__ __forceinline__ void gemm_phase(LAS unsigned char* lds, const GP p, const int tid) {
    const int K = p.K; const size_t tstep = (size_t)256 * K * 2;
#define SNEXT(i, u) sched_next(i, u, p.G, p.c, p.total, p.mode, p.nM0, p.nN0, p.A0, p.B0, p.A1, p.B1, p.A2, p.B2, p.A3, p.B3)
#define APTR(u) ((const char*)(u).A + (size_t)(u).pm * tstep)
#define BPTR(u) ((const char*)(u).B + (size_t)(u).pn * tstep)
    const int wid = __builtin_amdgcn_readfirstlane(tid >> 6), lane = tid & 63, wr = wid >> 2, wc = wid & 3, fr = lane & 15, fq = lane >> 4;
    const int nt = K / BK;
    unsigned voffA[2], voffB[2];
#pragma unroll
    for (int i = 0; i < 2; ++i) { int R, C; stage_rc(tid * 16 + i * 8192, R, C); const int Rb = (R & ~31) + perm32(R & 31);
        voffA[i] = (unsigned)(R * K + C) * 2u; voffB[i] = (unsigned)(Rb * K + C) * 2u; }
    const size_t kstep = (size_t)(BK * 2);
    const size_t hstep = (size_t)HALF * K * 2;
    const unsigned ldsw = (unsigned)wid * 1024u;
    const int aoff = lds_byte(wr * 64 + fr, fq * 8), boff = lds_byte(wc * 32 + fr, fq * 8);
#define PG8_SA(b, h) (((b) * 2 + (h)) * HTB)
#define PG8_SB(b, h) ((4 + (b) * 2 + (h)) * HTB)
#define PG8_STAGE(bufoff, gbase, voff) do { _Pragma("unroll") for (int _i = 0; _i < 2; ++_i) \
        __builtin_amdgcn_global_load_lds((const unsigned*)((const char*)(gbase) + (voff)[_i]), (LAS unsigned*)(lds + (bufoff) + ldsw + _i * 8192), 16, 0, 0); } while (0)
#define PG8_LDA(dst, b, h) do { _Pragma("unroll") for (int m = 0; m < 4; ++m) _Pragma("unroll") for (int k = 0; k < 2; ++k) dst[m][k] = *(const LAS bf16x8*)(lds + PG8_SA(b, h) + aoff + m * 2048 + k * 1024); } while (0)
#define PG8_LDB(dst, b, h) do { _Pragma("unroll") for (int n = 0; n < 2; ++n) _Pragma("unroll") for (int k = 0; k < 2; ++k) dst[n][k] = *(const LAS bf16x8*)(lds + PG8_SB(b, h) + boff + n * 2048 + k * 1024); } while (0)
#define PG8_MMA(ai, bj, At, Bt) do { __builtin_amdgcn_s_setprio(1); _Pragma("unroll") for (int m = 0; m < 4; ++m) _Pragma("unroll") for (int n = 0; n < 2; ++n) _Pragma("unroll") for (int k = 0; k < 2; ++k) \
        acc[ai][bj][m][n] = __builtin_amdgcn_mfma_f32_16x16x32_bf16(Bt[n][k], At[m][k], acc[ai][bj][m][n], 0, 0, 0); __builtin_amdgcn_s_setprio(0); } while (0)
#define PG8_WAIT_V(n) asm volatile("s_waitcnt vmcnt(" #n ")" ::: "memory")
#define PG8_WAIT_L(n) asm volatile("s_waitcnt lgkmcnt(" #n ")" ::: "memory")
#define PG8_BAR __builtin_amdgcn_s_barrier()
#define PG8_SCHED __builtin_amdgcn_sched_barrier(0)
    Unit cur, nxt; int ui = 0;
    if (!SNEXT(0, cur)) return;
    f32x4 acc[2][2][4][2];
#pragma unroll
    for (int a = 0; a < 2; ++a)
#pragma unroll
        for (int b = 0; b < 2; ++b)
#pragma unroll
            for (int m = 0; m < 4; ++m)
#pragma unroll
                for (int n = 0; n < 2; ++n) acc[a][b][m][n] = (f32x4){0.f, 0.f, 0.f, 0.f};
    bf16x8 At[4][2], B0[2][2], B1[2][2];
    const char* cA = APTR(cur); const char* cB = BPTR(cur);
    PG8_STAGE(PG8_SB(0, 0), cB, voffB); PG8_STAGE(PG8_SB(0, 1), cB + hstep, voffB); PG8_STAGE(PG8_SA(0, 0), cA, voffA); PG8_STAGE(PG8_SA(0, 1), cA + hstep, voffA);
    if (wr == 1) PG8_BAR;
    PG8_WAIT_V(2); PG8_BAR;
    PG8_STAGE(PG8_SB(1, 0), cB + kstep, voffB); PG8_STAGE(PG8_SA(1, 0), cA + kstep, voffA); PG8_STAGE(PG8_SB(1, 1), cB + hstep + kstep, voffB);
    PG8_WAIT_V(6); PG8_BAR;
    for (;;) {
        const bool has_next = SNEXT(ui + 1, nxt);
        const char* nA = has_next ? APTR(nxt) : cA; const char* nB = has_next ? BPTR(nxt) : cB;
        for (int t = 0; t < nt; t += 2) {
            const bool last = (t == nt - 2);
            const char* a1 = cA + (size_t)(t + 1) * kstep;
            const char* a2 = last ? nA : cA + (size_t)(t + 2) * kstep; const char* b2 = last ? nB : cB + (size_t)(t + 2) * kstep;
            const char* a3 = a2 + kstep; const char* b3 = b2 + kstep;
            PG8_LDB(B0, 0, 0); PG8_LDB(B1, 0, 1); PG8_SCHED; PG8_LDA(At, 0, 0); PG8_STAGE(PG8_SA(1, 1), a1 + hstep, voffA);
            PG8_WAIT_V(8); PG8_WAIT_L(0); PG8_BAR; PG8_MMA(0, 0, At, B0); PG8_MMA(0, 1, At, B1); PG8_BAR; PG8_SCHED;
            PG8_LDA(At, 0, 1); PG8_STAGE(PG8_SB(0, 0), b2, voffB); PG8_STAGE(PG8_SB(0, 1), b2 + hstep, voffB); PG8_STAGE(PG8_SA(0, 0), a2, voffA);
            PG8_WAIT_V(8); PG8_WAIT_L(0); PG8_BAR; PG8_MMA(1, 0, At, B0); PG8_MMA(1, 1, At, B1); PG8_BAR; PG8_SCHED;
            PG8_LDB(B0, 1, 0); PG8_LDB(B1, 1, 1); PG8_SCHED; PG8_LDA(At, 1, 0); PG8_STAGE(PG8_SA(0, 1), a2 + hstep, voffA);
            PG8_WAIT_V(8); PG8_WAIT_L(0); PG8_BAR; PG8_MMA(0, 0, At, B0); PG8_MMA(0, 1, At, B1); PG8_BAR; PG8_SCHED;
            PG8_LDA(At, 1, 1); PG8_STAGE(PG8_SB(1, 0), b3, voffB); PG8_STAGE(PG8_SB(1, 1), b3 + hstep, voffB); PG8_STAGE(PG8_SA(1, 0), a3, voffA);
            PG8_WAIT_V(8); PG8_WAIT_L(0); PG8_BAR; PG8_MMA(1, 0, At, B0); PG8_MMA(1, 1, At, B1); PG8_BAR; PG8_SCHED;
        }
        if (wr == 0) PG8_BAR;
        epilogue(acc, cur, wr, wc, fr, fq, p.mode, p.out, p.ld, p.proj, p.vt, p.km, p.vmt, p.rs);
        if (!has_next) break;
#pragma unroll
        for (int a = 0; a < 2; ++a)
#pragma unroll
            for (int b = 0; b < 2; ++b)
#pragma unroll
                for (int m = 0; m < 4; ++m)
#pragma unroll
                    for (int n = 0; n < 2; ++n) acc[a][b][m][n] = (f32x4){0.f, 0.f, 0.f, 0.f};
        cur = nxt; cA = nA; cB = nB; ++ui;
        if (wr == 1) PG8_BAR;
    }
    PG8_WAIT_V(0);
    PG8_BAR;
#undef SNEXT
#undef APTR
#undef BPTR
#undef PG8_SA
#undef PG8_SB
#undef PG8_STAGE
#undef PG8_LDA
#undef PG8_LDB
#undef PG8_MMA
#undef PG8_WAIT_V
#undef PG8_WAIT_L
#undef PG8_BAR
#undef PG8_SCHED
}
}

__device__ __forceinline__ void simple_gemm_job(const bf16_t* A, const bf16_t* Bt, int Mr, int Nc, int K, int job, bf16_t* proj, bf16_t* vt, bf16_t* km, bf16_t* vmt, int mode, bf16_t* out, int ld, int gw, int ngw, int lane) {
    const int fr = lane & 15, fq = lane >> 4, tn = Nc / 64, tiles = (Mr / 64) * tn;
    for (int t = gw; t < tiles; t += ngw) {
        const int row0 = (t / tn) * 64, col0 = (t % tn) * 64;
        f32x4 acc[4][4];
#pragma unroll
        for (int i = 0; i < 4; ++i)
#pragma unroll
            for (int j = 0; j < 4; ++j) acc[i][j] = (f32x4){0.f, 0.f, 0.f, 0.f};
        const bf16_t* ap = A + (size_t)(row0 + fr) * K + fq * 8; const bf16_t* bp = Bt + (size_t)(col0 + fr) * K + fq * 8;
        for (int k = 0; k < K; k += 32) {
            bf16x8 a[4], b[4];
#pragma unroll
            for (int i = 0; i < 4; ++i) { a[i] = *(const bf16x8*)(ap + (size_t)i * 16 * K + k); b[i] = *(const bf16x8*)(bp + (size_t)i * 16 * K + k); }
#pragma unroll
            for (int i = 0; i < 4; ++i)
#pragma unroll
                for (int j = 0; j < 4; ++j) acc[i][j] = mfma16(b[j], a[i], acc[i][j]);
        }
        OutBf o; o.base = out; o.ld = ld; o.act = 0; o.sc = 1.0f; if (mode == 2) o = p4_sel(job, row0 / 256, col0 / 256, proj, vt, km, vmt);
#pragma unroll
        for (int i = 0; i < 4; ++i)
#pragma unroll
            for (int j = 0; j < 4; ++j) o.st4(row0 + i * 16 + fr, col0 + j * 16 + fq * 4, acc[i][j]);
    }
}
__device__ __forceinline__ void simple_gemm_swiglu(const bf16_t* A, const bf16_t* Wt, bf16_t* H, int gw, int ngw, int lane) {
    const int fr = lane & 15, fq = lane >> 4, K = DM, tn = DFF / 32, tiles = (MTOK / 64) * tn;
    for (int t = gw; t < tiles; t += ngw) {
        const int row0 = (t / tn) * 64, h0 = (t % tn) * 32, wrow = 256 * (h0 >> 7) + (h0 & 127);
        f32x4 g[4][2], u[4][2];
#pragma unroll
        for (int i = 0; i < 4; ++i)
#pragma unroll
            for (int j = 0; j < 2; ++j) { g[i][j] = (f32x4){0.f, 0.f, 0.f, 0.f}; u[i][j] = (f32x4){0.f, 0.f, 0.f, 0.f}; }
        const bf16_t* ap = A + (size_t)(row0 + fr) * K + fq * 8; const bf16_t* bp = Wt + (size_t)(wrow + fr) * K + fq * 8;
        for (int k = 0; k < K; k += 32) {
            bf16x8 a[4], bg[2], bu[2];
#pragma unroll
            for (int i = 0; i < 4; ++i) a[i] = *(const bf16x8*)(ap + (size_t)i * 16 * K + k);
#pragma unroll
            for (int j = 0; j < 2; ++j) { bg[j] = *(const bf16x8*)(bp + (size_t)j * 16 * K + k); bu[j] = *(const bf16x8*)(bp + (size_t)(128 + j * 16) * K + k); }
#pragma unroll
            for (int i = 0; i < 4; ++i)
#pragma unroll
                for (int j = 0; j < 2; ++j) { g[i][j] = mfma16(bg[j], a[i], g[i][j]); u[i][j] = mfma16(bu[j], a[i], u[i][j]); }
        }
#pragma unroll
        for (int i = 0; i < 4; ++i)
#pragma unroll
            for (int j = 0; j < 2; ++j) {
                u32x2 w; w.x = pk2(silu_mul(g[i][j].x, u[i][j].x), silu_mul(g[i][j].y, u[i][j].y)); w.y = pk2(silu_mul(g[i][j].z, u[i][j].z), silu_mul(g[i][j].w, u[i][j].w));
                *(u32x2*)(H + (size_t)(row0 + i * 16 + fr) * DFF + h0 + j * 16 + fq * 4) = w;
            }
    }
}

__device__ __forceinline__ void transpose_item(const float* W, int K, int N, bf16_t* WT, int kb, int nbd, int src0, LAS float* scr, int lane, const float* gk = nullptr) {
    const int k0 = kb * 64;
    const float* wp = W + (size_t)(k0 + (lane >> 4)) * N + src0 + (lane & 15) * 4;
    f32x4 v[16];
#pragma unroll
    for (int i = 0; i < 16; ++i) v[i] = *(const f32x4*)(wp + (size_t)(4 * i) * N);
#pragma unroll
    for (int i = 0; i < 16; ++i) { if (gk) v[i] = v[i] * gk[k0 + 4 * i + (lane >> 4)];
        LAS float* s = scr + (4 * i + (lane >> 4)) * 65 + (lane & 15) * 4; s[0] = v[i].x; s[1] = v[i].y; s[2] = v[i].z; s[3] = v[i].w; }
    const int c = lane & 7;
#pragma unroll
    for (int jj = 0; jj < 8; ++jj) {
        const int n = (lane >> 3) + 8 * jj; const LAS float* s = scr + (8 * c) * 65 + n;
        u32x4 o; o.x = pk2(s[0], s[65]); o.y = pk2(s[2 * 65], s[3 * 65]); o.z = pk2(s[4 * 65], s[5 * 65]); o.w = pk2(s[6 * 65], s[7 * 65]);
        *(u32x4*)(WT + (size_t)(nbd * 64 + n) * K + k0 + 8 * c) = o;
    }
}
__device__ __forceinline__ int map_gu(int nb) { const int j = nb >> 2, part = nb & 3; return part < 2 ? 128 * j + 64 * part : DFF + 128 * j + 64 * (part - 2); }
__device__ __forceinline__ int map_win(int nb) { const int n = nb * 64; return n < 2048 ? n : n < 2560 ? n + 1024 : n < 3072 ? n + 1536 : n < 4096 ? n - 1024 : n - 512; }

__device__ __forceinline__ void norm_row_bf16(const float* xr, const float* g, bf16_t* o, int lane) {
    f32x4 v[8]; float s = 0.f;
#pragma unroll
    for (int j = 0; j < 8; ++j) { v[j] = *(const f32x4*)(xr + 256 * j + 4 * lane); s += (v[j].x * v[j].x + v[j].y * v[j].y) + (v[j].z * v[j].z + v[j].w * v[j].w); }
    const float rs = rsqrtf(wave_sum(s) * (1.0f / DM) + EPS);
#pragma unroll
    for (int j = 0; j < 8; ++j) { const f32x4 gv = *(const f32x4*)(g + 256 * j + 4 * lane);
        u32x2 w; w.x = pk2(v[j].x * rs * gv.x, v[j].y * rs * gv.y); w.y = pk2(v[j].z * rs * gv.z, v[j].w * rs * gv.w);
        *(u32x2*)(o + 256 * j + 4 * lane) = w; }
}
__device__ __forceinline__ void x_row(const float* xr, bf16_t* h, float* rs_out, int lane) {
    f32x4 v[8]; float s = 0.f;
#pragma unroll
    for (int j = 0; j < 8; ++j) { v[j] = *(const f32x4*)(xr + 256 * j + 4 * lane); s += (v[j].x * v[j].x + v[j].y * v[j].y) + (v[j].z * v[j].z + v[j].w * v[j].w); }
#pragma unroll
    for (int j = 0; j < 8; ++j) { u32x2 w; w.x = pk2(v[j].x, v[j].y); w.y = pk2(v[j].z, v[j].w); *(u32x2*)(h + 256 * j + 4 * lane) = w; }
    const float rs = rsqrtf(wave_sum(s) * (1.0f / DM) + EPS);
    if (lane == 0) *rs_out = rs;
}
template <bool FINAL>
__device__ __forceinline__ void resid_row(const bf16_t* f, bf16_t* h, const float* gpost, float alpha, float* rs_out, const float* gnext, float* fin, int lane) {
    f32x4 v[8], hv[8]; float s = 0.f;
#pragma unroll
    for (int j = 0; j < 8; ++j) { const u32x2 w = *(const u32x2*)(f + 256 * j + 4 * lane); v[j] = (f32x4){bflo(w.x), bfhi(w.x), bflo(w.y), bfhi(w.y)};
        s += (v[j].x * v[j].x + v[j].y * v[j].y) + (v[j].z * v[j].z + v[j].w * v[j].w); }
#pragma unroll
    for (int j = 0; j < 8; ++j) { const u32x2 w = *(const u32x2*)(h + 256 * j + 4 * lane); hv[j] = (f32x4){bflo(w.x), bfhi(w.x), bflo(w.y), bfhi(w.y)}; }
    const float rs = rsqrtf(wave_sum(s) * (1.0f / DM) + EPS) * alpha;
    float s2 = 0.f;
#pragma unroll
    for (int j = 0; j < 8; ++j) { const f32x4 gv = *(const f32x4*)(gpost + 256 * j + 4 * lane);
        v[j] = hv[j] + v[j] * rs * gv; s2 += (v[j].x * v[j].x + v[j].y * v[j].y) + (v[j].z * v[j].z + v[j].w * v[j].w);
        if (!FINAL) { u32x2 hw; hw.x = pk2(v[j].x, v[j].y); hw.y = pk2(v[j].z, v[j].w); *(u32x2*)(h + 256 * j + 4 * lane) = hw; } }
    const float rs2 = rsqrtf(wave_sum(s2) * (1.0f / DM) + EPS);
    if (!FINAL) { if (lane == 0) *rs_out = rs2; }
    else {
#pragma unroll
        for (int j = 0; j < 8; ++j) { const f32x4 gv = *(const f32x4*)(gnext + 256 * j + 4 * lane); *(f32x4*)(fin + 256 * j + 4 * lane) = v[j] * rs2 * gv; } }
}
__device__ __forceinline__ void rescale_row(bf16_t* y, const float* gna, const float* gsg, const float* gmem, int lane) {
    u32x4 w[4]; float ss[4];
#pragma unroll
    for (int j = 0; j < 4; ++j) { w[j] = *(const u32x4*)(y + 512 * j + 8 * lane);
        const float a0 = bflo(w[j].x), a1 = bfhi(w[j].x), a2 = bflo(w[j].y), a3 = bfhi(w[j].y), a4 = bflo(w[j].z), a5 = bfhi(w[j].z), a6 = bflo(w[j].w), a7 = bfhi(w[j].w);
        ss[j] = (a0 * a0 + a1 * a1) + (a2 * a2 + a3 * a3) + (a4 * a4 + a5 * a5) + (a6 * a6 + a7 * a7); }
    const float rna = rsqrtf(wave_sum(ss[0] + ss[1]) * (1.0f / 1024) + EPS), rsg = rsqrtf(wave_sum(ss[2]) * (1.0f / 512) + EPS), rme = rsqrtf(wave_sum(ss[3]) * (1.0f / 512) + EPS);
#pragma unroll
    for (int j = 0; j < 4; ++j) {
        const float* g = (j < 2 ? gna + 512 * j : j == 2 ? gsg : gmem) + 8 * lane; const float r = j < 2 ? rna : j == 2 ? rsg : rme;
        const f32x4 g0 = *(const f32x4*)g, g1 = *(const f32x4*)(g + 4);
        u32x4 o; o.x = pk2(bflo(w[j].x) * r * g0.x, bfhi(w[j].x) * r * g0.y); o.y = pk2(bflo(w[j].y) * r * g0.z, bfhi(w[j].y) * r * g0.w);
        o.z = pk2(bflo(w[j].z) * r * g1.x, bfhi(w[j].z) * r * g1.y); o.w = pk2(bflo(w[j].w) * r * g1.z, bfhi(w[j].w) * r * g1.w);
        *(u32x4*)(y + 512 * j + 8 * lane) = o; }
}

struct Ptrs {
    const float* in[25]; float* out; unsigned char* ws;
};
constexpr int VVT_LD = 136, KSTR = 272, KT_BYTES = 69632, VSTR_NA = 144, VSTR_MEM = 272, RPB_OFF = 143360;
static_assert(KT_BYTES + 512 * VSTR_NA <= RPB_OFF && KT_BYTES + 256 * VSTR_MEM <= RPB_OFF && 512 * VVT_LD * 2 <= RPB_OFF && RPB_OFF + 8 * 465 * 4 <= LDS_BYTES, "P5 LDS map");

template <bool NA>
__device__ __forceinline__ void attn_row(f32x4 (&o)[8], float& m, float& l, const bf16x8 (&qf)[4], const LAS unsigned char* kp, const LAS unsigned char* vp, const int vstr,
                                         const LAS float* br, const int qc, const int kc0  ) {
    bf16x8 kf[2][4];
#pragma unroll
    for (int a = 0; a < 2; ++a)
#pragma unroll
        for (int dc = 0; dc < 4; ++dc) kf[a][dc] = *(const LAS bf16x8*)(kp + a * 16 * KSTR + dc * 64);
    f32x4 s0 = (f32x4){0.f, 0.f, 0.f, 0.f}, s1 = (f32x4){0.f, 0.f, 0.f, 0.f};
#pragma unroll
    for (int dc = 0; dc < 4; ++dc) { s0 = mfma16(kf[0][dc], qf[dc], s0); s1 = mfma16(kf[1][dc], qf[dc], s1); }
    __builtin_amdgcn_sched_barrier(0);
    u32x2 vlo[8], vhi[8];
#pragma unroll
    for (int d = 0; d < 8; ++d) { vlo[d] = *(const LAS u32x2*)(vp + d * 16 * vstr); vhi[d] = *(const LAS u32x2*)(vp + d * 16 * vstr + 32); }
    if (NA) {
        const int cs = min(max(qc - 8, 0), 48);
#pragma unroll
        for (int e = 0; e < 4; ++e) {
            const int k0 = kc0 + e, k1 = kc0 + 16 + e;
            s0[e] = (k0 >= cs && k0 < cs + 16) ? s0[e] + br[min(max(k0 - qc, -15), 15) + 15] : -1.0e30f;
            s1[e] = (k1 >= cs && k1 < cs + 16) ? s1[e] + br[min(max(k1 - qc, -15), 15) + 15] : -1.0e30f;
        }
    }
    float mx = fmaxf(fmaxf(fmaxf(s0.x, s0.y), fmaxf(s0.z, s0.w)), fmaxf(fmaxf(s1.x, s1.y), fmaxf(s1.z, s1.w)));
    mx = fmaxf(mx, __shfl_xor(mx, 16)); mx = fmaxf(mx, __shfl_xor(mx, 32));
    const float mn = fmaxf(m, mx), alpha = fexp2(m - mn); m = mn;
#pragma unroll
    for (int e = 0; e < 4; ++e) { s0[e] = fexp2(s0[e] - mn); s1[e] = fexp2(s1[e] - mn); }
    l = l * alpha + ((s0.x + s0.y) + (s0.z + s0.w)) + ((s1.x + s1.y) + (s1.z + s1.w));
    u32x4 pw; pw.x = pk2(s0.x, s0.y); pw.y = pk2(s0.z, s0.w); pw.z = pk2(s1.x, s1.y); pw.w = pk2(s1.z, s1.w);
    const bf16x8 pb = __builtin_bit_cast(bf16x8, pw);
#pragma unroll
    for (int d = 0; d < 8; ++d) {
        u32x4 vw; vw.x = vlo[d].x; vw.y = vlo[d].y; vw.z = vhi[d].x; vw.w = vhi[d].y;
        o[d] = mfma16(__builtin_bit_cast(bf16x8, vw), pb, o[d] * alpha);
    }
}
__device__ __forceinline__ void attn_init(f32x4 (&o)[8], float& m, float& l) {
#pragma unroll
    for (int d = 0; d < 8; ++d) o[d] = (f32x4){0.f, 0.f, 0.f, 0.f};
    m = -3.0e38f; l = 0.f;
}
__device__ __forceinline__ void attn_finish(const f32x4 (&o)[8], float l, bf16_t* yp) {
    l += __shfl_xor(l, 16); l += __shfl_xor(l, 32);
    const float inv = frcp(l);
#pragma unroll
    for (int d = 0; d < 8; ++d) { u32x2 w; w.x = pk2(o[d].x * inv, o[d].y * inv); w.y = pk2(o[d].z * inv, o[d].w * inv); *(u32x2*)(yp + d * 16) = w; }
}
#define P5_LAUNDER() int tid = tid_in; asm volatile("" : "+v"(tid)); const int lane = tid & 63, fr = lane & 15, fq = lane >> 4
__device__ __forceinline__ void p5_unit(const Ptrs& P, LAS unsigned char* lds, int unit, int tid_in, int wave) {
    const bf16_t* proj = (const bf16_t*)(P.ws + WS_PROJ); const bf16_t* vt = (const bf16_t*)(P.ws + WS_VT);
    const bf16_t* km = (const bf16_t*)(P.ws + WS_KM); const bf16_t* vmt = (const bf16_t*)(P.ws + WS_VMT);
    const bf16_t* wsb = (const bf16_t*)(P.ws + WS_WSB);
    bf16_t* Y = (bf16_t*)P.out;
    const int b = unit >> 6, r = unit & 63, tok0 = b * SEQ + r * 64;
    const int rs = min(max(r - 4, 0), 56);
    LAS float* rpb = (LAS float*)(lds + RPB_OFF);
    LAS bf16_t* vvt = (LAS bf16_t*)lds;
    __syncthreads();
    for (int i = tid_in; i < 8 * 15 * 31; i += 512) rpb[i] = P.in[10][i] * LOG2E;
    for (int rep = 0; rep < P5_REP_PRE; ++rep) {
        P5_LAUNDER(); (void)fr; (void)fq;
        const int g = wave & 3, q = (wave >> 2) * 64 + lane, ctok = b * SEQ + (r >> 1) * 128;
        const bf16_t* vs = vt + (size_t)(1024 + g * 128) * VT_LD + ctok + q;
        float s = 0.f, ss = 0.f;
        LAS bf16_t* vq = vvt + (g * 128) * VVT_LD + q;
#pragma unroll 32
        for (int c = 0; c < 128; ++c) { const bf16_t xb = vs[(size_t)c * VT_LD]; const float x = bf1(xb); s += x; ss += x * x; vq[c * VVT_LD] = xb; }
        const float mu = s * (1.0f / 128), var = fmaxf(ss * (1.0f / 128) - mu * mu, 0.f), rstd = rsqrtf(var + EPS);
        const float* lg = P.in[11] + g * 128; const float* lb = P.in[12] + g * 128;
#pragma unroll 16
        for (int c = 0; c < 128; ++c) { const float x = bf1(vq[c * VVT_LD]); const float yv = (x - mu) * rstd * lg[c] + lb[c];
            vq[c * VVT_LD] = (bf16_t)(pk2(yv, 0.f) & 0xffffu); }
    }
    __syncthreads();
    for (int rep = 0; rep < P5_REP_SG; ++rep) {
        P5_LAUNDER();
        const int g = wave & 3, half = wave >> 2;
#pragma unroll 1
        for (int pb = 0; pb < 2; ++pb) {
            const int pl = half * 32 + pb * 16 + fr, pp = (r & 1) * 64 + pl;
            f32x4 acc[8];
#pragma unroll
            for (int c = 0; c < 8; ++c) acc[c] = (f32x4){0.f, 0.f, 0.f, 0.f};
#pragma unroll
            for (int qc = 0; qc < 4; ++qc) {
                const bf16x8 wf = *(const bf16x8*)(wsb + (size_t)(g * 128 + pp) * 128 + qc * 32 + fq * 8);
#pragma unroll
                for (int c = 0; c < 8; ++c) {
                    const bf16x8 af = *(const LAS bf16x8*)(vvt + (g * 128 + c * 16 + fr) * VVT_LD + qc * 32 + fq * 8);
                    acc[c] = mfma16(af, wf, acc[c]);
                }
            }
            const float bs = P.in[14][g * 128 + pp];
            const bf16_t* up = proj + ((size_t)tok0 + pl) * PROJ_LD + 2048 + g * 128 + fq * 4;
            bf16_t* yp = Y + ((size_t)tok0 + pl) * DM + 1024 + g * 128 + fq * 4;
#pragma unroll
            for (int c = 0; c < 8; ++c) { const u32x2 uw = *(const u32x2*)(up + c * 16);
                u32x2 w; w.x = pk2(bflo(uw.x) * (acc[c].x + bs), bfhi(uw.x) * (acc[c].y + bs)); w.y = pk2(bflo(uw.y) * (acc[c].z + bs), bfhi(uw.y) * (acc[c].w + bs));
                *(u32x2*)(yp + c * 16) = w; }
        }
    }
    for (int rep = 0; rep < P5_REP_NA; ++rep) {
        P5_LAUNDER();
        const int hh = wave & 3, qp = wave >> 2, qbA = 2 * qp, qbB = 2 * qp + 1;
        const int w0A = qp == 0 ? 0 : 24, w0B = qp == 0 ? 8 : 32;
        const unsigned kgo = (unsigned)((tid >> 6) * PROJ_LD + (tid & 63) * 8) * 2u, vgo = (unsigned)((tid >> 3) * VT_LD + (tid & 7) * 8) * 2u;
        const unsigned klo = (unsigned)((((tid >> 4) & 3) * 64 + (tid >> 6)) * KSTR + (tid & 15) * 16), vlo = (unsigned)((tid >> 3) * VSTR_NA + (tid & 7) * 16);
        bf16x8 qfA[4], qfB[4];
        f32x4 oA[8], oB[8]; float mA, lA, mB, lB;
        u32x4 tk[8];
        {   const size_t ktok = (size_t)b * SEQ + rs * 64;
            const char* kg = (const char*)(proj + ktok * PROJ_LD + 1024);
#pragma unroll
            for (int j = 0; j < 8; ++j) tk[j] = *(const u32x4*)(kg + (size_t)j * (8 * PROJ_LD * 2) + kgo); }
#pragma unroll 1
        for (int st = 0; st < 16; ++st) {
            const int hg = st >> 3, i = st & 7, h = hg * 4 + hh;
            if (i == 0) {
                const bf16_t* qa = proj + ((size_t)tok0 + qbA * 16 + fr) * PROJ_LD + h * 128 + fq * 8; const bf16_t* qb_ = qa + (size_t)16 * PROJ_LD;
#pragma unroll
                for (int dc = 0; dc < 4; ++dc) { qfA[dc] = *(const bf16x8*)(qa + dc * 32); qfB[dc] = *(const bf16x8*)(qb_ + dc * 32); }
                attn_init(oA, mA, lA); attn_init(oB, mB, lB);
            }
            {   u32x4 tv[8];
                const char* vg = (const char*)(vt + (size_t)(hg * 512) * VT_LD + (size_t)b * SEQ + (rs + i) * 64);
#pragma unroll
                for (int j = 0; j < 8; ++j) tv[j] = *(const u32x4*)(vg + (size_t)j * (64 * VT_LD * 2) + vgo);
                __syncthreads();
#pragma unroll
                for (int j = 0; j < 8; ++j) *(LAS u32x4*)(lds + klo + j * (8 * KSTR)) = tk[j];
#pragma unroll
                for (int j = 0; j < 8; ++j) *(LAS u32x4*)(lds + KT_BYTES + vlo + j * (64 * VSTR_NA)) = tv[j]; }
            __syncthreads();
            {   const int sn = st < 15 ? st + 1 : 15, hgn = sn >> 3, in_ = sn & 7;
                const char* kg = (const char*)(proj + ((size_t)b * SEQ + (rs + in_) * 64) * PROJ_LD + 1024 + hgn * 512);
#pragma unroll
                for (int j = 0; j < 8; ++j) tk[j] = *(const u32x4*)(kg + (size_t)j * (8 * PROJ_LD * 2) + kgo); }
            __builtin_amdgcn_sched_barrier(0);
            const LAS float* br = rpb + h * 465 + (rs - r + 7 + i) * 31;
            attn_row<true>(oA, mA, lA, qfA, lds + (hh * 64 + w0A + fr) * KSTR + fq * 16, lds + KT_BYTES + (hh * 128 + fr) * VSTR_NA + (w0A + fq * 4) * 2, VSTR_NA, br, qbA * 16 + fr, w0A + fq * 4);
            __builtin_amdgcn_sched_barrier(0);
            attn_row<true>(oB, mB, lB, qfB, lds + (hh * 64 + w0B + fr) * KSTR + fq * 16, lds + KT_BYTES + (hh * 128 + fr) * VSTR_NA + (w0B + fq * 4) * 2, VSTR_NA, br, qbB * 16 + fr, w0B + fq * 4);
            __builtin_amdgcn_sched_barrier(0);
            if (i == 7) {
                attn_finish(oA, lA, Y + ((size_t)tok0 + qbA * 16 + fr) * DM + h * 128 + fq * 4);
                attn_finish(oB, lB, Y + ((size_t)tok0 + qbB * 16 + fr) * DM + h * 128 + fq * 4);
            }
        }
    }
    for (int rep = 0; rep < P5_REP_MEM; ++rep) {
        P5_LAUNDER();
        const int hh = wave & 1, qb = wave >> 1;
        const unsigned kgo = (unsigned)((tid >> 5) * 512 + (tid & 31) * 8) * 2u, vgo = (unsigned)((tid >> 4) * 1024 + (tid & 15) * 8) * 2u;
        const unsigned klo = (unsigned)((((tid >> 4) & 1) * 128 + (tid >> 5)) * KSTR + (tid & 15) * 16), vlo = (unsigned)((tid >> 4) * VSTR_MEM + (tid & 15) * 16);
#pragma unroll 1
        for (int hp = 0; hp < 2; ++hp) {
            const int hm = hp * 2 + hh;
            bf16x8 qf[4];
            { const bf16_t* qa = proj + ((size_t)tok0 + qb * 16 + fr) * PROJ_LD + 2560 + hm * 128 + fq * 8;
#pragma unroll
              for (int dc = 0; dc < 4; ++dc) qf[dc] = *(const bf16x8*)(qa + dc * 32); }
            f32x4 o[8]; float m, l; attn_init(o, m, l);
#pragma unroll 1
            for (int kh = 0; kh < 2; ++kh) {
                const char* kg = (const char*)(km + (size_t)(b * 256 + kh * 128) * 512 + hp * 256); const char* vg = (const char*)(vmt + (size_t)(hp * 256) * 1024 + b * 256 + kh * 128);
                u32x4 tk[8];
#pragma unroll
                for (int j = 0; j < 8; ++j) tk[j] = *(const u32x4*)(kg + (size_t)j * (16 * 512 * 2) + kgo);
                __syncthreads();
#pragma unroll
                for (int j = 0; j < 8; ++j) *(LAS u32x4*)(lds + klo + j * (16 * KSTR)) = tk[j];
                __builtin_amdgcn_sched_barrier(0);
#pragma unroll
                for (int j = 0; j < 8; ++j) tk[j] = *(const u32x4*)(vg + (size_t)j * (32 * 1024 * 2) + vgo);
#pragma unroll
                for (int j = 0; j < 8; ++j) *(LAS u32x4*)(lds + KT_BYTES + vlo + j * (32 * VSTR_MEM)) = tk[j];
                __syncthreads();
#pragma unroll 1
                for (int rr = 0; rr < 4; ++rr)
                    attn_row<false>(o, m, l, qf, lds + (hh * 128 + rr * 32 + fr) * KSTR + fq * 16, lds + KT_BYTES + (hh * 128 + fr) * VSTR_MEM + (rr * 32 + fq * 4) * 2, VSTR_MEM, rpb, 0, 0);
            }
            attn_finish(o, l, Y + ((size_t)tok0 + qb * 16 + fr) * DM + 1536 + hm * 128 + fq * 4);
        }
    }
    __builtin_amdgcn_fence(__ATOMIC_RELEASE, "workgroup"); __syncthreads(); __builtin_amdgcn_fence(__ATOMIC_ACQUIRE, "workgroup");
    P5_LAUNDER(); (void)fr; (void)fq;
    for (int t = wave; t < 64; t += 8) rescale_row(Y + ((size_t)tok0 + t) * DM, P.in[15], P.in[16], P.in[17], lane);
}

__device__ __forceinline__ void naive_p5(const Ptrs& P, int gw, int ngw, int lane) {
    const bf16_t* proj = (const bf16_t*)(P.ws + WS_PROJ); const bf16_t* vt = (const bf16_t*)(P.ws + WS_VT);
    const bf16_t* km = (const bf16_t*)(P.ws + WS_KM); const bf16_t* vmt = (const bf16_t*)(P.ws + WS_VMT);
    bf16_t* Y = (bf16_t*)(P.ws + WS_XN);
    for (int task = gw; task < MTOK * 16; task += ngw) {
        const int t = task >> 4, sub = task & 15, b = t / SEQ, pos = t % SEQ;
        if (sub < 12) {
            const bool na = sub < 8; const int h = na ? sub : sub - 8;
            const unsigned qw = *(const unsigned*)(proj + (size_t)t * PROJ_LD + (na ? 0 : 2560) + h * 128 + 2 * lane);
            const float q0 = bflo(qw), q1 = bfhi(qw);
            const int r = pos >> 6, c = pos & 63, rs = min(max(r - 4, 0), 56), cs = min(max(c - 8, 0), 48);
            float m = -3.0e38f, l = 0.f, o0 = 0.f, o1 = 0.f;
            const int nk = na ? 128 : 256;
            for (int kk = 0; kk < nk; ++kk) {
                float bias = 0.f; size_t koff, voff;
                if (na) { const int kr = rs + (kk >> 4), kc = cs + (kk & 15), kt = b * SEQ + kr * 64 + kc;
                    koff = (size_t)kt * PROJ_LD + 1024 + h * 128 + 2 * lane; voff = (size_t)(h * 128 + 2 * lane) * VT_LD + kt;
                    bias = P.in[10][(h * 15 + (kr - r + 7)) * 31 + min(max(kc - c, -15), 15) + 15] * LOG2E;
                } else { koff = (size_t)(b * 256 + kk) * 512 + h * 128 + 2 * lane; voff = (size_t)(h * 128 + 2 * lane) * 1024 + b * 256 + kk; }
                const unsigned kw = *(const unsigned*)((na ? proj : km) + koff);
                const float s = wave_sum(q0 * bflo(kw) + q1 * bfhi(kw)) + bias;
                const bf16_t* vb = na ? vt : vmt; const int vl = na ? VT_LD : 1024;
                const float v0 = bf1(vb[voff]), v1 = bf1(vb[voff + vl]);
                const float mn = fmaxf(m, s), al = fexp2(m - mn), p = fexp2(s - mn); m = mn;
                l = l * al + p; o0 = o0 * al + p * v0; o1 = o1 * al + p * v1;
            }
            const float inv = 1.0f / l;
            *(unsigned*)(Y + (size_t)t * DM + (na ? 0 : 1536) + h * 128 + 2 * lane) = pk2(o0 * inv, o1 * inv);
        } else {
            const int g = sub - 12, p = pos & 127, ctok = t - p;
            float a0 = 0.f, a1 = 0.f;
            const float lg0 = P.in[11][g * 128 + 2 * lane], lg1 = P.in[11][g * 128 + 2 * lane + 1], lb0 = P.in[12][g * 128 + 2 * lane], lb1 = P.in[12][g * 128 + 2 * lane + 1];
            for (int q = 0; q < 128; ++q) {
                const float x0 = bf1(vt[(size_t)(1024 + g * 128 + 2 * lane) * VT_LD + ctok + q]), x1 = bf1(vt[(size_t)(1024 + g * 128 + 2 * lane + 1) * VT_LD + ctok + q]);
                const float mu = wave_sum(x0 + x1) * (1.0f / 128), d0 = x0 - mu, d1 = x1 - mu;
                const float rstd = rsqrtf(wave_sum(d0 * d0 + d1 * d1) * (1.0f / 128) + EPS);
                const float w = P.in[13][(size_t)(g * 128 + p) * 128 + q];
                a0 += w * (d0 * rstd * lg0 + lb0); a1 += w * (d1 * rstd * lg1 + lb1);
            }
            const float bs = P.in[14][g * 128 + p];
            const unsigned uw = *(const unsigned*)(proj + (size_t)t * PROJ_LD + 2048 + g * 128 + 2 * lane);
            *(unsigned*)(Y + (size_t)t * DM + 1024 + g * 128 + 2 * lane) = pk2(bflo(uw) * (a0 + bs), bfhi(uw) * (a1 + bs));
        }
    }
}

#define XB_TMO      128
#define XB_XCNT(j)  (256  + 64 * (j))
#define XB_XSUB(j)  (1280 + 64 * (j))
#define XB_XGEN(j)  (2304 + 64 * (j))
#define XB_TOP      3328
#define XB_TOPGEN   3392
#define XCD_BAR_WORDS 3456
#define XB_SPIN_CAP (1u << 18)
__device__ __forceinline__ unsigned xb_ld(unsigned* p)              { return __hip_atomic_load(p, __ATOMIC_RELAXED, __HIP_MEMORY_SCOPE_AGENT); }
__device__ __forceinline__ unsigned xb_add(unsigned* p, unsigned v) { return __hip_atomic_fetch_add(p, v, __ATOMIC_RELAXED, __HIP_MEMORY_SCOPE_AGENT); }
__device__ __forceinline__ unsigned xb_xcc_id() { return (unsigned)__builtin_amdgcn_s_getreg((3 << 11) | 20) & 0xFu; }
#define XB_SPIN(cond, bar) do { unsigned _sp = 0; while (cond) { __builtin_amdgcn_s_sleep(1); \
    if ((++_sp & 255u) == 0u) { if (xb_ld(&(bar)[XB_TMO])) break; if (_sp > XB_SPIN_CAP) { atomicAdd(&(bar)[XB_TMO], 1u); break; } } } } while (0)
struct XcdBarrier { unsigned* bar; unsigned x; volatile LAS unsigned* st; };
__device__ __forceinline__ XcdBarrier xcd_barrier_post(unsigned* bar, volatile LAS unsigned* st) {
    XcdBarrier b; b.bar = bar; b.x = xb_xcc_id(); b.st = st;
    if (threadIdx.x == 0) (void)xb_add(&bar[XB_XCNT(b.x)], 1u);
    return b;
}
__device__ __forceinline__ void xcd_barrier_complete(unsigned* bar, unsigned x, unsigned& nloc, unsigned& nx) {
    const unsigned G = gridDim.x * gridDim.y * gridDim.z;
    unsigned sum, cnt, mine, sp = 0u;
    for (;;) {
        sum = 0u; cnt = 0u; mine = 0u;
#pragma unroll
        for (unsigned j = 0; j < 16; ++j) { const unsigned c = xb_ld(&bar[XB_XCNT(j)]); sum += c; cnt += (c > 0u) ? 1u : 0u; mine = (j == x) ? c : mine; }
        if (sum == G) break;
        __builtin_amdgcn_s_sleep(1);
        if ((++sp & 255u) == 0u) { if (xb_ld(&bar[XB_TMO])) break; if (sp > XB_SPIN_CAP) { atomicAdd(&bar[XB_TMO], 1u); break; } }
    }
    nloc = mine > 0u ? mine : 1u; nx = cnt > 0u ? cnt : 1u;
}
__device__ __forceinline__ void xcd_barrier(const XcdBarrier& b) {
    asm volatile("s_waitcnt vmcnt(0)" ::: "memory");
    __syncthreads();
    if (threadIdx.x == 0) {
        unsigned* bar = b.bar;
        __builtin_amdgcn_s_waitcnt(0);
        unsigned nloc = b.st[0], nx = b.st[1];
        if (nloc == 0u) { xcd_barrier_complete(bar, b.x, nloc, nx); b.st[0] = nloc; b.st[1] = nx; }
        const unsigned old = xb_add(&bar[XB_XSUB(b.x)], 1u);
        const unsigned gen = old / nloc;
        if (old + 1u == (gen + 1u) * nloc) {
            __builtin_amdgcn_fence(__ATOMIC_RELEASE, "agent");
            asm volatile("s_waitcnt vmcnt(0)" ::: "memory");
            const unsigned og = xb_add(&bar[XB_TOP], 1u);
            const unsigned tg = og / nx;
            if (og + 1u == (tg + 1u) * nx) xb_add(&bar[XB_TOPGEN], 1u);
            else XB_SPIN(xb_ld(&bar[XB_TOPGEN]) == tg, bar);
            __builtin_amdgcn_fence(__ATOMIC_ACQUIRE, "agent");
            xb_add(&bar[XB_XGEN(b.x)], 1u);
            asm volatile("s_waitcnt vmcnt(0)" ::: "memory");
        } else {
            XB_SPIN(xb_ld(&bar[XB_XGEN(b.x)]) == gen, bar);
            __builtin_amdgcn_fence(__ATOMIC_ACQUIRE, "agent");
            asm volatile("s_waitcnt vmcnt(0)" ::: "memory");
        }
    }
    __syncthreads();
}

struct Args { const float* in[25]; float* out; unsigned char* ws; int ph_lo, ph_hi; };

__global__ void __launch_bounds__(512, 2) fwd_kernel(Args a) {
    extern __shared__ __attribute__((aligned(16))) unsigned char smem[];
    LAS unsigned char* lds = (LAS unsigned char*)smem;
    cg::grid_group grid = cg::this_grid();
    const int wave0 = __builtin_amdgcn_readfirstlane((int)threadIdx.x >> 6);
    const int G = gridDim.x, bid = blockIdx.x, ngw = G * 8;
    Ptrs P;
#pragma unroll
    for (int i = 0; i < 25; ++i) P.in[i] = a.in[i];
    P.out = a.out; P.ws = a.ws;
    unsigned char* ws = a.ws;
    bf16_t* XN = (bf16_t*)(ws + WS_XN)  ; bf16_t* H = (bf16_t*)(ws + WS_H); bf16_t* F = (bf16_t*)(ws + WS_F);
    float* RS = (float*)(ws + WS_RS); bf16_t* Yb = (bf16_t*)a.out;

    int probe_rep = 0;
    const bool multi = (a.ph_hi - a.ph_lo) > 1;
    volatile LAS unsigned* xb_st = (volatile LAS unsigned*)(lds + LDS_BYTES - 16);
    XcdBarrier bar; bar.bar = (unsigned*)(ws + WS_BAR); bar.x = 0; bar.st = xb_st;
    if (multi) { if (threadIdx.x == 0) { xb_st[0] = 0u; xb_st[1] = 0u; } __syncthreads(); bar = xcd_barrier_post((unsigned*)(ws + WS_BAR), xb_st); }
    if (a.ph_hi > 1000) grid.sync();
    if (PROBE_PH == 99) for (int i = 0; i < PROBE_N; ++i) xcd_barrier(bar);
    for (int ph = a.ph_lo; ph < a.ph_hi; ++ph) {
        if (ph == 6 && !NAIVE_P5) continue;
        int tid = wave0 * 64 + (int)__builtin_amdgcn_mbcnt_hi(~0u, __builtin_amdgcn_mbcnt_lo(~0u, 0u)); asm volatile("" : "+v"(tid));
        const int lane = tid & 63, wave = __builtin_amdgcn_readfirstlane(tid >> 6), gw = bid * 8 + wave;
        const bool is_gemm = (ph == 1 || ph == 2 || ph == 4 || ph == 7 || ph == 9 || ph == 10);
        if (is_gemm) {
            pg8::GP p; p.K = DM; p.G = G; p.c = bid; p.mode = 1; p.ld = DM; p.out = F; p.nM0 = 64; p.nN0 = 8; p.total = 512;
            p.proj = (bf16_t*)(ws + WS_PROJ); p.vt = (bf16_t*)(ws + WS_VT); p.km = (bf16_t*)(ws + WS_KM); p.vmt = (bf16_t*)(ws + WS_VMT);
            const bf16_t* win = (const bf16_t*)(ws + WS_WIN); const bf16_t* wmkv = (const bf16_t*)(ws + WS_WMKV); const bf16_t* memn = (const bf16_t*)(ws + WS_MEMN);
            p.rs = RS; p.A0 = XN; p.B0 = (const bf16_t*)(ws + WS_WOUT);
            p.A1 = win + (size_t)3072 * DM; p.B1 = XN; p.A2 = memn; p.B2 = wmkv; p.A3 = wmkv + (size_t)512 * DM; p.B3 = memn;
            if (ph == 1 || ph == 9) { p.B0 = (const bf16_t*)(ws + (ph == 1 ? WS_WGU1 : WS_WGU2)); p.nN0 = 44; p.total = 64 * 44; p.mode = 0; p.out = H; }
            else if (ph == 7) { p.A0 = Yb; }
            else if (ph == 2 || ph == 10) { p.A0 = H; p.B0 = (const bf16_t*)(ws + (ph == 2 ? WS_WD1 : WS_WD2)); p.K = DFF; }
            else if (ph == 4) { p.B0 = win; p.nN0 = 12; p.total = 1168; p.mode = 2; }
#if NAIVE_GEMM
            if (p.mode == 0) simple_gemm_swiglu(p.A0, p.B0, H, gw, ngw, lane);
            else {
                simple_gemm_job(p.A0, p.B0, p.nM0 * 256, p.nN0 * 256, p.K, 0, p.proj, p.vt, p.km, p.vmt, p.mode, p.out, p.ld, gw, ngw, lane);
                if (p.mode == 2) {
                    simple_gemm_job(p.A1, p.B1, 6 * 256, 64 * 256, p.K, 1, p.proj, p.vt, p.km, p.vmt, 2, p.out, p.ld, gw, ngw, lane);
                    simple_gemm_job(p.A2, p.B2, 4 * 256, 2 * 256, p.K, 2, p.proj, p.vt, p.km, p.vmt, 2, p.out, p.ld, gw, ngw, lane);
                    simple_gemm_job(p.A3, p.B3, 2 * 256, 4 * 256, p.K, 3, p.proj, p.vt, p.km, p.vmt, 2, p.out, p.ld, gw, ngw, lane);
                }
            }
#else
            pg8::gemm_phase(lds, p, tid);
#endif
        } else if (ph == 0) {
            LAS float* scr = (LAS float*)(lds + wave * (64 * 65 * 4));
            constexpr int I_GU = 32 * 176, I_D = 88 * 32, I_IN = 32 * 72, I_MKV = 32 * 16, I_OUT = 32 * 32;
            constexpr int NITEMS = 2 * I_GU + 2 * I_D + I_IN + I_MKV + I_OUT;
            for (int it = gw; it < NITEMS; it += ngw) {
                int r = it;
                if (r < I_GU) { const int nb = r % 176; transpose_item(P.in[3], DM, NGU, (bf16_t*)(ws + WS_WGU1), r / 176, nb, map_gu(nb), scr, lane, P.in[2]); continue; } r -= I_GU;
                if (r < I_GU) { const int nb = r % 176; transpose_item(P.in[21], DM, NGU, (bf16_t*)(ws + WS_WGU2), r / 176, nb, map_gu(nb), scr, lane, P.in[20]); continue; } r -= I_GU;
                if (r < I_D) { const int nb = r % 32; transpose_item(P.in[4], DFF, DM, (bf16_t*)(ws + WS_WD1), r / 32, nb, nb * 64, scr, lane); continue; } r -= I_D;
                if (r < I_D) { const int nb = r % 32; transpose_item(P.in[22], DFF, DM, (bf16_t*)(ws + WS_WD2), r / 32, nb, nb * 64, scr, lane); continue; } r -= I_D;
                if (r < I_IN) { const int nb = r % 72; transpose_item(P.in[8], DM, 4608, (bf16_t*)(ws + WS_WIN), r / 72, nb, map_win(nb), scr, lane, P.in[6]); continue; } r -= I_IN;
                if (r < I_MKV) { const int nb = r % 16; transpose_item(P.in[9], DM, 1024, (bf16_t*)(ws + WS_WMKV), r / 16, nb, nb * 64, scr, lane); continue; } r -= I_MKV;
                { const int nb = r % 32; transpose_item(P.in[18], DM, DM, (bf16_t*)(ws + WS_WOUT), r / 32, nb, nb * 64, scr, lane); }
            }
            for (int i = gw * 64 + lane; i < 4 * 128 * 128 / 2; i += ngw * 64) { const float2 v = *(const float2*)(P.in[13] + 2 * i); ((unsigned*)(ws + WS_WSB))[i] = pk2(v.x, v.y); }
            for (int m = gw; m < MTOK; m += ngw) x_row(P.in[0] + (size_t)m * DM, XN + (size_t)m * DM, RS + m, lane);
            for (int m = gw; m < 1024; m += ngw) norm_row_bf16(P.in[1] + (size_t)m * DM, P.in[7], (bf16_t*)(ws + WS_MEMN) + (size_t)m * DM, lane);
        } else if (ph == 3) {
            for (int m = gw; m < MTOK; m += ngw) resid_row<false>(F + (size_t)m * DM, XN + (size_t)m * DM, P.in[5], 0.5f, RS + m, nullptr, nullptr, lane);
        } else if (ph == 8) {
            for (int m = gw; m < MTOK; m += ngw) resid_row<false>(F + (size_t)m * DM, XN + (size_t)m * DM, P.in[19], 1.0f, RS + m, nullptr, nullptr, lane);
        } else if (ph == 11) {
            for (int m = gw; m < MTOK; m += ngw) resid_row<true>(F + (size_t)m * DM, XN + (size_t)m * DM, P.in[23], 0.5f, nullptr, P.in[24], P.out + (size_t)m * DM, lane);
        } else if (ph == 5) {
#if NAIVE_P5
            naive_p5(P, gw, ngw, lane);
#else
            for (int u = bid; u < 256; u += G) p5_unit(P, lds, u, tid, wave);
#endif
        } else if (ph == 6) {
            for (int m = gw; m < MTOK; m += ngw) rescale_row(XN + (size_t)m * DM, P.in[15], P.in[16], P.in[17], lane);
        }
        if (ph + 1 < a.ph_hi) xcd_barrier(bar);
        if (ph == PROBE_PH && probe_rep < PROBE_N) { ++probe_rep; --ph; }
    }
}

extern "C" void kernel_launch(void* const* d_in, const int* in_sizes, int n_in, void* d_out, int out_size, void* d_ws, size_t ws_size, hipStream_t stream) {
    static int grid = 0;
    if (grid == 0) {
        if (n_in != 25 || out_size != MTOK * DM || ws_size < WS_TOTAL) { fprintf(stderr, "kernel_launch: unexpected problem (n_in %d, out %d, ws %zu < %zu)\n", n_in, out_size, ws_size, (size_t)WS_TOTAL); grid = -1; return; }
        int dev = 0, cus = 0, per_cu = 0;
        (void)hipGetDevice(&dev);
        (void)hipDeviceGetAttribute(&cus, hipDeviceAttributeMultiprocessorCount, dev);
        (void)hipFuncSetAttribute((const void*)fwd_kernel, hipFuncAttributeMaxDynamicSharedMemorySize, LDS_BYTES);
        (void)hipOccupancyMaxActiveBlocksPerMultiprocessor(&per_cu, (const void*)fwd_kernel, 512, LDS_BYTES);
        if (per_cu < 1) { fprintf(stderr, "kernel_launch: occupancy query says %d blocks per CU\n", per_cu); per_cu = 1; }
        grid = cus * 1;
        (void)hipGetLastError();
    }
    if (grid < 0) return;
    Args a{};
    for (int i = 0; i < 25; ++i) a.in[i] = (const float*)d_in[i];
    a.out = (float*)d_out; a.ws = (unsigned char*)d_ws;
#if MULTI_LAUNCH
    for (int ph = 0; ph < NPHASE; ++ph) {
        if (ph == 6 && !NAIVE_P5) continue;
        a.ph_lo = ph; a.ph_hi = ph + 1;
        hipLaunchKernelGGL(fwd_kernel, dim3(grid), dim3(512), LDS_BYTES, stream, a);
    }
#else
    a.ph_lo = 0; a.ph_hi = NPHASE;
    (void)hipMemsetAsync((unsigned char*)d_ws + WS_BAR, 0, 16384, stream);
    void* args[] = {&a};
    hipError_t e = hipLaunchCooperativeKernel((const void*)fwd_kernel, dim3(grid), dim3(512), args, LDS_BYTES, stream);
    if (e != hipSuccess) fprintf(stderr, "cooperative launch failed: %s (grid %d)\n", hipGetErrorString(e), grid);
#endif
}
```

```cpp
#include <hip/hip_runtime.h>
#include <hip/hip_cooperative_groups.h>
#include <cstdio>
namespace cg = cooperative_groups;

#define LAS __attribute__((address_space(3)))
#define SCHED_FENCE() __builtin_amdgcn_sched_barrier(0)
typedef unsigned short bf16_t;
typedef short bf16x8 __attribute__((ext_vector_type(8)));
typedef float f32x4 __attribute__((ext_vector_type(4)));
typedef unsigned u32x4 __attribute__((ext_vector_type(4)));
typedef unsigned u32x2 __attribute__((ext_vector_type(2)));
typedef float f32x2 __attribute__((ext_vector_type(2)));

constexpr int MTOK = 16384, DM = 2048, DFF = 5632, NGU = 11264, SEQ = 4096;
constexpr int PROJ_LD = 3072, VT_LD = 16384;
constexpr float EPS = 1e-6f;
constexpr float LOG2E = 1.4426950408889634f;
constexpr float QSCALE = 0.08838834764831845f * LOG2E;
constexpr int NPHASE = 12;
constexpr int LDS_BYTES = 156 * 1024;

constexpr size_t WS_WGU1 = 0;
constexpr size_t WS_WD1 = WS_WGU1 + (size_t)NGU * DM * 2;
constexpr size_t WS_WIN = WS_WD1 + (size_t)DM * DFF * 2;
constexpr size_t WS_WMKV = WS_WIN + (size_t)4608 * DM * 2;
constexpr size_t WS_WOUT = WS_WMKV + (size_t)1024 * DM * 2;
constexpr size_t WS_WGU2 = WS_WOUT + (size_t)DM * DM * 2;
constexpr size_t WS_WD2 = WS_WGU2 + (size_t)NGU * DM * 2;
constexpr size_t WS_WSB = WS_WD2 + (size_t)DM * DFF * 2;
constexpr size_t WS_MEMN = WS_WSB + (size_t)4 * 128 * 128 * 2;
constexpr size_t WS_KM = WS_MEMN + (size_t)1024 * DM * 2;
constexpr size_t WS_VMT = WS_KM + (size_t)1024 * 512 * 2;
constexpr size_t WS_XN = WS_VMT + (size_t)512 * 1024 * 2;
constexpr size_t WS_H = WS_XN + (size_t)MTOK * DM * 2;
constexpr size_t WS_PROJ = WS_H;
constexpr size_t WS_VT = WS_H + (size_t)MTOK * PROJ_LD * 2;
constexpr size_t WS_F = WS_H + (size_t)MTOK * DFF * 2;
constexpr size_t WS_END = WS_F + (size_t)MTOK * DM * 2;
static_assert(WS_VT + (size_t)1536 * VT_LD * 2 <= WS_F, "overlay");
constexpr size_t WS_BAR = WS_END;
constexpr size_t WS_RS = WS_BAR + 16384;
constexpr size_t WS_TOTAL = WS_RS + (size_t)MTOK * 4;
static_assert(WS_TOTAL <= (size_t)536870912, "workspace");

__device__ __forceinline__ unsigned pk2(float lo, float hi) { unsigned r; asm("v_cvt_pk_bf16_f32 %0, %1, %2" : "=v"(r) : "v"(lo), "v"(hi)); return r; }
__device__ __forceinline__ float bflo(unsigned u) { return __uint_as_float(u << 16); }
__device__ __forceinline__ float bfhi(unsigned u) { return __uint_as_float(u & 0xffff0000u); }
__device__ __forceinline__ float bf1(bf16_t b) { return __uint_as_float(((unsigned)b) << 16); }
__device__ __forceinline__ float shfl_xor_l(float v, int lane, int mask) { return __int_as_float(__builtin_amdgcn_ds_bpermute((lane ^ mask) << 2, __float_as_int(v))); }
__device__ __forceinline__ float wave_sum(float v, int lane) {
#pragma unroll
    for (int o = 1; o < 64; o <<= 1) v += shfl_xor_l(v, lane, o);
    return v;
}
__device__ __forceinline__ float fexp2(float x) { return __builtin_amdgcn_exp2f(x); }
__device__ __forceinline__ float frcp(float x) { return __builtin_amdgcn_rcpf(x); }
__device__ __forceinline__ float gelu_tanh(float x) {
    const float t = x * (1.0f + 0.044715f * x * x);
    return x * frcp(1.0f + fexp2(t * (-2.0f * 0.7978845608028654f * LOG2E)));
}
__device__ __forceinline__ float silu_mul(float g, float u) { return g * frcp(1.0f + fexp2(g * (-LOG2E))) * u; }
__device__ __forceinline__ f32x4 mfma16(bf16x8 a, bf16x8 b, f32x4 c) { return __builtin_amdgcn_mfma_f32_16x16x32_bf16(a, b, c, 0, 0, 0); }

struct OutBf {
    bf16_t* base; int ld; int act; float sc;
    __device__ __forceinline__ f32x4 xf(f32x4 v) const {
        v = v * sc;
        if (act) { v.x = gelu_tanh(v.x); v.y = gelu_tanh(v.y); v.z = gelu_tanh(v.z); v.w = gelu_tanh(v.w); }
        return v;
    }
    __device__ __forceinline__ void st4(int row, int col, f32x4 v) const {
        v = xf(v); u32x2 w; w.x = pk2(v.x, v.y); w.y = pk2(v.z, v.w);
        *(u32x2*)(base + (size_t)row * ld + col) = w;
    }
    __device__ __forceinline__ void st8(int row, int col, f32x4 a, f32x4 b) const {
        a = xf(a); b = xf(b); u32x4 w; w.x = pk2(a.x, a.y); w.y = pk2(a.z, a.w); w.z = pk2(b.x, b.y); w.w = pk2(b.z, b.w);
        *(u32x4*)(base + (size_t)row * ld + col) = w;
    }
};
__device__ __forceinline__ OutBf p4_sel(int job, int pm, int pn, bf16_t* proj, bf16_t* vt, bf16_t* km, bf16_t* vmt) {
    OutBf o; o.act = 0; o.sc = 1.0f; o.base = proj; o.ld = PROJ_LD;
    if (job == 0) { if (pn < 4 || pn >= 10) o.sc = QSCALE; else if (pn >= 8) o.act = 1; }
    if (job == 1) { o.base = vt; o.ld = VT_LD; if (pm >= 4) o.act = 1; }
    if (job == 2) { o.base = km; o.ld = 512; }
    if (job == 3) { o.base = vmt; o.ld = 1024; }
    return o;
}

namespace pg8 {
constexpr int BM = 256, BK = 64, HALF = 128, HTB = HALF * BK * 2, STAGE_BYTES = 8 * HTB, NXCD = 8, WGM = 4;
__device__ __forceinline__ int lds_byte(int r, int c) { const int st = (r >> 4) * 2 + (c >> 5), rr = r & 15, cc = c & 31, ob = rr * 64 + cc * 2; return st * 1024 + (ob ^ (((ob >> 9) & 1) << 5)); }
__device__ __forceinline__ void stage_rc(int b, int& R, int& C) { const int st = b / 1024, sb = b % 1024, swz = sb ^ (((sb >> 9) & 1) << 5); R = (st >> 1) * 16 + swz / 64; C = (st & 1) * 32 + (swz % 64) / 2; }
__device__ __forceinline__ int perm32(int rho) { const int n = rho >> 4, i = rho & 15; return 8 * (i >> 2) + 4 * n + (i & 3); }

struct Unit { int pm, pn, job; const bf16_t* A; const bf16_t* B; };
struct GP {
    int K, G, c, mode, ld, nM0, nN0, total;
    bf16_t* out; const bf16_t *A0, *B0, *A1, *B1, *A2, *B2, *A3, *B3; bf16_t *proj, *vt, *km, *vmt; const float* rs;
};
__device__ __forceinline__ bool sched_next(int i, Unit& u, int G, int c, int total, int mode, int nM0, int nN0, const bf16_t* A0, const bf16_t* B0,
                                           const bf16_t* A1, const bf16_t* B1, const bf16_t* A2, const bf16_t* B2, const bf16_t* A3, const bf16_t* B3) {
    const int L = i * G + c; if (L >= total) return false;
    int job = 0, st = 0, nM = nM0, nN = nN0; const bf16_t* pa = A0; const bf16_t* pb = B0;
    if (mode == 2) {
        if (L >= 768) { job = 1; st = 768; nM = 6; nN = 64; pa = A1; pb = B1; }
        if (L >= 1152) { job = 2; st = 1152; nM = 4; nN = 2; pa = A2; pb = B2; }
        if (L >= 1160) { job = 3; st = 1160; nM = 2; nN = 4; pa = A3; pb = B3; }
    }
    int wgid = L - st; const int nwg = nM * nN;
    { const int q = nwg / NXCD, r = nwg % NXCD, xcd = wgid % NXCD, off = wgid / NXCD; wgid = (xcd < r ? xcd * (q + 1) : r * (q + 1) + (xcd - r) * q) + off; }
    const int nig = WGM * nN, gid = wgid / nig, fm = gid * WGM, gsz = (nM - fm) < WGM ? (nM - fm) : WGM;
    u.pm = fm + ((wgid % nig) % gsz); u.pn = (wgid % nig) / gsz; u.job = job; u.A = pa; u.B = pb; return true;
}
__device__ __forceinline__ void epilogue(const f32x4 (&acc)[2][2][4][2], const Unit& u, int wr, int wc, int fr, int fq, int mode, bf16_t* out, int ld, bf16_t* proj, bf16_t* vt, bf16_t* km, bf16_t* vmt, const float* rs, const float (&rsv)[2][4]) {
    const int row0 = u.pm * BM + wr * 64 + fr, cb = wc * 32 + 8 * fq;
    if (mode == 0) {
#pragma unroll
        for (int ai = 0; ai < 2; ++ai)
#pragma unroll
            for (int m = 0; m < 4; ++m) {
                const float r = rsv[ai][m];
                const f32x4 g0 = acc[ai][0][m][0] * r, g1 = acc[ai][0][m][1] * r, u0 = acc[ai][1][m][0] * r, u1 = acc[ai][1][m][1] * r;
                u32x4 w;
                w.x = pk2(silu_mul(g0.x, u0.x), silu_mul(g0.y, u0.y)); w.y = pk2(silu_mul(g0.z, u0.z), silu_mul(g0.w, u0.w));
                w.z = pk2(silu_mul(g1.x, u1.x), silu_mul(g1.y, u1.y)); w.w = pk2(silu_mul(g1.z, u1.z), silu_mul(g1.w, u1.w));
                *(u32x4*)(out + (size_t)(row0 + ai * HALF + m * 16) * DFF + u.pn * 128 + cb) = w;
            }
    } else {
        OutBf o; o.base = out; o.ld = ld; o.act = 0; o.sc = 1.0f;
        if (mode == 2) o = p4_sel(u.job, u.pm, u.pn, proj, vt, km, vmt);
        const bool rowsc = (mode == 2 && u.job == 0), colsc = (mode == 2 && u.job == 1);
        f32x4 c0[2], c1[2];
#pragma unroll
        for (int bj = 0; bj < 2; ++bj) { c0[bj] = (f32x4){1.f, 1.f, 1.f, 1.f}; c1[bj] = c0[bj];
            if (colsc) { const float* cp = rs + u.pn * BM + bj * HALF + cb; c0[bj] = *(const f32x4*)cp; c1[bj] = *(const f32x4*)(cp + 4); } }
#pragma unroll
        for (int ai = 0; ai < 2; ++ai)
#pragma unroll
            for (int m = 0; m < 4; ++m) {
                const float r = rowsc ? rsv[ai][m] : 1.0f;
#pragma unroll
                for (int bj = 0; bj < 2; ++bj)
                    o.st8(row0 + ai * HALF + m * 16, u.pn * BM + bj * HALF + cb, acc[ai][bj][m][0] * c0[bj] * r, acc[ai][bj][m][1] * c1[bj] * r);
            }
    }
}

__device__ __forceinline__ void gemm_phase(LAS unsigned char* lds, const GP p, const int tid) {
    const int K = p.K; const size_t tstep = (size_t)256 * K * 2;
#define SNEXT(i, u) sched_next(i, u, p.G, p.c, p.total, p.mode, p.nM0, p.nN0, p.A0, p.B0, p.A1, p.B1, p.A2, p.B2, p.A3, p.B3)
#define APTR(u) ((const char*)(u).A + (size_t)(u).pm * tstep)
#define BPTR(u) ((const char*)(u).B + (size_t)(u).pn * tstep)
    const int wid = __builtin_amdgcn_readfirstlane(tid >> 6), lane = tid & 63, wr = wid >> 2, wc = wid & 3, fr = lane & 15, fq = lane >> 4;
    const int nt = K / BK;
    unsigned voffA[2], voffB[2];
#pragma unroll
    for (int i = 0; i < 2; ++i) { int R, C; stage_rc(tid * 16 + i * 8192, R, C); const int Rb = (R & ~31) + perm32(R & 31);
        voffA[i] = (unsigned)(R * K + C) * 2u; voffB[i] = (unsigned)(Rb * K + C) * 2u; }
    const size_t kstep = (size_t)(BK * 2);
    const size_t hstep = (size_t)HALF * K * 2;
    const unsigned ldsw = (unsigned)wid * 1024u;
    const int aoff = lds_byte(wr * 64 + fr, fq * 8), boff = lds_byte(wc * 32 + fr, fq * 8);
#define PG8_SA(b, h) (((b) * 2 + (h)) * HTB)
#define PG8_SB(b, h) ((4 + (b) * 2 + (h)) * HTB)
#define PG8_STAGE(bufoff, gbase, voff) do { _Pragma("unroll") for (int _i = 0; _i < 2; ++_i) \
        __builtin_amdgcn_global_load_lds((const unsigned*)((const char*)(gbase) + (voff)[_i]), (LAS unsigned*)(lds + (bufoff) + ldsw + _i * 8192), 16, 0, 0); } while (0)
#define PG8_LDA(dst, b, h) do { _Pragma("unroll") for (int m = 0; m < 4; ++m) _Pragma("unroll") for (int k = 0; k < 2; ++k) dst[m][k] = *(const LAS bf16x8*)(lds + PG8_SA(b, h) + aoff + m * 2048 + k * 1024); } while (0)
#define PG8_LDB(dst, b, h) do { _Pragma("unroll") for (int n = 0; n < 2; ++n) _Pragma("unroll") for (int k = 0; k < 2; ++k) dst[n][k] = *(const LAS bf16x8*)(lds + PG8_SB(b, h) + boff + n * 2048 + k * 1024); } while (0)
#define PG8_MMA(ai, bj, At, Bt) do { __builtin_amdgcn_s_setprio(1); _Pragma("unroll") for (int m = 0; m < 4; ++m) _Pragma("unroll") for (int n = 0; n < 2; ++n) _Pragma("unroll") for (int k = 0; k < 2; ++k) \
        acc[ai][bj][m][n] = __builtin_amdgcn_mfma_f32_16x16x32_bf16(Bt[n][k], At[m][k], acc[ai][bj][m][n], 0, 0, 0); __builtin_amdgcn_s_setprio(0); } while (0)
#define PG8_WAIT_V(n) asm volatile("s_waitcnt vmcnt(" #n ")" ::: "memory")
#define PG8_WAIT_L(n) asm volatile("s_waitcnt lgkmcnt(" #n ")" ::: "memory")
#define PG8_BAR __builtin_amdgcn_s_barrier()
#define PG8_SCHED __builtin_amdgcn_sched_barrier(0)
    Unit cur, nxt; int ui = 0;
    if (!SNEXT(0, cur)) return;
    f32x4 acc[2][2][4][2];
#pragma unroll
    for (int a = 0; a < 2; ++a)
#pragma unroll
        for (int b = 0; b < 2; ++b)
#pragma unroll
            for (int m = 0; m < 4; ++m)
#pragma unroll
                for (int n = 0; n < 2; ++n) acc[a][b][m][n] = (f32x4){0.f, 0.f, 0.f, 0.f};
    bf16x8 At[4][2], B0[2][2], B1[2][2];
    float rsv[2][4];
#pragma unroll
    for (int ai = 0; ai < 2; ++ai)
#pragma unroll
        for (int m = 0; m < 4; ++m) rsv[ai][m] = 1.0f;
    const char* cA = APTR(cur); const char* cB = BPTR(cur);
    PG8_STAGE(PG8_SB(0, 0), cB, voffB); PG8_STAGE(PG8_SB(0, 1), cB + hstep, voffB); PG8_STAGE(PG8_SA(0, 0), cA, voffA); PG8_STAGE(PG8_SA(0, 1), cA + hstep, voffA);
    if (wr == 1) PG8_BAR;
    PG8_WAIT_V(2); PG8_BAR;
    PG8_STAGE(PG8_SB(1, 0), cB + kstep, voffB); PG8_STAGE(PG8_SA(1, 0), cA + kstep, voffA); PG8_STAGE(PG8_SB(1, 1), cB + hstep + kstep, voffB);
    PG8_WAIT_V(6); PG8_BAR;
    for (;;) {
        const bool has_next = SNEXT(ui + 1, nxt);
        const char* nA = has_next ? APTR(nxt) : cA; const char* nB = has_next ? BPTR(nxt) : cB;
        for (int t = 0; t < nt; t += 2) {
            const bool last = (t == nt - 2);
            if (last && p.mode != 1) {
                const float* rp = p.rs + cur.pm * BM + wr * 64 + fr;
#pragma unroll
                for (int ai = 0; ai < 2; ++ai)
#pragma unroll
                    for (int m = 0; m < 4; ++m) rsv[ai][m] = rp[ai * HALF + m * 16];
            }
            const char* a1 = cA + (size_t)(t + 1) * kstep;
            const char* a2 = last ? nA : cA + (size_t)(t + 2) * kstep; const char* b2 = last ? nB : cB + (size_t)(t + 2) * kstep;
            const char* a3 = a2 + kstep; const char* b3 = b2 + kstep;
            PG8_LDB(B0, 0, 0); PG8_LDB(B1, 0, 1); PG8_SCHED; PG8_LDA(At, 0, 0); PG8_STAGE(PG8_SA(1, 1), a1 + hstep, voffA);
            PG8_WAIT_V(8); PG8_WAIT_L(0); PG8_BAR; PG8_MMA(0, 0, At, B0); PG8_MMA(0, 1, At, B1); PG8_BAR; PG8_SCHED;
            PG8_LDA(At, 0, 1); PG8_STAGE(PG8_SB(0, 0), b2, voffB); PG8_STAGE(PG8_SB(0, 1), b2 + hstep, voffB); PG8_STAGE(PG8_SA(0, 0), a2, voffA);
            PG8_WAIT_V(8); PG8_WAIT_L(0); PG8_BAR; PG8_MMA(1, 0, At, B0); PG8_MMA(1, 1, At, B1); PG8_BAR; PG8_SCHED;
            PG8_LDB(B0, 1, 0); PG8_LDB(B1, 1, 1); PG8_SCHED; PG8_LDA(At, 1, 0); PG8_STAGE(PG8_SA(0, 1), a2 + hstep, voffA);
            PG8_WAIT_V(8); PG8_WAIT_L(0); PG8_BAR; PG8_MMA(0, 0, At, B0); PG8_MMA(0, 1, At, B1); PG8_BAR; PG8_SCHED;
            PG8_LDA(At, 1, 1); PG8_STAGE(PG8_SB(1, 0), b3, voffB); PG8_STAGE(PG8_SB(1, 1), b3 + hstep, voffB); PG8_STAGE(PG8_SA(1, 0), a3, voffA);
            PG8_WAIT_V(8); PG8_WAIT_L(0); PG8_BAR; PG8_MMA(1, 0, At, B0); PG8_MMA(1, 1, At, B1); PG8_BAR; PG8_SCHED;
        }
        if (wr == 0) PG8_BAR;
        epilogue(acc, cur, wr, wc, fr, fq, p.mode, p.out, p.ld, p.proj, p.vt, p.km, p.vmt, p.rs, rsv);
        if (!has_next) break;
#pragma unroll
        for (int a = 0; a < 2; ++a)
#pragma unroll
            for (int b = 0; b < 2; ++b)
#pragma unroll
                for (int m = 0; m < 4; ++m)
#pragma unroll
                    for (int n = 0; n < 2; ++n) acc[a][b][m][n] = (f32x4){0.f, 0.f, 0.f, 0.f};
        cur = nxt; cA = nA; cB = nB; ++ui;
        if (wr == 1) PG8_BAR;
    }
    PG8_WAIT_V(0);
    PG8_BAR;
#undef SNEXT
#undef APTR
#undef BPTR
#undef PG8_SA
#undef PG8_SB
#undef PG8_STAGE
#undef PG8_LDA
#undef PG8_LDB
#undef PG8_MMA
#undef PG8_WAIT_V
#undef PG8_WAIT_L
#undef PG8_BAR
#undef PG8_SCHED
}
}

__device__ __forceinline__ void transpose_item(const float* W, int K, int N, bf16_t* WT, int kb, int nbd, int src0, LAS float* scr, int lane, const float* gk = nullptr) {
    const int k0 = kb * 64;
    const float* wp = W + (size_t)(k0 + (lane >> 4)) * N + src0 + (lane & 15) * 4;
    f32x4 v[16];
#pragma unroll
    for (int i = 0; i < 16; ++i) v[i] = *(const f32x4*)(wp + (size_t)(4 * i) * N);
    SCHED_FENCE();
#pragma unroll
    for (int i = 0; i < 16; ++i) { if (gk) v[i] = v[i] * gk[k0 + 4 * i + (lane >> 4)];
        LAS float* s = scr + (4 * i + (lane >> 4)) * 65 + (lane & 15) * 4; s[0] = v[i].x; s[1] = v[i].y; s[2] = v[i].z; s[3] = v[i].w; }
    const int c = lane & 7;
#pragma unroll
    for (int jj = 0; jj < 8; ++jj) {
        const int n = (lane >> 3) + 8 * jj; const LAS float* s = scr + (8 * c) * 65 + n;
        u32x4 o; o.x = pk2(s[0], s[65]); o.y = pk2(s[2 * 65], s[3 * 65]); o.z = pk2(s[4 * 65], s[5 * 65]); o.w = pk2(s[6 * 65], s[7 * 65]);
        *(u32x4*)(WT + (size_t)(nbd * 64 + n) * K + k0 + 8 * c) = o;
    }
}
__device__ __forceinline__ int map_gu(int nb) { const int j = nb >> 2, part = nb & 3; return part < 2 ? 128 * j + 64 * part : DFF + 128 * j + 64 * (part - 2); }
__device__ __forceinline__ int map_win(int nb) { const int n = nb * 64; return n < 2048 ? n : n < 2560 ? n + 1024 : n < 3072 ? n + 1536 : n < 4096 ? n - 1024 : n - 512; }

__device__ __forceinline__ void norm_row_bf16(const float* xr, const float* g, bf16_t* o, int lane) {
    f32x4 v[8], gv[8]; float s = 0.f;
#pragma unroll
    for (int j = 0; j < 8; ++j) { v[j] = *(const f32x4*)(xr + 256 * j + 4 * lane); gv[j] = *(const f32x4*)(g + 256 * j + 4 * lane); }
    SCHED_FENCE();
#pragma unroll
    for (int j = 0; j < 8; ++j) s += (v[j].x * v[j].x + v[j].y * v[j].y) + (v[j].z * v[j].z + v[j].w * v[j].w);
    const float rs = rsqrtf(wave_sum(s, lane) * (1.0f / DM) + EPS);
#pragma unroll
    for (int j = 0; j < 8; ++j) {
        u32x2 w; w.x = pk2(v[j].x * rs * gv[j].x, v[j].y * rs * gv[j].y); w.y = pk2(v[j].z * rs * gv[j].z, v[j].w * rs * gv[j].w);
        *(u32x2*)(o + 256 * j + 4 * lane) = w; }
}
__device__ __forceinline__ void x_row(const float* xr, bf16_t* h, float* rs_out, int lane) {
    f32x4 v[8]; float s = 0.f;
#pragma unroll
    for (int j = 0; j < 8; ++j) v[j] = *(const f32x4*)(xr + 256 * j + 4 * lane);
    SCHED_FENCE();
#pragma unroll
    for (int j = 0; j < 8; ++j) { s += (v[j].x * v[j].x + v[j].y * v[j].y) + (v[j].z * v[j].z + v[j].w * v[j].w);
        u32x2 w; w.x = pk2(v[j].x, v[j].y); w.y = pk2(v[j].z, v[j].w); *(u32x2*)(h + 256 * j + 4 * lane) = w; }
    const float rs = rsqrtf(wave_sum(s, lane) * (1.0f / DM) + EPS);
    if (lane == 0) *rs_out = rs;
}
template <bool FINAL>
__device__ __forceinline__ void resid_row(const bf16_t* f, bf16_t* h, const f32x4 (&gp)[8], float alpha, float* rs_out, const f32x4 (&gn)[8], float* fin, int lane) {
    u32x2 wf[8], wh[8];
#pragma unroll
    for (int j = 0; j < 8; ++j) { wf[j] = *(const u32x2*)(f + 256 * j + 4 * lane); wh[j] = *(const u32x2*)(h + 256 * j + 4 * lane); }
    SCHED_FENCE();
    f32x4 v[8]; float s = 0.f;
#pragma unroll
    for (int j = 0; j < 8; ++j) { v[j] = (f32x4){bflo(wf[j].x), bfhi(wf[j].x), bflo(wf[j].y), bfhi(wf[j].y)};
        s += (v[j].x * v[j].x + v[j].y * v[j].y) + (v[j].z * v[j].z + v[j].w * v[j].w); }
    const float rs = rsqrtf(wave_sum(s, lane) * (1.0f / DM) + EPS) * alpha;
    float s2 = 0.f;
#pragma unroll
    for (int j = 0; j < 8; ++j) { const f32x4 hv = (f32x4){bflo(wh[j].x), bfhi(wh[j].x), bflo(wh[j].y), bfhi(wh[j].y)};
        v[j] = hv + v[j] * rs * gp[j]; s2 += (v[j].x * v[j].x + v[j].y * v[j].y) + (v[j].z * v[j].z + v[j].w * v[j].w);
        if (!FINAL) { u32x2 hw; hw.x = pk2(v[j].x, v[j].y); hw.y = pk2(v[j].z, v[j].w); *(u32x2*)(h + 256 * j + 4 * lane) = hw; } }
    const float rs2 = rsqrtf(wave_sum(s2, lane) * (1.0f / DM) + EPS);
    if (!FINAL) { if (lane == 0) *rs_out = rs2; }
    else {
#pragma unroll
        for (int j = 0; j < 8; ++j) *(f32x4*)(fin + 256 * j + 4 * lane) = v[j] * rs2 * gn[j]; }
}
template <int NR>
__device__ __forceinline__ void rescale_rows(bf16_t* y, size_t stride, const float* gna, const float* gsg, const float* gmem, int lane) {
    u32x4 w[NR][4];
#pragma unroll
    for (int i = 0; i < NR; ++i)
#pragma unroll
        for (int j = 0; j < 4; ++j) w[i][j] = *(const u32x4*)(y + (size_t)i * stride + 512 * j + 8 * lane);
    f32x4 g0[4], g1[4];
#pragma unroll
    for (int j = 0; j < 4; ++j) { const float* g = (j < 2 ? gna + 512 * j : j == 2 ? gsg : gmem) + 8 * lane; g0[j] = *(const f32x4*)g; g1[j] = *(const f32x4*)(g + 4); }
    SCHED_FENCE();
    float sna[NR], ssg[NR], sme[NR];
#pragma unroll
    for (int i = 0; i < NR; ++i) {
        float ss[4];
#pragma unroll
        for (int j = 0; j < 4; ++j) { const u32x4 v = w[i][j];
            const float a0 = bflo(v.x), a1 = bfhi(v.x), a2 = bflo(v.y), a3 = bfhi(v.y), a4 = bflo(v.z), a5 = bfhi(v.z), a6 = bflo(v.w), a7 = bfhi(v.w);
            ss[j] = (a0 * a0 + a1 * a1) + (a2 * a2 + a3 * a3) + (a4 * a4 + a5 * a5) + (a6 * a6 + a7 * a7); }
        sna[i] = ss[0] + ss[1]; ssg[i] = ss[2]; sme[i] = ss[3];
    }
#pragma unroll
    for (int o = 1; o < 64; o <<= 1)
#pragma unroll
        for (int i = 0; i < NR; ++i) { sna[i] += shfl_xor_l(sna[i], lane, o); ssg[i] += shfl_xor_l(ssg[i], lane, o); sme[i] += shfl_xor_l(sme[i], lane, o); }
#pragma unroll
    for (int i = 0; i < NR; ++i) {
        const float rna = rsqrtf(sna[i] * (1.0f / 1024) + EPS), rsg = rsqrtf(ssg[i] * (1.0f / 512) + EPS), rme = rsqrtf(sme[i] * (1.0f / 512) + EPS);
#pragma unroll
        for (int j = 0; j < 4; ++j) { const float r = j < 2 ? rna : j == 2 ? rsg : rme; const u32x4 v = w[i][j];
            u32x4 o; o.x = pk2(bflo(v.x) * r * g0[j].x, bfhi(v.x) * r * g0[j].y); o.y = pk2(bflo(v.y) * r * g0[j].z, bfhi(v.y) * r * g0[j].w);
            o.z = pk2(bflo(v.z) * r * g1[j].x, bfhi(v.z) * r * g1[j].y); o.w = pk2(bflo(v.w) * r * g1[j].z, bfhi(v.w) * r * g1[j].w);
            *(u32x4*)(y + (size_t)i * stride + 512 * j + 8 * lane) = o; }
    }
}

struct Ptrs {
    const float* in[25]; float* out; unsigned char* ws;
};
constexpr int VVT_LD = 136, RPB_OFF = 143360;
static_assert(2 * 256 * 272 <= RPB_OFF && 512 * VVT_LD * 2 + 4096 <= RPB_OFF && RPB_OFF + 8 * 15 * 32 * 4 <= LDS_BYTES - 16, "P5 LDS map");

constexpr int ABUF2 = 256 * 272;
template <bool NA>
__device__ __forceinline__ void attn_2phase(const bf16_t* qbase  , const bf16_t* kg0, const size_t kstep, const size_t kld,
                                            const bf16_t* vg0, const size_t vstep, const size_t vld, const LAS float* rpb, const int brow0, const int w0, const int qc,
                                            LAS unsigned char* lds, bf16_t* ybase, const int tid, const int lane, const int hh) {
    constexpr int NSTEP = NA ? 4 : 2, NGRP = NA ? 2 : 4, NHP = NA ? 4 : 2;
    const int fr = lane & 15, fq = lane >> 4;
    const unsigned kgo = (unsigned)(((size_t)(tid >> 5) * kld + (tid & 31) * 8) * 2), vgo = (unsigned)(((size_t)(tid >> 4) * vld + (tid & 15) * 8) * 2);
    const unsigned klo = (unsigned)((((tid >> 4) & 1) * 128 + (tid >> 5)) * 272 + (tid & 15) * 16), vlo = (unsigned)((tid >> 4) * 272 + (tid & 15) * 16);
    int bidx[8];
    if (NA) { const int cs = min(max(qc - 8, 0), 48);
#pragma unroll
        for (int e = 0; e < 8; ++e) { const int kc = w0 + (e >> 2) * 16 + fq * 4 + (e & 3); bidx[e] = (kc >= cs && kc < cs + 16) ? min(max(kc - qc, -15), 15) + 15 : 31; } }
    u32x4 t8[8];
#define A2_LOADK(hp_, s_) do { const char* _g = (const char*)(kg0 + (size_t)(s_) * kstep + (hp_) * 256); _Pragma("unroll") for (int j = 0; j < 8; ++j) t8[j] = *(const u32x4*)(_g + (size_t)j * (16 * kld * 2) + kgo); } while (0)
#define A2_LOADV(hp_, s_) do { const char* _g = (const char*)(vg0 + (size_t)(hp_) * 256 * vld + (size_t)(s_) * vstep); _Pragma("unroll") for (int j = 0; j < 8; ++j) t8[j] = *(const u32x4*)(_g + (size_t)j * (32 * vld * 2) + vgo); } while (0)
#define A2_WRITEK(buf_) do { _Pragma("unroll") for (int j = 0; j < 8; ++j) *(LAS u32x4*)((buf_) + klo + j * (16 * 272)) = t8[j]; } while (0)
#define A2_WRITEV(buf_) do { _Pragma("unroll") for (int j = 0; j < 8; ++j) *(LAS u32x4*)((buf_) + vlo + j * (32 * 272)) = t8[j]; } while (0)
    A2_LOADK(0, 0);
    __syncthreads();
    A2_WRITEK(lds);
    __syncthreads();
    int cb = 0;
#pragma unroll 1
    for (int hp = 0; hp < NHP; ++hp) {
        bf16x8 qf[4];
        { const bf16_t* qa = qbase + (hp * 2 + hh) * 128;
#pragma unroll
          for (int dc = 0; dc < 4; ++dc) qf[dc] = *(const bf16x8*)(qa + dc * 32); }
        __builtin_amdgcn_s_waitcnt(0x0F70);
        f32x4 sc[8][2];
#pragma unroll
        for (int ks = 0; ks < NSTEP; ++ks) {
            LAS unsigned char* cur = lds + cb * ABUF2; LAS unsigned char* nxt = lds + (cb ^ 1) * ABUF2;
            if (ks < NSTEP - 1) A2_LOADK(hp, ks + 1); else A2_LOADV(hp, 0);
            SCHED_FENCE();
#pragma unroll
            for (int g = 0; g < NGRP; ++g) {
                const int gi = ks * NGRP + g, koff = NA ? g * 64 + w0 : g * 32;
                const LAS unsigned char* kp = cur + (hh * 128 + koff + fr) * 272 + fq * 16;
                bf16x8 kf[2][4];
#pragma unroll
                for (int a = 0; a < 2; ++a)
#pragma unroll
                    for (int dc = 0; dc < 4; ++dc) kf[a][dc] = *(const LAS bf16x8*)(kp + a * 16 * 272 + dc * 64);
                f32x4 s0 = (f32x4){0.f, 0.f, 0.f, 0.f}, s1 = (f32x4){0.f, 0.f, 0.f, 0.f};
#pragma unroll
                for (int dc = 0; dc < 4; ++dc) { s0 = mfma16(kf[0][dc], qf[dc], s0); s1 = mfma16(kf[1][dc], qf[dc], s1); }
                if (NA) { const LAS float* br = rpb + ((hp * 2 + hh) * 15 + brow0 + 2 * ks + g) * 32;
#pragma unroll
                    for (int e = 0; e < 4; ++e) { s0[e] += br[bidx[e]]; s1[e] += br[bidx[4 + e]]; } }
                sc[gi][0] = s0; sc[gi][1] = s1;
            }
            SCHED_FENCE();
            if (ks < NSTEP - 1) A2_WRITEK(nxt); else A2_WRITEV(nxt);
            __syncthreads(); cb ^= 1;
        }
        float mx = -3.0e38f;
#pragma unroll
        for (int gi = 0; gi < 8; ++gi)
#pragma unroll
            for (int a = 0; a < 2; ++a) mx = fmaxf(mx, fmaxf(fmaxf(sc[gi][a].x, sc[gi][a].y), fmaxf(sc[gi][a].z, sc[gi][a].w)));
        mx = fmaxf(mx, shfl_xor_l(mx, lane, 16)); mx = fmaxf(mx, shfl_xor_l(mx, lane, 32));
        float l = 0.f; bf16x8 pb[8];
#pragma unroll
        for (int gi = 0; gi < 8; ++gi) {
            f32x4 p0 = sc[gi][0], p1 = sc[gi][1];
#pragma unroll
            for (int e = 0; e < 4; ++e) { p0[e] = fexp2(p0[e] - mx); p1[e] = fexp2(p1[e] - mx); }
            l += ((p0.x + p0.y) + (p0.z + p0.w)) + ((p1.x + p1.y) + (p1.z + p1.w));
            u32x4 pw; pw.x = pk2(p0.x, p0.y); pw.y = pk2(p0.z, p0.w); pw.z = pk2(p1.x, p1.y); pw.w = pk2(p1.z, p1.w);
            pb[gi] = __builtin_bit_cast(bf16x8, pw);
        }
        l += shfl_xor_l(l, lane, 16); l += shfl_xor_l(l, lane, 32);
        f32x4 o[8];
#pragma unroll
        for (int d = 0; d < 8; ++d) o[d] = (f32x4){0.f, 0.f, 0.f, 0.f};
#pragma unroll
        for (int vs = 0; vs < NSTEP; ++vs) {
            LAS unsigned char* cur = lds + cb * ABUF2; LAS unsigned char* nxt = lds + (cb ^ 1) * ABUF2;
            if (vs < NSTEP - 1) A2_LOADV(hp, vs + 1); else if (hp < NHP - 1) A2_LOADK(hp + 1, 0);
            SCHED_FENCE();
#pragma unroll
            for (int g = 0; g < NGRP; ++g) {
                const int gi = vs * NGRP + g, voff = NA ? g * 64 + w0 : g * 32;
                const LAS unsigned char* vp = cur + (hh * 128 + fr) * 272 + (voff + fq * 4) * 2;
#pragma unroll
                for (int d = 0; d < 8; ++d) {
                    const u32x2 lo = *(const LAS u32x2*)(vp + d * 16 * 272), hi = *(const LAS u32x2*)(vp + d * 16 * 272 + 32);
                    u32x4 vw; vw.x = lo.x; vw.y = lo.y; vw.z = hi.x; vw.w = hi.y;
                    o[d] = mfma16(__builtin_bit_cast(bf16x8, vw), pb[gi], o[d]);
                }
            }
            SCHED_FENCE();
            if (vs < NSTEP - 1) A2_WRITEV(nxt); else if (hp < NHP - 1) A2_WRITEK(nxt);
            __syncthreads(); cb ^= 1;
        }
        const float inv = frcp(l);
        bf16_t* yp = ybase + (hp * 2 + hh) * 128;
#pragma unroll
        for (int d = 0; d < 8; ++d) { u32x2 w; w.x = pk2(o[d].x * inv, o[d].y * inv); w.y = pk2(o[d].z * inv, o[d].w * inv); *(u32x2*)(yp + d * 16) = w; }
    }
#undef A2_LOADK
#undef A2_LOADV
#undef A2_WRITEK
#undef A2_WRITEV
}

#define P5_LAUNDER() int tid = tid_in; asm volatile("" : "+v"(tid)); const int lane = tid & 63, fr = lane & 15, fq = lane >> 4
__device__ __forceinline__ void p5_unit(const Ptrs& P, LAS unsigned char* lds, int unit, int tid_in, int wave) {
    const bf16_t* proj = (const bf16_t*)(P.ws + WS_PROJ); const bf16_t* vt = (const bf16_t*)(P.ws + WS_VT);
    const bf16_t* km = (const bf16_t*)(P.ws + WS_KM); const bf16_t* vmt = (const bf16_t*)(P.ws + WS_VMT);
    const bf16_t* wsb = (const bf16_t*)(P.ws + WS_WSB);
    bf16_t* Y = (bf16_t*)P.out;
    const int b = unit >> 6, r = unit & 63, tok0 = b * SEQ + r * 64;
    const int rs = min(max(r - 4, 0), 56);
    LAS float* rpb = (LAS float*)(lds + RPB_OFF);
    LAS bf16_t* vvt = (LAS bf16_t*)lds;
    __syncthreads();
    {
        P5_LAUNDER(); (void)fr; (void)fq; (void)lane;
        float rv[8];
#pragma unroll
        for (int k = 0; k < 8; ++k) { const int i = min(tid + 512 * k, 8 * 15 * 32 - 1), c = i & 31; rv[k] = P.in[10][(i >> 5) * 31 + min(c, 30)]; }
        SCHED_FENCE();
#pragma unroll
        for (int k = 0; k < 8; ++k) { const int i = tid + 512 * k; if (i < 8 * 15 * 32) rpb[i] = (i & 31) < 31 ? rv[k] * LOG2E : -1.0e30f; }
    }
    {
        P5_LAUNDER(); (void)fr; (void)fq;
        const int t = tid >> 4, p = tid & 15, ctok = b * SEQ + (r >> 1) * 128;
        const char* vg = (const char*)(vt + (size_t)1024 * VT_LD + ctok);
        const unsigned vgo = (unsigned)(t * VT_LD + p * 8) * 2u;
        u32x4 d[16];
#pragma unroll
        for (int j = 0; j < 16; ++j) d[j] = *(const u32x4*)(vg + (size_t)j * (32 * VT_LD * 2) + vgo);
        SCHED_FENCE();
        LAS float* st = (LAS float*)lds;
        LAS float* st2 = (LAS float*)(lds + 512 * VVT_LD * 2);
#pragma unroll
        for (int g = 0; g < 4; ++g) {
            float sm[8], sq[8];
#pragma unroll
            for (int k = 0; k < 8; ++k) { sm[k] = 0.f; sq[k] = 0.f; }
#pragma unroll
            for (int jj = 0; jj < 4; ++jj) { const u32x4 w = d[4 * g + jj];
                const float x0 = bflo(w.x), x1 = bfhi(w.x), x2 = bflo(w.y), x3 = bfhi(w.y), x4 = bflo(w.z), x5 = bfhi(w.z), x6 = bflo(w.w), x7 = bfhi(w.w);
                sm[0] += x0; sq[0] += x0 * x0; sm[1] += x1; sq[1] += x1 * x1; sm[2] += x2; sq[2] += x2 * x2; sm[3] += x3; sq[3] += x3 * x3;
                sm[4] += x4; sq[4] += x4 * x4; sm[5] += x5; sq[5] += x5 * x5; sm[6] += x6; sq[6] += x6 * x6; sm[7] += x7; sq[7] += x7 * x7; }
            LAS f32x4* sp = (LAS f32x4*)(st + ((g * 32 + t) * 128 + p * 8) * 2);
            sp[0] = (f32x4){sm[0], sq[0], sm[1], sq[1]}; sp[1] = (f32x4){sm[2], sq[2], sm[3], sq[3]}; sp[2] = (f32x4){sm[4], sq[4], sm[5], sq[5]}; sp[3] = (f32x4){sm[6], sq[6], sm[7], sq[7]};
        }
        __syncthreads();
        float lgv[16], lbv[16];
        { const float* lgp = P.in[11] + t; const float* lbp = P.in[12] + t;
#pragma unroll
          for (int j = 0; j < 16; ++j) { lgv[j] = lgp[32 * j]; lbv[j] = lbp[32 * j]; } }
        SCHED_FENCE();
        {   const int g = tid >> 7, tok = tid & 127; float a = 0.f, q2 = 0.f;
#pragma unroll 8
            for (int tt = 0; tt < 32; ++tt) { const f32x2 v2 = *(const LAS f32x2*)(st + ((g * 32 + tt) * 128 + tok) * 2); a += v2.x; q2 += v2.y; }
            const float mu = a * (1.0f / 128), var = fmaxf(q2 * (1.0f / 128) - mu * mu, 0.f);
            *(LAS f32x2*)(st2 + (g * 128 + tok) * 2) = (f32x2){mu, rsqrtf(var + EPS)}; }
        __syncthreads();
#pragma unroll
        for (int g = 0; g < 4; ++g) {
            const LAS f32x4* mp = (const LAS f32x4*)(st2 + (g * 128 + p * 8) * 2);
            const f32x4 m01 = mp[0], m23 = mp[1], m45 = mp[2], m67 = mp[3];
#pragma unroll
            for (int jj = 0; jj < 4; ++jj) { const u32x4 w = d[4 * g + jj]; const int c = t + 32 * jj;
                const float lg = lgv[4 * g + jj], lb = lbv[4 * g + jj];
                u32x4 o;
                o.x = pk2((bflo(w.x) - m01.x) * m01.y * lg + lb, (bfhi(w.x) - m01.z) * m01.w * lg + lb);
                o.y = pk2((bflo(w.y) - m23.x) * m23.y * lg + lb, (bfhi(w.y) - m23.z) * m23.w * lg + lb);
                o.z = pk2((bflo(w.z) - m45.x) * m45.y * lg + lb, (bfhi(w.z) - m45.z) * m45.w * lg + lb);
                o.w = pk2((bflo(w.w) - m67.x) * m67.y * lg + lb, (bfhi(w.w) - m67.z) * m67.w * lg + lb);
                *(LAS u32x4*)(vvt + (g * 128 + c) * VVT_LD + p * 8) = o; }
        }
    }
    __syncthreads();
    {
        P5_LAUNDER();
        const int g = wave & 3, half = wave >> 2;
#pragma unroll 1
        for (int pb = 0; pb < 2; ++pb) {
            const int pl = half * 32 + pb * 16 + fr, pp = (r & 1) * 64 + pl;
            bf16x8 wf[4]; u32x2 uw[8];
            const bf16_t* up = proj + ((size_t)tok0 + pl) * PROJ_LD + 2048 + g * 128 + fq * 4;
#pragma unroll
            for (int qc = 0; qc < 4; ++qc) wf[qc] = *(const bf16x8*)(wsb + (size_t)(g * 128 + pp) * 128 + qc * 32 + fq * 8);
#pragma unroll
            for (int c = 0; c < 8; ++c) uw[c] = *(const u32x2*)(up + c * 16);
            const float bs = P.in[14][g * 128 + pp];
            f32x4 acc[8];
#pragma unroll
            for (int c = 0; c < 8; ++c) acc[c] = (f32x4){0.f, 0.f, 0.f, 0.f};
#pragma unroll
            for (int qc = 0; qc < 4; ++qc)
#pragma unroll
                for (int c = 0; c < 8; ++c) {
                    const bf16x8 af = *(const LAS bf16x8*)(vvt + (g * 128 + c * 16 + fr) * VVT_LD + qc * 32 + fq * 8);
                    acc[c] = mfma16(af, wf[qc], acc[c]);
                }
            bf16_t* yp = Y + ((size_t)tok0 + pl) * DM + 1024 + g * 128 + fq * 4;
#pragma unroll
            for (int c = 0; c < 8; ++c) {
                u32x2 w; w.x = pk2(bflo(uw[c].x) * (acc[c].x + bs), bfhi(uw[c].x) * (acc[c].y + bs)); w.y = pk2(bflo(uw[c].y) * (acc[c].z + bs), bfhi(uw[c].y) * (acc[c].w + bs));
                *(u32x2*)(yp + c * 16) = w; }
        }
    }
    {
        P5_LAUNDER();
        const int hh = wave & 1, qb = wave >> 1;
        const int w0 = qb == 0 ? 0 : qb == 1 ? 8 : qb == 2 ? 24 : 32;
        const size_t qtok = (size_t)tok0 + qb * 16 + fr;
        const size_t ktok = (size_t)b * SEQ + rs * 64;
        attn_2phase<true>(proj + qtok * PROJ_LD + fq * 8, proj + ktok * PROJ_LD + 1024, (size_t)128 * PROJ_LD, (size_t)PROJ_LD,
                          vt + ktok, (size_t)128, (size_t)VT_LD, rpb, rs - r + 7, w0, qb * 16 + fr, lds, Y + qtok * DM + fq * 4, tid, lane, hh);
        attn_2phase<false>(proj + qtok * PROJ_LD + 2560 + fq * 8, km + (size_t)(b * 256) * 512, (size_t)128 * 512, (size_t)512,
                           vmt + b * 256, (size_t)128, (size_t)1024, rpb, 0, 0, 0, lds, Y + qtok * DM + 1536 + fq * 4, tid, lane, hh);
    }
    __builtin_amdgcn_fence(__ATOMIC_RELEASE, "workgroup"); __syncthreads(); __builtin_amdgcn_fence(__ATOMIC_ACQUIRE, "workgroup");
    P5_LAUNDER(); (void)fr; (void)fq;
#pragma unroll 1
    for (int hb = 0; hb < 2; ++hb) rescale_rows<4>(Y + ((size_t)tok0 + wave * 8 + hb * 4) * DM, (size_t)DM, P.in[15], P.in[16], P.in[17], lane);
}

#define XB_TMO      128
#define XB_XCNT(j)  (256  + 64 * (j))
#define XB_XSUB(j)  (1280 + 64 * (j))
#define XB_XGEN(j)  (2304 + 64 * (j))
#define XB_TOP      3328
#define XB_TOPGEN   3392
#define XCD_BAR_WORDS 3456
#define XB_SPIN_CAP (1u << 18)
__device__ __forceinline__ unsigned xb_ld(unsigned* p)              { return __hip_atomic_load(p, __ATOMIC_RELAXED, __HIP_MEMORY_SCOPE_AGENT); }
__device__ __forceinline__ unsigned xb_add(unsigned* p, unsigned v) { return __hip_atomic_fetch_add(p, v, __ATOMIC_RELAXED, __HIP_MEMORY_SCOPE_AGENT); }
__device__ __forceinline__ unsigned xb_xcc_id() { return (unsigned)__builtin_amdgcn_s_getreg((3 << 11) | 20) & 0xFu; }
#define XB_SPIN(cond, bar) do { unsigned _sp = 0; while (cond) { __builtin_amdgcn_s_sleep(1); \
    if ((++_sp & 255u) == 0u) { if (xb_ld(&(bar)[XB_TMO])) break; if (_sp > XB_SPIN_CAP) { atomicAdd(&(bar)[XB_TMO], 1u); break; } } } } while (0)
struct XcdBarrier { unsigned* bar; unsigned x; volatile LAS unsigned* st; };
__device__ __forceinline__ XcdBarrier xcd_barrier_post(unsigned* bar, volatile LAS unsigned* st) {
    XcdBarrier b; b.bar = bar; b.x = xb_xcc_id(); b.st = st;
    if (threadIdx.x == 0) (void)xb_add(&bar[XB_XCNT(b.x)], 1u);
    return b;
}
__device__ __forceinline__ void xcd_barrier_complete(unsigned* bar, unsigned x, unsigned& nloc, unsigned& nx) {
    const unsigned G = gridDim.x * gridDim.y * gridDim.z;
    unsigned sum, cnt, mine, sp = 0u;
    for (;;) {
        sum = 0u; cnt = 0u; mine = 0u;
        unsigned cv[16];
#pragma unroll
        for (unsigned j = 0; j < 16; ++j) cv[j] = xb_ld(&bar[XB_XCNT(j)]);
        SCHED_FENCE();
#pragma unroll
        for (unsigned j = 0; j < 16; ++j) { const unsigned c = cv[j]; sum += c; cnt += (c > 0u) ? 1u : 0u; mine = (j == x) ? c : mine; }
        if (sum == G) break;
        __builtin_amdgcn_s_sleep(1);
        if ((++sp & 255u) == 0u) { if (xb_ld(&bar[XB_TMO])) break; if (sp > XB_SPIN_CAP) { atomicAdd(&bar[XB_TMO], 1u); break; } }
    }
    nloc = mine > 0u ? mine : 1u; nx = cnt > 0u ? cnt : 1u;
}
__device__ __forceinline__ void xcd_barrier(const XcdBarrier& b) {
    asm volatile("s_waitcnt vmcnt(0)" ::: "memory");
    __syncthreads();
    if (threadIdx.x == 0) {
        unsigned* bar = b.bar;
        __builtin_amdgcn_s_waitcnt(0);
        unsigned nloc = b.st[0], nx = b.st[1];
        if (nloc == 0u) { xcd_barrier_complete(bar, b.x, nloc, nx); b.st[0] = nloc; b.st[1] = nx; }
        const unsigned old = xb_add(&bar[XB_XSUB(b.x)], 1u);
        const unsigned gen = old / nloc;
        if (old + 1u == (gen + 1u) * nloc) {
            __builtin_amdgcn_fence(__ATOMIC_RELEASE, "agent");
            asm volatile("s_waitcnt vmcnt(0)" ::: "memory");
            const unsigned og = xb_add(&bar[XB_TOP], 1u);
            const unsigned tg = og / nx;
            if (og + 1u == (tg + 1u) * nx) xb_add(&bar[XB_TOPGEN], 1u);
            else XB_SPIN(xb_ld(&bar[XB_TOPGEN]) == tg, bar);
            __builtin_amdgcn_fence(__ATOMIC_ACQUIRE, "agent");
            xb_add(&bar[XB_XGEN(b.x)], 1u);
            asm volatile("s_waitcnt vmcnt(0)" ::: "memory");
        } else {
            XB_SPIN(xb_ld(&bar[XB_XGEN(b.x)]) == gen, bar);
            __builtin_amdgcn_fence(__ATOMIC_ACQUIRE, "agent");
            asm volatile("s_waitcnt vmcnt(0)" ::: "memory");
        }
    }
    __syncthreads();
}

struct Args { const float* in[25]; float* out; unsigned char* ws; int ph_lo, ph_hi; };

__global__ void __launch_bounds__(512, 2) fwd_kernel(Args a) {
    extern __shared__ __attribute__((aligned(16))) unsigned char smem[];
    LAS unsigned char* lds = (LAS unsigned char*)smem;
    cg::grid_group grid = cg::this_grid();
    const int wave0 = __builtin_amdgcn_readfirstlane((int)threadIdx.x >> 6);
    const int G = gridDim.x, bid = blockIdx.x, ngw = G * 8;
    Ptrs P;
#pragma unroll
    for (int i = 0; i < 25; ++i) P.in[i] = a.in[i];
    P.out = a.out; P.ws = a.ws;
    unsigned char* ws = a.ws;
    bf16_t* XN = (bf16_t*)(ws + WS_XN)  ; bf16_t* H = (bf16_t*)(ws + WS_H); bf16_t* F = (bf16_t*)(ws + WS_F);
    float* RS = (float*)(ws + WS_RS); bf16_t* Yb = (bf16_t*)a.out;

    const bool multi = (a.ph_hi - a.ph_lo) > 1;
    volatile LAS unsigned* xb_st = (volatile LAS unsigned*)(lds + LDS_BYTES - 16);
    XcdBarrier bar; bar.bar = (unsigned*)(ws + WS_BAR); bar.x = 0; bar.st = xb_st;
    if (multi) { if (threadIdx.x == 0) { xb_st[0] = 0u; xb_st[1] = 0u; } __syncthreads(); bar = xcd_barrier_post((unsigned*)(ws + WS_BAR), xb_st); }
    if (a.ph_hi > 1000) grid.sync();
    for (int ph = a.ph_lo; ph < a.ph_hi; ++ph) {
        if (ph == 6) continue;
#define PH_LAUNDER() int tid = wave0 * 64 + (int)__builtin_amdgcn_mbcnt_hi(~0u, __builtin_amdgcn_mbcnt_lo(~0u, 0u)); asm volatile("" : "+v"(tid)); \
        const int lane = tid & 63, wave = wave0, gw = bid * 8 + wave; (void)lane; (void)gw
        const bool is_gemm = (ph == 1 || ph == 2 || ph == 4 || ph == 7 || ph == 9 || ph == 10);
        if (is_gemm) {
            PH_LAUNDER();
            pg8::GP p; p.K = DM; p.G = G; p.c = bid; p.mode = 1; p.ld = DM; p.out = F; p.nM0 = 64; p.nN0 = 8; p.total = 512;
            p.proj = (bf16_t*)(ws + WS_PROJ); p.vt = (bf16_t*)(ws + WS_VT); p.km = (bf16_t*)(ws + WS_KM); p.vmt = (bf16_t*)(ws + WS_VMT);
            const bf16_t* win = (const bf16_t*)(ws + WS_WIN); const bf16_t* wmkv = (const bf16_t*)(ws + WS_WMKV); const bf16_t* memn = (const bf16_t*)(ws + WS_MEMN);
            p.rs = RS; p.A0 = XN; p.B0 = (const bf16_t*)(ws + WS_WOUT);
            p.A1 = win + (size_t)3072 * DM; p.B1 = XN; p.A2 = memn; p.B2 = wmkv; p.A3 = wmkv + (size_t)512 * DM; p.B3 = memn;
            if (ph == 1 || ph == 9) { p.B0 = (const bf16_t*)(ws + (ph == 1 ? WS_WGU1 : WS_WGU2)); p.nN0 = 44; p.total = 64 * 44; p.mode = 0; p.out = H; }
            else if (ph == 7) { p.A0 = Yb; }
            else if (ph == 2 || ph == 10) { p.A0 = H; p.B0 = (const bf16_t*)(ws + (ph == 2 ? WS_WD1 : WS_WD2)); p.K = DFF; }
            else if (ph == 4) { p.B0 = win; p.nN0 = 12; p.total = 1168; p.mode = 2; }
            pg8::gemm_phase(lds, p, tid);
        } else if (ph == 0) {
            PH_LAUNDER();
            LAS float* scr = (LAS float*)(lds + wave * (64 * 65 * 4));
            constexpr int I_GU = 32 * 176, I_D = 88 * 32, I_IN = 32 * 72, I_MKV = 32 * 16, I_OUT = 32 * 32;
            constexpr int NITEMS = 2 * I_GU + 2 * I_D + I_IN + I_MKV + I_OUT;
            for (int it = gw; it < NITEMS; it += ngw) {
                int r = it;
                if (r < I_GU) { const int nb = r % 176; transpose_item(P.in[3], DM, NGU, (bf16_t*)(ws + WS_WGU1), r / 176, nb, map_gu(nb), scr, lane, P.in[2]); continue; } r -= I_GU;
                if (r < I_GU) { const int nb = r % 176; transpose_item(P.in[21], DM, NGU, (bf16_t*)(ws + WS_WGU2), r / 176, nb, map_gu(nb), scr, lane, P.in[20]); continue; } r -= I_GU;
                if (r < I_D) { const int nb = r % 32; transpose_item(P.in[4], DFF, DM, (bf16_t*)(ws + WS_WD1), r / 32, nb, nb * 64, scr, lane); continue; } r -= I_D;
                if (r < I_D) { const int nb = r % 32; transpose_item(P.in[22], DFF, DM, (bf16_t*)(ws + WS_WD2), r / 32, nb, nb * 64, scr, lane); continue; } r -= I_D;
                if (r < I_IN) { const int nb = r % 72; transpose_item(P.in[8], DM, 4608, (bf16_t*)(ws + WS_WIN), r / 72, nb, map_win(nb), scr, lane, P.in[6]); continue; } r -= I_IN;
                if (r < I_MKV) { const int nb = r % 16; transpose_item(P.in[9], DM, 1024, (bf16_t*)(ws + WS_WMKV), r / 16, nb, nb * 64, scr, lane); continue; } r -= I_MKV;
                { const int nb = r % 32; transpose_item(P.in[18], DM, DM, (bf16_t*)(ws + WS_WOUT), r / 32, nb, nb * 64, scr, lane); }
            }
            for (int i = gw * 64 + lane; i < 4 * 128 * 128 / 2; i += ngw * 64) { const float2 v = *(const float2*)(P.in[13] + 2 * i); ((unsigned*)(ws + WS_WSB))[i] = pk2(v.x, v.y); }
            for (int m = gw; m < MTOK; m += ngw) x_row(P.in[0] + (size_t)m * DM, XN + (size_t)m * DM, RS + m, lane);
            for (int m = gw; m < 1024; m += ngw) norm_row_bf16(P.in[1] + (size_t)m * DM, P.in[7], (bf16_t*)(ws + WS_MEMN) + (size_t)m * DM, lane);
        } else if (ph == 3 || ph == 8 || ph == 11) {
            PH_LAUNDER();
            const float* gpp = a.in[ph == 3 ? 5 : ph == 8 ? 19 : 23];
            const float* gnp = a.in[24];
            f32x4 gp[8], gn[8];
#pragma unroll
            for (int j = 0; j < 8; ++j) { gp[j] = *(const f32x4*)(gpp + 256 * j + 4 * lane); gn[j] = *(const f32x4*)(gnp + 256 * j + 4 * lane); }
            if (ph == 11) { for (int m = gw; m < MTOK; m += ngw) resid_row<true>(F + (size_t)m * DM, XN + (size_t)m * DM, gp, 0.5f, nullptr, gn, P.out + (size_t)m * DM, lane); }
            else { const float alpha = ph == 3 ? 0.5f : 1.0f;
                for (int m = gw; m < MTOK; m += ngw) resid_row<false>(F + (size_t)m * DM, XN + (size_t)m * DM, gp, alpha, RS + m, gn, nullptr, lane); }
        } else if (ph == 5) {
            PH_LAUNDER();
            for (int u = bid; u < 256; u += G) p5_unit(P, lds, (G == 256) ? ((u & 7) * 32 + (u >> 3)) : u, tid, wave);
        }
        if (ph + 1 < a.ph_hi) xcd_barrier(bar);
    }
}

extern "C" void kernel_launch(void* const* d_in, const int* in_sizes, int n_in, void* d_out, int out_size, void* d_ws, size_t ws_size, hipStream_t stream) {
    static int grid = 0;
    if (grid == 0) {
        if (n_in != 25 || out_size != MTOK * DM || ws_size < WS_TOTAL) { fprintf(stderr, "kernel_launch: unexpected problem (n_in %d, out %d, ws %zu < %zu)\n", n_in, out_size, ws_size, (size_t)WS_TOTAL); grid = -1; return; }
        int dev = 0, cus = 0, per_cu = 0;
        (void)hipGetDevice(&dev);
        (void)hipDeviceGetAttribute(&cus, hipDeviceAttributeMultiprocessorCount, dev);
        (void)hipFuncSetAttribute((const void*)fwd_kernel, hipFuncAttributeMaxDynamicSharedMemorySize, LDS_BYTES);
        (void)hipOccupancyMaxActiveBlocksPerMultiprocessor(&per_cu, (const void*)fwd_kernel, 512, LDS_BYTES);
        if (per_cu < 1) { fprintf(stderr, "kernel_launch: occupancy query says %d blocks per CU\n", per_cu); per_cu = 1; }
        grid = cus * 1;
        (void)hipGetLastError();
    }
    if (grid < 0) return;
    Args a{};
    for (int i = 0; i < 25; ++i) a.in[i] = (const float*)d_in[i];
    a.out = (float*)d_out; a.ws = (unsigned char*)d_ws;
    a.ph_lo = 0; a.ph_hi = NPHASE;
    (void)hipMemsetAsync((unsigned char*)d_ws + WS_BAR, 0, 16384, stream);
    void* args[] = {&a};
    hipError_t e = hipLaunchCooperativeKernel((const void*)fwd_kernel, dim3(grid), dim3(512), args, LDS_BYTES, stream);
    if (e != hipSuccess) fprintf(stderr, "cooperative launch failed: %s (grid %d)\n", hipGetErrorString(e), grid);
}
```

```cpp
#include <hip/hip_runtime.h>
#include <hip/hip_cooperative_groups.h>
#include <cstdio>
namespace cg = cooperative_groups;

#define LAS __attribute__((address_space(3)))
#define SCHED_FENCE() __builtin_amdgcn_sched_barrier(0)
typedef unsigned short bf16_t;
typedef short bf16x8 __attribute__((ext_vector_type(8)));
typedef float f32x4 __attribute__((ext_vector_type(4)));
typedef unsigned u32x4 __attribute__((ext_vector_type(4)));
typedef unsigned u32x2 __attribute__((ext_vector_type(2)));
typedef float f32x2 __attribute__((ext_vector_type(2)));

constexpr int MTOK = 16384, DM = 2048, DFF = 5632, NGU = 11264, SEQ = 4096;
constexpr int PROJ_LD = 3072, VT_LD = 16384;
constexpr float EPS = 1e-6f;
constexpr float LOG2E = 1.4426950408889634f;
constexpr float QSCALE = 0.08838834764831845f * LOG2E;
constexpr int NPHASE = 12;
constexpr int LDS_BYTES = 156 * 1024;

constexpr size_t WS_WGU1 = 0;
constexpr size_t WS_WD1 = WS_WGU1 + (size_t)NGU * DM * 2;
constexpr size_t WS_WIN = WS_WD1 + (size_t)DM * DFF * 2;
constexpr size_t WS_WMKV = WS_WIN + (size_t)4608 * DM * 2;
constexpr size_t WS_WOUT = WS_WMKV + (size_t)1024 * DM * 2;
constexpr size_t WS_WGU2 = WS_WOUT + (size_t)DM * DM * 2;
constexpr size_t WS_WD2 = WS_WGU2 + (size_t)NGU * DM * 2;
constexpr size_t WS_WSB = WS_WD2 + (size_t)DM * DFF * 2;
constexpr size_t WS_MEMN = WS_WSB + (size_t)4 * 128 * 128 * 2;
constexpr size_t WS_KM = WS_MEMN + (size_t)1024 * DM * 2;
constexpr size_t WS_VMT = WS_KM + (size_t)1024 * 512 * 2;
constexpr size_t WS_XN = WS_VMT + (size_t)512 * 1024 * 2;
constexpr size_t WS_H = WS_XN + (size_t)MTOK * DM * 2;
constexpr size_t WS_PROJ = WS_H;
constexpr size_t WS_VT = WS_H + (size_t)MTOK * PROJ_LD * 2;
constexpr size_t WS_F = WS_H + (size_t)MTOK * DFF * 2;
constexpr size_t WS_END = WS_F + (size_t)MTOK * DM * 2;
static_assert(WS_VT + (size_t)1536 * VT_LD * 2 <= WS_F, "overlay");
constexpr size_t WS_BAR = WS_END;
constexpr size_t WS_RS = WS_BAR + 16384;
constexpr size_t WS_TOTAL = WS_RS + (size_t)MTOK * 4;
static_assert(WS_TOTAL <= (size_t)536870912, "workspace");

__device__ __forceinline__ unsigned pk2(float lo, float hi) { unsigned r; asm("v_cvt_pk_bf16_f32 %0, %1, %2" : "=v"(r) : "v"(lo), "v"(hi)); return r; }
__device__ __forceinline__ float bflo(unsigned u) { return __uint_as_float(u << 16); }
__device__ __forceinline__ float bfhi(unsigned u) { return __uint_as_float(u & 0xffff0000u); }
__device__ __forceinline__ float bf1(bf16_t b) { return __uint_as_float(((unsigned)b) << 16); }
__device__ __forceinline__ float shfl_xor_l(float v, int lane, int mask) { return __int_as_float(__builtin_amdgcn_ds_bpermute((lane ^ mask) << 2, __float_as_int(v))); }
__device__ __forceinline__ float wave_sum(float v, int lane) {
#pragma unroll
    for (int o = 1; o < 64; o <<= 1) v += shfl_xor_l(v, lane, o);
    return v;
}
__device__ __forceinline__ float fexp2(float x) { return __builtin_amdgcn_exp2f(x); }
__device__ __forceinline__ float frcp(float x) { return __builtin_amdgcn_rcpf(x); }
__device__ __forceinline__ float gelu_tanh(float x) {
    const float t = x * (1.0f + 0.044715f * x * x);
    return x * frcp(1.0f + fexp2(t * (-2.0f * 0.7978845608028654f * LOG2E)));
}
__device__ __forceinline__ float silu_mul(float g, float u) { return g * frcp(1.0f + fexp2(g * (-LOG2E))) * u; }
__device__ __forceinline__ f32x4 mfma16(bf16x8 a, bf16x8 b, f32x4 c) { return __builtin_amdgcn_mfma_f32_16x16x32_bf16(a, b, c, 0, 0, 0); }

struct OutBf {
    bf16_t* base; int ld; int act; float sc;
    __device__ __forceinline__ f32x4 xf(f32x4 v) const {
        v = v * sc;
        if (act) { v.x = gelu_tanh(v.x); v.y = gelu_tanh(v.y); v.z = gelu_tanh(v.z); v.w = gelu_tanh(v.w); }
        return v;
    }
    __device__ __forceinline__ void st4(int row, int col, f32x4 v) const {
        v = xf(v); u32x2 w; w.x = pk2(v.x, v.y); w.y = pk2(v.z, v.w);
        *(u32x2*)(base + (size_t)row * ld + col) = w;
    }
    __device__ __forceinline__ void st8(int row, int col, f32x4 a, f32x4 b) const {
        a = xf(a); b = xf(b); u32x4 w; w.x = pk2(a.x, a.y); w.y = pk2(a.z, a.w); w.z = pk2(b.x, b.y); w.w = pk2(b.z, b.w);
        *(u32x4*)(base + (size_t)row * ld + col) = w;
    }
};
__device__ __forceinline__ OutBf p4_sel(int job, int pm, int pn, bf16_t* proj, bf16_t* vt, bf16_t* km, bf16_t* vmt) {
    OutBf o; o.act = 0; o.sc = 1.0f; o.base = proj; o.ld = PROJ_LD;
    if (job == 0) { if (pn < 4 || pn >= 10) o.sc = QSCALE; else if (pn >= 8) o.act = 1; }
    if (job == 1) { o.base = vt; o.ld = VT_LD; if (pm >= 4) o.act = 1; }
    if (job == 2) { o.base = km; o.ld = 512; }
    if (job == 3) { o.base = vmt; o.ld = 1024; }
    return o;
}

namespace pg8 {
constexpr int BM = 256, BK = 64, HALF = 128, HTB = HALF * BK * 2, STAGE_BYTES = 8 * HTB, NXCD = 8, WGM = 4;
__device__ __forceinline__ int lds_byte(int r, int c) { const int st = (r >> 4) * 2 + (c >> 5), rr = r & 15, cc = c & 31, ob = rr * 64 + cc * 2; return st * 1024 + (ob ^ (((ob >> 9) & 1) << 5)); }
__device__ __forceinline__ void stage_rc(int b, int& R, int& C) { const int st = b / 1024, sb = b % 1024, swz = sb ^ (((sb >> 9) & 1) << 5); R = (st >> 1) * 16 + swz / 64; C = (st & 1) * 32 + (swz % 64) / 2; }
__device__ __forceinline__ int perm32(int rho) { const int n = rho >> 4, i = rho & 15; return 8 * (i >> 2) + 4 * n + (i & 3); }

struct Unit { int pm, pn, job; const bf16_t* A; const bf16_t* B; };
struct GP {
    int K, G, c, mode, ld, nM0, nN0, total;
    bf16_t* out; const bf16_t *A0, *B0, *A1, *B1, *A2, *B2, *A3, *B3; bf16_t *proj, *vt, *km, *vmt; const float* rs;
};
__device__ __forceinline__ bool sched_next(int i, Unit& u, int G, int c, int total, int mode, int nM0, int nN0, const bf16_t* A0, const bf16_t* B0,
                                           const bf16_t* A1, const bf16_t* B1, const bf16_t* A2, const bf16_t* B2, const bf16_t* A3, const bf16_t* B3) {
    const int L = i * G + c; if (L >= total) return false;
    int job = 0, st = 0, nM = nM0, nN = nN0; const bf16_t* pa = A0; const bf16_t* pb = B0;
    if (mode == 2) {
        if (L >= 768) { job = 1; st = 768; nM = 6; nN = 64; pa = A1; pb = B1; }
        if (L >= 1152) { job = 2; st = 1152; nM = 4; nN = 2; pa = A2; pb = B2; }
        if (L >= 1160) { job = 3; st = 1160; nM = 2; nN = 4; pa = A3; pb = B3; }
    }
    int wgid = L - st; const int nwg = nM * nN;
    { const int q = nwg / NXCD, r = nwg % NXCD, xcd = wgid % NXCD, off = wgid / NXCD; wgid = (xcd < r ? xcd * (q + 1) : r * (q + 1) + (xcd - r) * q) + off; }
    const int nig = WGM * nN, gid = wgid / nig, fm = gid * WGM, gsz = (nM - fm) < WGM ? (nM - fm) : WGM;
    u.pm = fm + ((wgid % nig) % gsz); u.pn = (wgid % nig) / gsz; u.job = job; u.A = pa; u.B = pb; return true;
}
__device__ __forceinline__ void epilogue(const f32x4 (&acc)[2][2][4][2], const Unit& u, int wr, int wc, int fr, int fq, int mode, bf16_t* out, int ld, bf16_t* proj, bf16_t* vt, bf16_t* km, bf16_t* vmt, const float* rs, const float (&rsv)[2][4]) {
    const int row0 = u.pm * BM + wr * 64 + fr, cb = wc * 32 + 8 * fq;
    if (mode == 0) {
#pragma unroll
        for (int ai = 0; ai < 2; ++ai)
#pragma unroll
            for (int m = 0; m < 4; ++m) {
                const float r = rsv[ai][m];
                const f32x4 g0 = acc[ai][0][m][0] * r, g1 = acc[ai][0][m][1] * r, u0 = acc[ai][1][m][0] * r, u1 = acc[ai][1][m][1] * r;
                u32x4 w;
                w.x = pk2(silu_mul(g0.x, u0.x), silu_mul(g0.y, u0.y)); w.y = pk2(silu_mul(g0.z, u0.z), silu_mul(g0.w, u0.w));
                w.z = pk2(silu_mul(g1.x, u1.x), silu_mul(g1.y, u1.y)); w.w = pk2(silu_mul(g1.z, u1.z), silu_mul(g1.w, u1.w));
                *(u32x4*)(out + (size_t)(row0 + ai * HALF + m * 16) * DFF + u.pn * 128 + cb) = w;
            }
    } else {
        OutBf o; o.base = out; o.ld = ld; o.act = 0; o.sc = 1.0f;
        if (mode == 2) o = p4_sel(u.job, u.pm, u.pn, proj, vt, km, vmt);
        const bool rowsc = (mode == 2 && u.job == 0), colsc = (mode == 2 && u.job == 1);
        f32x4 c0[2], c1[2];
#pragma unroll
        for (int bj = 0; bj < 2; ++bj) { c0[bj] = (f32x4){1.f, 1.f, 1.f, 1.f}; c1[bj] = c0[bj];
            if (colsc) { const float* cp = rs + u.pn * BM + bj * HALF + cb; c0[bj] = *(const f32x4*)cp; c1[bj] = *(const f32x4*)(cp + 4); } }
#pragma unroll
        for (int ai = 0; ai < 2; ++ai)
#pragma unroll
            for (int m = 0; m < 4; ++m) {
                const float r = rowsc ? rsv[ai][m] : 1.0f;
#pragma unroll
                for (int bj = 0; bj < 2; ++bj)
                    o.st8(row0 + ai * HALF + m * 16, u.pn * BM + bj * HALF + cb, acc[ai][bj][m][0] * c0[bj] * r, acc[ai][bj][m][1] * c1[bj] * r);
            }
    }
}

__device__ __forceinline__ void gemm_phase(LAS unsigned char* lds, const GP p, const int tid) {
    const int K = p.K; const size_t tstep = (size_t)256 * K * 2;
#define SNEXT(i, u) sched_next(i, u, p.G, p.c, p.total, p.mode, p.nM0, p.nN0, p.A0, p.B0, p.A1, p.B1, p.A2, p.B2, p.A3, p.B3)
#define APTR(u) ((const char*)(u).A + (size_t)(u).pm * tstep)
#define BPTR(u) ((const char*)(u).B + (size_t)(u).pn * tstep)
    const int wid = __builtin_amdgcn_readfirstlane(tid >> 6), lane = tid & 63, wr = wid >> 2, wc = wid & 3, fr = lane & 15, fq = lane >> 4;
    const int nt = K / BK;
    unsigned voffA[2], voffB[2];
#pragma unroll
    for (int i = 0; i < 2; ++i) { int R, C; stage_rc(tid * 16 + i * 8192, R, C); const int Rb = (R & ~31) + perm32(R & 31);
        voffA[i] = (unsigned)(R * K + C) * 2u; voffB[i] = (unsigned)(Rb * K + C) * 2u; }
    const size_t kstep = (size_t)(BK * 2);
    const size_t hstep = (size_t)HALF * K * 2;
    const unsigned ldsw = (unsigned)wid * 1024u;
    const int aoff = lds_byte(wr * 64 + fr, fq * 8), boff = lds_byte(wc * 32 + fr, fq * 8);
#define PG8_SA(b, h) (((b) * 2 + (h)) * HTB)
#define PG8_SB(b, h) ((4 + (b) * 2 + (h)) * HTB)
#define PG8_STAGE(bufoff, gbase, voff) do { _Pragma("unroll") for (int _i = 0; _i < 2; ++_i) \
        __builtin_amdgcn_global_load_lds((const unsigned*)((const char*)(gbase) + (voff)[_i]), (LAS unsigned*)(lds + (bufoff) + ldsw + _i * 8192), 16, 0, 0); } while (0)
#define PG8_LDA(dst, b, h) do { _Pragma("unroll") for (int m = 0; m < 4; ++m) _Pragma("unroll") for (int k = 0; k < 2; ++k) dst[m][k] = *(const LAS bf16x8*)(lds + PG8_SA(b, h) + aoff + m * 2048 + k * 1024); } while (0)
#define PG8_LDB(dst, b, h) do { _Pragma("unroll") for (int n = 0; n < 2; ++n) _Pragma("unroll") for (int k = 0; k < 2; ++k) dst[n][k] = *(const LAS bf16x8*)(lds + PG8_SB(b, h) + boff + n * 2048 + k * 1024); } while (0)
#define PG8_MMA(ai, bj, At, Bt) do { __builtin_amdgcn_s_setprio(1); _Pragma("unroll") for (int m = 0; m < 4; ++m) _Pragma("unroll") for (int n = 0; n < 2; ++n) _Pragma("unroll") for (int k = 0; k < 2; ++k) \
        acc[ai][bj][m][n] = __builtin_amdgcn_mfma_f32_16x16x32_bf16(Bt[n][k], At[m][k], acc[ai][bj][m][n], 0, 0, 0); __builtin_amdgcn_s_setprio(0); } while (0)
#define PG8_WAIT_V(n) asm volatile("s_waitcnt vmcnt(" #n ")" ::: "memory")
#define PG8_WAIT_L(n) asm volatile("s_waitcnt lgkmcnt(" #n ")" ::: "memory")
#define PG8_BAR __builtin_amdgcn_s_barrier()
#define PG8_SCHED __builtin_amdgcn_sched_barrier(0)
    Unit cur, nxt; int ui = 0;
    if (!SNEXT(0, cur)) return;
    f32x4 acc[2][2][4][2];
#pragma unroll
    for (int a = 0; a < 2; ++a)
#pragma unroll
        for (int b = 0; b < 2; ++b)
#pragma unroll
            for (int m = 0; m < 4; ++m)
#pragma unroll
                for (int n = 0; n < 2; ++n) acc[a][b][m][n] = (f32x4){0.f, 0.f, 0.f, 0.f};
    bf16x8 At[4][2], B0[2][2], B1[2][2];
    float rsv[2][4];
#pragma unroll
    for (int ai = 0; ai < 2; ++ai)
#pragma unroll
        for (int m = 0; m < 4; ++m) rsv[ai][m] = 1.0f;
    const char* cA = APTR(cur); const char* cB = BPTR(cur);
    PG8_STAGE(PG8_SB(0, 0), cB, voffB); PG8_STAGE(PG8_SB(0, 1), cB + hstep, voffB); PG8_STAGE(PG8_SA(0, 0), cA, voffA); PG8_STAGE(PG8_SA(0, 1), cA + hstep, voffA);
    if (wr == 1) PG8_BAR;
    PG8_WAIT_V(2); PG8_BAR;
    PG8_STAGE(PG8_SB(1, 0), cB + kstep, voffB); PG8_STAGE(PG8_SA(1, 0), cA + kstep, voffA); PG8_STAGE(PG8_SB(1, 1), cB + hstep + kstep, voffB);
    PG8_WAIT_V(6); PG8_BAR;
    for (;;) {
        const bool has_next = SNEXT(ui + 1, nxt);
        const char* nA = has_next ? APTR(nxt) : cA; const char* nB = has_next ? BPTR(nxt) : cB;
        for (int t = 0; t < nt; t += 2) {
            const bool last = (t == nt - 2);
            if (last && p.mode != 1) {
                const float* rp = p.rs + cur.pm * BM + wr * 64 + fr;
#pragma unroll
                for (int ai = 0; ai < 2; ++ai)
#pragma unroll
                    for (int m = 0; m < 4; ++m) rsv[ai][m] = rp[ai * HALF + m * 16];
            }
            const char* a1 = cA + (size_t)(t + 1) * kstep;
            const char* a2 = last ? nA : cA + (size_t)(t + 2) * kstep; const char* b2 = last ? nB : cB + (size_t)(t + 2) * kstep;
            const char* a3 = a2 + kstep; const char* b3 = b2 + kstep;
            PG8_LDB(B0, 0, 0); PG8_LDB(B1, 0, 1); PG8_SCHED; PG8_LDA(At, 0, 0); PG8_STAGE(PG8_SA(1, 1), a1 + hstep, voffA);
            PG8_WAIT_V(8); PG8_WAIT_L(0); PG8_BAR; PG8_MMA(0, 0, At, B0); PG8_MMA(0, 1, At, B1); PG8_BAR; PG8_SCHED;
            PG8_LDA(At, 0, 1); PG8_STAGE(PG8_SB(0, 0), b2, voffB); PG8_STAGE(PG8_SB(0, 1), b2 + hstep, voffB); PG8_STAGE(PG8_SA(0, 0), a2, voffA);
            PG8_WAIT_V(8); PG8_WAIT_L(0); PG8_BAR; PG8_MMA(1, 0, At, B0); PG8_MMA(1, 1, At, B1); PG8_BAR; PG8_SCHED;
            PG8_LDB(B0, 1, 0); PG8_LDB(B1, 1, 1); PG8_SCHED; PG8_LDA(At, 1, 0); PG8_STAGE(PG8_SA(0, 1), a2 + hstep, voffA);
            PG8_WAIT_V(8); PG8_WAIT_L(0); PG8_BAR; PG8_MMA(0, 0, At, B0); PG8_MMA(0, 1, At, B1); PG8_BAR; PG8_SCHED;
            PG8_LDA(At, 1, 1); PG8_STAGE(PG8_SB(1, 0), b3, voffB); PG8_STAGE(PG8_SB(1, 1), b3 + hstep, voffB); PG8_STAGE(PG8_SA(1, 0), a3, voffA);
            PG8_WAIT_V(8); PG8_WAIT_L(0); PG8_BAR; PG8_MMA(1, 0, At, B0); PG8_MMA(1, 1, At, B1); PG8_BAR; PG8_SCHED;
        }
        if (wr == 0) PG8_BAR;
        epilogue(acc, cur, wr, wc, fr, fq, p.mode, p.out, p.ld, p.proj, p.vt, p.km, p.vmt, p.rs, rsv);
        if (!has_next) break;
#pragma unroll
        for (int a = 0; a < 2; ++a)
#pragma unroll
            for (int b = 0; b < 2; ++b)
#pragma unroll
                for (int m = 0; m < 4; ++m)
#pragma unroll
                    for (int n = 0; n < 2; ++n) acc[a][b][m][n] = (f32x4){0.f, 0.f, 0.f, 0.f};
        cur = nxt; cA = nA; cB = nB; ++ui;
        if (wr == 1) PG8_BAR;
    }
    PG8_WAIT_V(0);
    PG8_BAR;
#undef SNEXT
#undef APTR
#undef BPTR
#undef PG8_SA
#undef PG8_SB
#undef PG8_STAGE
#undef PG8_LDA
#undef PG8_LDB
#undef PG8_MMA
#undef PG8_WAIT_V
#undef PG8_WAIT_L
#undef PG8_BAR
#undef PG8_SCHED
}
}

__device__ __forceinline__ void transpose_item(const float* W, int K, int N, bf16_t* WT, int kb, int nbd, int src0, LAS float* scr, int lane, const float* gk = nullptr) {
    const int k0 = kb * 64;
    const float* wp = W + (size_t)(k0 + (lane >> 4)) * N + src0 + (lane & 15) * 4;
    f32x4 v[16];
#pragma unroll
    for (int i = 0; i < 16; ++i) v[i] = *(const f32x4*)(wp + (size_t)(4 * i) * N);
    SCHED_FENCE();
#pragma unroll
    for (int i = 0; i < 16; ++i) { if (gk) v[i] = v[i] * gk[k0 + 4 * i + (lane >> 4)];
        LAS float* s = scr + (4 * i + (lane >> 4)) * 65 + (lane & 15) * 4; s[0] = v[i].x; s[1] = v[i].y; s[2] = v[i].z; s[3] = v[i].w; }
    const int c = lane & 7;
#pragma unroll
    for (int jj = 0; jj < 8; ++jj) {
        const int n = (lane >> 3) + 8 * jj; const LAS float* s = scr + (8 * c) * 65 + n;
        u32x4 o; o.x = pk2(s[0], s[65]); o.y = pk2(s[2 * 65], s[3 * 65]); o.z = pk2(s[4 * 65], s[5 * 65]); o.w = pk2(s[6 * 65], s[7 * 65]);
        *(u32x4*)(WT + (size_t)(nbd * 64 + n) * K + k0 + 8 * c) = o;
    }
}
__device__ __forceinline__ int map_gu(int nb) { const int j = nb >> 2, part = nb & 3; return part < 2 ? 128 * j + 64 * part : DFF + 128 * j + 64 * (part - 2); }
__device__ __forceinline__ int map_win(int nb) { const int n = nb * 64; return n < 2048 ? n : n < 2560 ? n + 1024 : n < 3072 ? n + 1536 : n < 4096 ? n - 1024 : n - 512; }

__device__ __forceinline__ void norm_row_bf16(const float* xr, const float* g, bf16_t* o, int lane) {
    f32x4 v[8], gv[8]; float s = 0.f;
#pragma unroll
    for (int j = 0; j < 8; ++j) { v[j] = *(const f32x4*)(xr + 256 * j + 4 * lane); gv[j] = *(const f32x4*)(g + 256 * j + 4 * lane); }
    SCHED_FENCE();
#pragma unroll
    for (int j = 0; j < 8; ++j) s += (v[j].x * v[j].x + v[j].y * v[j].y) + (v[j].z * v[j].z + v[j].w * v[j].w);
    const float rs = rsqrtf(wave_sum(s, lane) * (1.0f / DM) + EPS);
#pragma unroll
    for (int j = 0; j < 8; ++j) {
        u32x2 w; w.x = pk2(v[j].x * rs * gv[j].x, v[j].y * rs * gv[j].y); w.y = pk2(v[j].z * rs * gv[j].z, v[j].w * rs * gv[j].w);
        *(u32x2*)(o + 256 * j + 4 * lane) = w; }
}
__device__ __forceinline__ void x_row(const float* xr, bf16_t* h, float* rs_out, int lane) {
    f32x4 v[8]; float s = 0.f;
#pragma unroll
    for (int j = 0; j < 8; ++j) v[j] = *(const f32x4*)(xr + 256 * j + 4 * lane);
    SCHED_FENCE();
#pragma unroll
    for (int j = 0; j < 8; ++j) { s += (v[j].x * v[j].x + v[j].y * v[j].y) + (v[j].z * v[j].z + v[j].w * v[j].w);
        u32x2 w; w.x = pk2(v[j].x, v[j].y); w.y = pk2(v[j].z, v[j].w); *(u32x2*)(h + 256 * j + 4 * lane) = w; }
    const float rs = rsqrtf(wave_sum(s, lane) * (1.0f / DM) + EPS);
    if (lane == 0) *rs_out = rs;
}
template <bool FINAL>
__device__ __forceinline__ void resid_row(const bf16_t* f, bf16_t* h, const f32x4 (&gp)[8], float alpha, float* rs_out, const f32x4 (&gn)[8], float* fin, int lane) {
    u32x2 wf[8], wh[8];
#pragma unroll
    for (int j = 0; j < 8; ++j) { wf[j] = *(const u32x2*)(f + 256 * j + 4 * lane); wh[j] = *(const u32x2*)(h + 256 * j + 4 * lane); }
    SCHED_FENCE();
    f32x4 v[8]; float s = 0.f;
#pragma unroll
    for (int j = 0; j < 8; ++j) { v[j] = (f32x4){bflo(wf[j].x), bfhi(wf[j].x), bflo(wf[j].y), bfhi(wf[j].y)};
        s += (v[j].x * v[j].x + v[j].y * v[j].y) + (v[j].z * v[j].z + v[j].w * v[j].w); }
    const float rs = rsqrtf(wave_sum(s, lane) * (1.0f / DM) + EPS) * alpha;
    float s2 = 0.f;
#pragma unroll
    for (int j = 0; j < 8; ++j) { const f32x4 hv = (f32x4){bflo(wh[j].x), bfhi(wh[j].x), bflo(wh[j].y), bfhi(wh[j].y)};
        v[j] = hv + v[j] * rs * gp[j]; s2 += (v[j].x * v[j].x + v[j].y * v[j].y) + (v[j].z * v[j].z + v[j].w * v[j].w);
        if (!FINAL) { u32x2 hw; hw.x = pk2(v[j].x, v[j].y); hw.y = pk2(v[j].z, v[j].w); *(u32x2*)(h + 256 * j + 4 * lane) = hw; } }
    const float rs2 = rsqrtf(wave_sum(s2, lane) * (1.0f / DM) + EPS);
    if (!FINAL) { if (lane == 0) *rs_out = rs2; }
    else {
#pragma unroll
        for (int j = 0; j < 8; ++j) *(f32x4*)(fin + 256 * j + 4 * lane) = v[j] * rs2 * gn[j]; }
}
template <int NR>
__device__ __forceinline__ void rescale_rows(bf16_t* y, size_t stride, const float* gna, const float* gsg, const float* gmem, int lane) {
    u32x4 w[NR][4];
#pragma unroll
    for (int i = 0; i < NR; ++i)
#pragma unroll
        for (int j = 0; j < 4; ++j) w[i][j] = *(const u32x4*)(y + (size_t)i * stride + 512 * j + 8 * lane);
    f32x4 g0[4], g1[4];
#pragma unroll
    for (int j = 0; j < 4; ++j) { const float* g = (j < 2 ? gna + 512 * j : j == 2 ? gsg : gmem) + 8 * lane; g0[j] = *(const f32x4*)g; g1[j] = *(const f32x4*)(g + 4); }
    SCHED_FENCE();
    float sna[NR], ssg[NR], sme[NR];
#pragma unroll
    for (int i = 0; i < NR; ++i) {
        float ss[4];
#pragma unroll
        for (int j = 0; j < 4; ++j) { const u32x4 v = w[i][j];
            const float a0 = bflo(v.x), a1 = bfhi(v.x), a2 = bflo(v.y), a3 = bfhi(v.y), a4 = bflo(v.z), a5 = bfhi(v.z), a6 = bflo(v.w), a7 = bfhi(v.w);
            ss[j] = (a0 * a0 + a1 * a1) + (a2 * a2 + a3 * a3) + (a4 * a4 + a5 * a5) + (a6 * a6 + a7 * a7); }
        sna[i] = ss[0] + ss[1]; ssg[i] = ss[2]; sme[i] = ss[3];
    }
#pragma unroll
    for (int o = 1; o < 64; o <<= 1)
#pragma unroll
        for (int i = 0; i < NR; ++i) { sna[i] += shfl_xor_l(sna[i], lane, o); ssg[i] += shfl_xor_l(ssg[i], lane, o); sme[i] += shfl_xor_l(sme[i], lane, o); }
#pragma unroll
    for (int i = 0; i < NR; ++i) {
        const float rna = rsqrtf(sna[i] * (1.0f / 1024) + EPS), rsg = rsqrtf(ssg[i] * (1.0f / 512) + EPS), rme = rsqrtf(sme[i] * (1.0f / 512) + EPS);
#pragma unroll
        for (int j = 0; j < 4; ++j) { const float r = j < 2 ? rna : j == 2 ? rsg : rme; const u32x4 v = w[i][j];
            u32x4 o; o.x = pk2(bflo(v.x) * r * g0[j].x, bfhi(v.x) * r * g0[j].y); o.y = pk2(bflo(v.y) * r * g0[j].z, bfhi(v.y) * r * g0[j].w);
            o.z = pk2(bflo(v.z) * r * g1[j].x, bfhi(v.z) * r * g1[j].y); o.w = pk2(bflo(v.w) * r * g1[j].z, bfhi(v.w) * r * g1[j].w);
            *(u32x4*)(y + (size_t)i * stride + 512 * j + 8 * lane) = o; }
    }
}

struct Ptrs {
    const float* in[25]; float* out; unsigned char* ws;
};
constexpr int VVT_LD = 136, RPB_OFF = 143360;
static_assert(2 * 256 * 272 <= RPB_OFF && 512 * VVT_LD * 2 + 4096 <= RPB_OFF && RPB_OFF + 8 * 15 * 32 * 4 <= LDS_BYTES - 16, "P5 LDS map");

constexpr int ABUF2 = 256 * 272;
template <bool NA>
__device__ __forceinline__ void attn_2phase(const bf16_t* qbase  , const bf16_t* kg0, const size_t kstep, const size_t kld,
                                            const bf16_t* vg0, const size_t vstep, const size_t vld, const LAS float* rpb, const int brow0, const int w0, const int qc,
                                            LAS unsigned char* lds, bf16_t* ybase, const int tid, const int lane, const int hh) {
    constexpr int NSTEP = NA ? 4 : 2, NGRP = NA ? 2 : 4, NHP = NA ? 4 : 2;
    const int fr = lane & 15, fq = lane >> 4;
    const unsigned kgo = (unsigned)(((size_t)(tid >> 5) * kld + (tid & 31) * 8) * 2), vgo = (unsigned)(((size_t)(tid >> 4) * vld + (tid & 15) * 8) * 2);
    const unsigned klo = (unsigned)((((tid >> 4) & 1) * 128 + (tid >> 5)) * 272 + (tid & 15) * 16), vlo = (unsigned)((tid >> 4) * 272 + (tid & 15) * 16);
    int bidx[8];
    if (NA) { const int cs = min(max(qc - 8, 0), 48);
#pragma unroll
        for (int e = 0; e < 8; ++e) { const int kc = w0 + (e >> 2) * 16 + fq * 4 + (e & 3); bidx[e] = (kc >= cs && kc < cs + 16) ? min(max(kc - qc, -15), 15) + 15 : 31; } }
    u32x4 t8[8];
#define A2_LOADK(hp_, s_) do { const char* _g = (const char*)(kg0 + (size_t)(s_) * kstep + (hp_) * 256); _Pragma("unroll") for (int j = 0; j < 8; ++j) t8[j] = *(const u32x4*)(_g + (size_t)j * (16 * kld * 2) + kgo); } while (0)
#define A2_LOADV(hp_, s_) do { const char* _g = (const char*)(vg0 + (size_t)(hp_) * 256 * vld + (size_t)(s_) * vstep); _Pragma("unroll") for (int j = 0; j < 8; ++j) t8[j] = *(const u32x4*)(_g + (size_t)j * (32 * vld * 2) + vgo); } while (0)
#define A2_WRITEK(buf_) do { _Pragma("unroll") for (int j = 0; j < 8; ++j) *(LAS u32x4*)((buf_) + klo + j * (16 * 272)) = t8[j]; } while (0)
#define A2_WRITEV(buf_) do { _Pragma("unroll") for (int j = 0; j < 8; ++j) *(LAS u32x4*)((buf_) + vlo + j * (32 * 272)) = t8[j]; } while (0)
    A2_LOADK(0, 0);
    __syncthreads();
    A2_WRITEK(lds);
    __syncthreads();
    int cb = 0;
    bf16x8 qf[4], qfn[4];
    { const bf16_t* qa = qbase + hh * 128;
#pragma unroll
      for (int dc = 0; dc < 4; ++dc) { qf[dc] = *(const bf16x8*)(qa + dc * 32); qfn[dc] = qf[dc]; } }
    __builtin_amdgcn_s_waitcnt(0x0F70);
#pragma unroll 1
    for (int hp = 0; hp < NHP; ++hp) {
        f32x4 sc[8][2];
#pragma unroll
        for (int ks = 0; ks < NSTEP; ++ks) {
            LAS unsigned char* cur = lds + cb * ABUF2; LAS unsigned char* nxt = lds + (cb ^ 1) * ABUF2;
            if (ks < NSTEP - 1) A2_LOADK(hp, ks + 1); else A2_LOADV(hp, 0);
            SCHED_FENCE();
#pragma unroll
            for (int g = 0; g < NGRP; ++g) {
                const int gi = ks * NGRP + g, koff = NA ? g * 64 + w0 : g * 32;
                const LAS unsigned char* kp = cur + (hh * 128 + koff + fr) * 272 + fq * 16;
                bf16x8 kf[2][4];
#pragma unroll
                for (int a = 0; a < 2; ++a)
#pragma unroll
                    for (int dc = 0; dc < 4; ++dc) kf[a][dc] = *(const LAS bf16x8*)(kp + a * 16 * 272 + dc * 64);
                f32x4 s0 = (f32x4){0.f, 0.f, 0.f, 0.f}, s1 = (f32x4){0.f, 0.f, 0.f, 0.f};
#pragma unroll
                for (int dc = 0; dc < 4; ++dc) { s0 = mfma16(kf[0][dc], qf[dc], s0); s1 = mfma16(kf[1][dc], qf[dc], s1); }
                if (NA) { const LAS float* br = rpb + ((hp * 2 + hh) * 15 + brow0 + 2 * ks + g) * 32;
#pragma unroll
                    for (int e = 0; e < 4; ++e) { s0[e] += br[bidx[e]]; s1[e] += br[bidx[4 + e]]; } }
                sc[gi][0] = s0; sc[gi][1] = s1;
            }
            SCHED_FENCE();
            if (ks < NSTEP - 1) A2_WRITEK(nxt); else A2_WRITEV(nxt);
            __syncthreads(); cb ^= 1;
        }
        float mx = -3.0e38f;
#pragma unroll
        for (int gi = 0; gi < 8; ++gi)
#pragma unroll
            for (int a = 0; a < 2; ++a) mx = fmaxf(mx, fmaxf(fmaxf(sc[gi][a].x, sc[gi][a].y), fmaxf(sc[gi][a].z, sc[gi][a].w)));
        mx = fmaxf(mx, shfl_xor_l(mx, lane, 16)); mx = fmaxf(mx, shfl_xor_l(mx, lane, 32));
        float l = 0.f; bf16x8 pb[8];
#pragma unroll
        for (int gi = 0; gi < 8; ++gi) {
            f32x4 p0 = sc[gi][0], p1 = sc[gi][1];
#pragma unroll
            for (int e = 0; e < 4; ++e) { p0[e] = fexp2(p0[e] - mx); p1[e] = fexp2(p1[e] - mx); }
            l += ((p0.x + p0.y) + (p0.z + p0.w)) + ((p1.x + p1.y) + (p1.z + p1.w));
            u32x4 pw; pw.x = pk2(p0.x, p0.y); pw.y = pk2(p0.z, p0.w); pw.z = pk2(p1.x, p1.y); pw.w = pk2(p1.z, p1.w);
            pb[gi] = __builtin_bit_cast(bf16x8, pw);
        }
        l += shfl_xor_l(l, lane, 16); l += shfl_xor_l(l, lane, 32);
        f32x4 o[8];
#pragma unroll
        for (int d = 0; d < 8; ++d) o[d] = (f32x4){0.f, 0.f, 0.f, 0.f};
#pragma unroll
        for (int vs = 0; vs < NSTEP; ++vs) {
            LAS unsigned char* cur = lds + cb * ABUF2; LAS unsigned char* nxt = lds + (cb ^ 1) * ABUF2;
            if (vs == NSTEP - 1 && hp < NHP - 1) {
                const bf16_t* qa = qbase + ((hp + 1) * 2 + hh) * 128;
#pragma unroll
                for (int dc = 0; dc < 4; ++dc) qfn[dc] = *(const bf16x8*)(qa + dc * 32);
            }
            if (vs < NSTEP - 1) A2_LOADV(hp, vs + 1); else if (hp < NHP - 1) A2_LOADK(hp + 1, 0);
            SCHED_FENCE();
#pragma unroll
            for (int g = 0; g < NGRP; ++g) {
                const int gi = vs * NGRP + g, voff = NA ? g * 64 + w0 : g * 32;
                const LAS unsigned char* vp = cur + (hh * 128 + fr) * 272 + (voff + fq * 4) * 2;
#pragma unroll
                for (int d = 0; d < 8; ++d) {
                    const u32x2 lo = *(const LAS u32x2*)(vp + d * 16 * 272), hi = *(const LAS u32x2*)(vp + d * 16 * 272 + 32);
                    u32x4 vw; vw.x = lo.x; vw.y = lo.y; vw.z = hi.x; vw.w = hi.y;
                    o[d] = mfma16(__builtin_bit_cast(bf16x8, vw), pb[gi], o[d]);
                }
            }
            SCHED_FENCE();
            if (vs < NSTEP - 1) A2_WRITEV(nxt); else if (hp < NHP - 1) A2_WRITEK(nxt);
            __syncthreads(); cb ^= 1;
        }
        const float inv = frcp(l);
        bf16_t* yp = ybase + (hp * 2 + hh) * 128;
#pragma unroll
        for (int d = 0; d < 8; ++d) { u32x2 w; w.x = pk2(o[d].x * inv, o[d].y * inv); w.y = pk2(o[d].z * inv, o[d].w * inv); *(u32x2*)(yp + d * 16) = w; }
#pragma unroll
        for (int dc = 0; dc < 4; ++dc) qf[dc] = qfn[dc];
    }
#undef A2_LOADK
#undef A2_LOADV
#undef A2_WRITEK
#undef A2_WRITEV
}

#define P5_LAUNDER() int tid = tid_in; asm volatile("" : "+v"(tid)); const int lane = tid & 63, fr = lane & 15, fq = lane >> 4
__device__ __forceinline__ void p5_unit(const Ptrs& P, LAS unsigned char* lds, int unit, int tid_in, int wave) {
    const bf16_t* proj = (const bf16_t*)(P.ws + WS_PROJ); const bf16_t* vt = (const bf16_t*)(P.ws + WS_VT);
    const bf16_t* km = (const bf16_t*)(P.ws + WS_KM); const bf16_t* vmt = (const bf16_t*)(P.ws + WS_VMT);
    const bf16_t* wsb = (const bf16_t*)(P.ws + WS_WSB);
    bf16_t* Y = (bf16_t*)P.out;
    const int b = unit >> 6, r = unit & 63, tok0 = b * SEQ + r * 64;
    const int rs = min(max(r - 4, 0), 56);
    LAS float* rpb = (LAS float*)(lds + RPB_OFF);
    LAS bf16_t* vvt = (LAS bf16_t*)lds;
    __syncthreads();
    {
        P5_LAUNDER(); (void)fr; (void)fq; (void)lane;
        float rv[8];
#pragma unroll
        for (int k = 0; k < 8; ++k) { const int i = min(tid + 512 * k, 8 * 15 * 32 - 1), c = i & 31; rv[k] = P.in[10][(i >> 5) * 31 + min(c, 30)]; }
        SCHED_FENCE();
#pragma unroll
        for (int k = 0; k < 8; ++k) { const int i = tid + 512 * k; if (i < 8 * 15 * 32) rpb[i] = (i & 31) < 31 ? rv[k] * LOG2E : -1.0e30f; }
    }
    {
        P5_LAUNDER(); (void)fr; (void)fq;
        const int t = tid >> 4, p = tid & 15, ctok = b * SEQ + (r >> 1) * 128;
        const char* vg = (const char*)(vt + (size_t)1024 * VT_LD + ctok);
        const unsigned vgo = (unsigned)(t * VT_LD + p * 8) * 2u;
        u32x4 d[16];
#pragma unroll
        for (int j = 0; j < 16; ++j) d[j] = *(const u32x4*)(vg + (size_t)j * (32 * VT_LD * 2) + vgo);
        SCHED_FENCE();
        LAS float* st = (LAS float*)lds;
        LAS float* st2 = (LAS float*)(lds + 512 * VVT_LD * 2);
#pragma unroll
        for (int g = 0; g < 4; ++g) {
            float sm[8], sq[8];
#pragma unroll
            for (int k = 0; k < 8; ++k) { sm[k] = 0.f; sq[k] = 0.f; }
#pragma unroll
            for (int jj = 0; jj < 4; ++jj) { const u32x4 w = d[4 * g + jj];
                const float x0 = bflo(w.x), x1 = bfhi(w.x), x2 = bflo(w.y), x3 = bfhi(w.y), x4 = bflo(w.z), x5 = bfhi(w.z), x6 = bflo(w.w), x7 = bfhi(w.w);
                sm[0] += x0; sq[0] += x0 * x0; sm[1] += x1; sq[1] += x1 * x1; sm[2] += x2; sq[2] += x2 * x2; sm[3] += x3; sq[3] += x3 * x3;
                sm[4] += x4; sq[4] += x4 * x4; sm[5] += x5; sq[5] += x5 * x5; sm[6] += x6; sq[6] += x6 * x6; sm[7] += x7; sq[7] += x7 * x7; }
            LAS f32x4* sp = (LAS f32x4*)(st + ((g * 32 + t) * 128 + p * 8) * 2);
            sp[0] = (f32x4){sm[0], sq[0], sm[1], sq[1]}; sp[1] = (f32x4){sm[2], sq[2], sm[3], sq[3]}; sp[2] = (f32x4){sm[4], sq[4], sm[5], sq[5]}; sp[3] = (f32x4){sm[6], sq[6], sm[7], sq[7]};
        }
        __syncthreads();
        float lgv[16], lbv[16];
        { const float* lgp = P.in[11] + t; const float* lbp = P.in[12] + t;
#pragma unroll
          for (int j = 0; j < 16; ++j) { lgv[j] = lgp[32 * j]; lbv[j] = lbp[32 * j]; } }
        SCHED_FENCE();
        {   const int g = tid >> 7, tok = tid & 127; float a = 0.f, q2 = 0.f;
#pragma unroll 8
            for (int tt = 0; tt < 32; ++tt) { const f32x2 v2 = *(const LAS f32x2*)(st + ((g * 32 + tt) * 128 + tok) * 2); a += v2.x; q2 += v2.y; }
            const float mu = a * (1.0f / 128), var = fmaxf(q2 * (1.0f / 128) - mu * mu, 0.f);
            *(LAS f32x2*)(st2 + (g * 128 + tok) * 2) = (f32x2){mu, rsqrtf(var + EPS)}; }
        __syncthreads();
#pragma unroll
        for (int g = 0; g < 4; ++g) {
            const LAS f32x4* mp = (const LAS f32x4*)(st2 + (g * 128 + p * 8) * 2);
            const f32x4 m01 = mp[0], m23 = mp[1], m45 = mp[2], m67 = mp[3];
#pragma unroll
            for (int jj = 0; jj < 4; ++jj) { const u32x4 w = d[4 * g + jj]; const int c = t + 32 * jj;
                const float lg = lgv[4 * g + jj], lb = lbv[4 * g + jj];
                u32x4 o;
                o.x = pk2((bflo(w.x) - m01.x) * m01.y * lg + lb, (bfhi(w.x) - m01.z) * m01.w * lg + lb);
                o.y = pk2((bflo(w.y) - m23.x) * m23.y * lg + lb, (bfhi(w.y) - m23.z) * m23.w * lg + lb);
                o.z = pk2((bflo(w.z) - m45.x) * m45.y * lg + lb, (bfhi(w.z) - m45.z) * m45.w * lg + lb);
                o.w = pk2((bflo(w.w) - m67.x) * m67.y * lg + lb, (bfhi(w.w) - m67.z) * m67.w * lg + lb);
                *(LAS u32x4*)(vvt + (g * 128 + c) * VVT_LD + p * 8) = o; }
        }
    }
    __syncthreads();
    {
        P5_LAUNDER();
        const int g = wave & 3, half = wave >> 2;
#pragma unroll 1
        for (int pb = 0; pb < 2; ++pb) {
            const int pl = half * 32 + pb * 16 + fr, pp = (r & 1) * 64 + pl;
            bf16x8 wf[4]; u32x2 uw[8];
            const bf16_t* up = proj + ((size_t)tok0 + pl) * PROJ_LD + 2048 + g * 128 + fq * 4;
#pragma unroll
            for (int qc = 0; qc < 4; ++qc) wf[qc] = *(const bf16x8*)(wsb + (size_t)(g * 128 + pp) * 128 + qc * 32 + fq * 8);
#pragma unroll
            for (int c = 0; c < 8; ++c) uw[c] = *(const u32x2*)(up + c * 16);
            const float bs = P.in[14][g * 128 + pp];
            f32x4 acc[8];
#pragma unroll
            for (int c = 0; c < 8; ++c) acc[c] = (f32x4){0.f, 0.f, 0.f, 0.f};
#pragma unroll
            for (int qc = 0; qc < 4; ++qc)
#pragma unroll
                for (int c = 0; c < 8; ++c) {
                    const bf16x8 af = *(const LAS bf16x8*)(vvt + (g * 128 + c * 16 + fr) * VVT_LD + qc * 32 + fq * 8);
                    acc[c] = mfma16(af, wf[qc], acc[c]);
                }
            bf16_t* yp = Y + ((size_t)tok0 + pl) * DM + 1024 + g * 128 + fq * 4;
#pragma unroll
            for (int c = 0; c < 8; ++c) {
                u32x2 w; w.x = pk2(bflo(uw[c].x) * (acc[c].x + bs), bfhi(uw[c].x) * (acc[c].y + bs)); w.y = pk2(bflo(uw[c].y) * (acc[c].z + bs), bfhi(uw[c].y) * (acc[c].w + bs));
                *(u32x2*)(yp + c * 16) = w; }
        }
    }
    {
        P5_LAUNDER();
        const int hh = wave & 1, qb = wave >> 1;
        const int w0 = qb == 0 ? 0 : qb == 1 ? 8 : qb == 2 ? 24 : 32;
        const size_t qtok = (size_t)tok0 + qb * 16 + fr;
        const size_t ktok = (size_t)b * SEQ + rs * 64;
        attn_2phase<true>(proj + qtok * PROJ_LD + fq * 8, proj + ktok * PROJ_LD + 1024, (size_t)128 * PROJ_LD, (size_t)PROJ_LD,
                          vt + ktok, (size_t)128, (size_t)VT_LD, rpb, rs - r + 7, w0, qb * 16 + fr, lds, Y + qtok * DM + fq * 4, tid, lane, hh);
        attn_2phase<false>(proj + qtok * PROJ_LD + 2560 + fq * 8, km + (size_t)(b * 256) * 512, (size_t)128 * 512, (size_t)512,
                           vmt + b * 256, (size_t)128, (size_t)1024, rpb, 0, 0, 0, lds, Y + qtok * DM + 1536 + fq * 4, tid, lane, hh);
    }
    __builtin_amdgcn_fence(__ATOMIC_RELEASE, "workgroup"); __syncthreads(); __builtin_amdgcn_fence(__ATOMIC_ACQUIRE, "workgroup");
    P5_LAUNDER(); (void)fr; (void)fq;
#pragma unroll 1
    for (int hb = 0; hb < 2; ++hb) rescale_rows<4>(Y + ((size_t)tok0 + wave * 8 + hb * 4) * DM, (size_t)DM, P.in[15], P.in[16], P.in[17], lane);
}

#define XB_TMO      128
#define XB_XCNT(j)  (256  + 64 * (j))
#define XB_XSUB(j)  (1280 + 64 * (j))
#define XB_XGEN(j)  (2304 + 64 * (j))
#define XB_TOP      3328
#define XB_TOPGEN   3392
#define XCD_BAR_WORDS 3456
#define XB_SPIN_CAP (1u << 18)
__device__ __forceinline__ unsigned xb_ld(unsigned* p)              { return __hip_atomic_load(p, __ATOMIC_RELAXED, __HIP_MEMORY_SCOPE_AGENT); }
__device__ __forceinline__ unsigned xb_add(unsigned* p, unsigned v) { return __hip_atomic_fetch_add(p, v, __ATOMIC_RELAXED, __HIP_MEMORY_SCOPE_AGENT); }
__device__ __forceinline__ unsigned xb_xcc_id() { return (unsigned)__builtin_amdgcn_s_getreg((3 << 11) | 20) & 0xFu; }
#define XB_SPIN(cond, bar) do { unsigned _sp = 0; while (cond) { __builtin_amdgcn_s_sleep(1); \
    if ((++_sp & 255u) == 0u) { if (xb_ld(&(bar)[XB_TMO])) break; if (_sp > XB_SPIN_CAP) { atomicAdd(&(bar)[XB_TMO], 1u); break; } } } } while (0)
struct XcdBarrier { unsigned* bar; unsigned x; volatile LAS unsigned* st; };
__device__ __forceinline__ XcdBarrier xcd_barrier_post(unsigned* bar, volatile LAS unsigned* st) {
    XcdBarrier b; b.bar = bar; b.x = xb_xcc_id(); b.st = st;
    if (threadIdx.x == 0) (void)xb_add(&bar[XB_XCNT(b.x)], 1u);
    return b;
}
__device__ __forceinline__ void xcd_barrier_complete(unsigned* bar, unsigned x, unsigned& nloc, unsigned& nx) {
    const unsigned G = gridDim.x * gridDim.y * gridDim.z;
    unsigned sum, cnt, mine, sp = 0u;
    for (;;) {
        sum = 0u; cnt = 0u; mine = 0u;
#pragma unroll
        for (unsigned j = 0; j < 16; ++j) { const unsigned c = xb_ld(&bar[XB_XCNT(j)]); sum += c; cnt += (c > 0u) ? 1u : 0u; mine = (j == x) ? c : mine; }
        if (sum == G) break;
        __builtin_amdgcn_s_sleep(1);
        if ((++sp & 255u) == 0u) { if (xb_ld(&bar[XB_TMO])) break; if (sp > XB_SPIN_CAP) { atomicAdd(&bar[XB_TMO], 1u); break; } }
    }
    nloc = mine > 0u ? mine : 1u; nx = cnt > 0u ? cnt : 1u;
}
__device__ __forceinline__ void xcd_barrier(const XcdBarrier& b) {
    asm volatile("s_waitcnt vmcnt(0)" ::: "memory");
    __syncthreads();
    if (threadIdx.x == 0) {
        unsigned* bar = b.bar;
        __builtin_amdgcn_s_waitcnt(0);
        unsigned nloc = b.st[0], nx = b.st[1];
        if (nloc == 0u) { xcd_barrier_complete(bar, b.x, nloc, nx); b.st[0] = nloc; b.st[1] = nx; }
        const unsigned old = xb_add(&bar[XB_XSUB(b.x)], 1u);
        const unsigned gen = old / nloc;
        if (old + 1u == (gen + 1u) * nloc) {
            __builtin_amdgcn_fence(__ATOMIC_RELEASE, "agent");
            asm volatile("s_waitcnt vmcnt(0)" ::: "memory");
            const unsigned og = xb_add(&bar[XB_TOP], 1u);
            const unsigned tg = og / nx;
            if (og + 1u == (tg + 1u) * nx) xb_add(&bar[XB_TOPGEN], 1u);
            else XB_SPIN(xb_ld(&bar[XB_TOPGEN]) == tg, bar);
            __builtin_amdgcn_fence(__ATOMIC_ACQUIRE, "agent");
            xb_add(&bar[XB_XGEN(b.x)], 1u);
            asm volatile("s_waitcnt vmcnt(0)" ::: "memory");
        } else {
            XB_SPIN(xb_ld(&bar[XB_XGEN(b.x)]) == gen, bar);
            __builtin_amdgcn_fence(__ATOMIC_ACQUIRE, "agent");
            asm volatile("s_waitcnt vmcnt(0)" ::: "memory");
        }
    }
    __syncthreads();
}

struct Args { const float* in[25]; float* out; unsigned char* ws; int ph_lo, ph_hi; };

__global__ void __launch_bounds__(512, 2) fwd_kernel(Args a) {
    extern __shared__ __attribute__((aligned(16))) unsigned char smem[];
    LAS unsigned char* lds = (LAS unsigned char*)smem;
    cg::grid_group grid = cg::this_grid();
    const int wave0 = __builtin_amdgcn_readfirstlane((int)threadIdx.x >> 6);
    const int G = gridDim.x, bid = blockIdx.x, ngw = G * 8;
    Ptrs P;
#pragma unroll
    for (int i = 0; i < 25; ++i) P.in[i] = a.in[i];
    P.out = a.out; P.ws = a.ws;
    unsigned char* ws = a.ws;
    bf16_t* XN = (bf16_t*)(ws + WS_XN)  ; bf16_t* H = (bf16_t*)(ws + WS_H); bf16_t* F = (bf16_t*)(ws + WS_F);
    float* RS = (float*)(ws + WS_RS); bf16_t* Yb = (bf16_t*)a.out;

    const bool multi = (a.ph_hi - a.ph_lo) > 1;
    volatile LAS unsigned* xb_st = (volatile LAS unsigned*)(lds + LDS_BYTES - 16);
    XcdBarrier bar; bar.bar = (unsigned*)(ws + WS_BAR); bar.x = 0; bar.st = xb_st;
    if (multi) { if (threadIdx.x == 0) { xb_st[0] = 0u; xb_st[1] = 0u; } __syncthreads(); bar = xcd_barrier_post((unsigned*)(ws + WS_BAR), xb_st); }
    if (a.ph_hi > 1000) grid.sync();
    for (int ph = a.ph_lo; ph < a.ph_hi; ++ph) {
        if (ph == 6) continue;
#define PH_LAUNDER() int tid = wave0 * 64 + (int)__builtin_amdgcn_mbcnt_hi(~0u, __builtin_amdgcn_mbcnt_lo(~0u, 0u)); asm volatile("" : "+v"(tid)); \
        const int lane = tid & 63, wave = wave0, gw = bid * 8 + wave; (void)lane; (void)gw
        const bool is_gemm = (ph == 1 || ph == 2 || ph == 4 || ph == 7 || ph == 9 || ph == 10);
        if (is_gemm) {
            PH_LAUNDER();
            pg8::GP p; p.K = DM; p.G = G; p.c = bid; p.mode = 1; p.ld = DM; p.out = F; p.nM0 = 64; p.nN0 = 8; p.total = 512;
            p.proj = (bf16_t*)(ws + WS_PROJ); p.vt = (bf16_t*)(ws + WS_VT); p.km = (bf16_t*)(ws + WS_KM); p.vmt = (bf16_t*)(ws + WS_VMT);
            const bf16_t* win = (const bf16_t*)(ws + WS_WIN); const bf16_t* wmkv = (const bf16_t*)(ws + WS_WMKV); const bf16_t* memn = (const bf16_t*)(ws + WS_MEMN);
            p.rs = RS; p.A0 = XN; p.B0 = (const bf16_t*)(ws + WS_WOUT);
            p.A1 = win + (size_t)3072 * DM; p.B1 = XN; p.A2 = memn; p.B2 = wmkv; p.A3 = wmkv + (size_t)512 * DM; p.B3 = memn;
            if (ph == 1 || ph == 9) { p.B0 = (const bf16_t*)(ws + (ph == 1 ? WS_WGU1 : WS_WGU2)); p.nN0 = 44; p.total = 64 * 44; p.mode = 0; p.out = H; }
            else if (ph == 7) { p.A0 = Yb; }
            else if (ph == 2 || ph == 10) { p.A0 = H; p.B0 = (const bf16_t*)(ws + (ph == 2 ? WS_WD1 : WS_WD2)); p.K = DFF; }
            else if (ph == 4) { p.B0 = win; p.nN0 = 12; p.total = 1168; p.mode = 2; }
            pg8::gemm_phase(lds, p, tid);
        } else if (ph == 0) {
            PH_LAUNDER();
            LAS float* scr = (LAS float*)(lds + wave * (64 * 65 * 4));
            constexpr int I_GU = 32 * 176, I_D = 88 * 32, I_IN = 32 * 72, I_MKV = 32 * 16, I_OUT = 32 * 32;
            constexpr int NITEMS = 2 * I_GU + 2 * I_D + I_IN + I_MKV + I_OUT;
            for (int it = gw; it < NITEMS; it += ngw) {
                int r = it;
                if (r < I_GU) { const int nb = r % 176; transpose_item(P.in[3], DM, NGU, (bf16_t*)(ws + WS_WGU1), r / 176, nb, map_gu(nb), scr, lane, P.in[2]); continue; } r -= I_GU;
                if (r < I_GU) { const int nb = r % 176; transpose_item(P.in[21], DM, NGU, (bf16_t*)(ws + WS_WGU2), r / 176, nb, map_gu(nb), scr, lane, P.in[20]); continue; } r -= I_GU;
                if (r < I_D) { const int nb = r % 32; transpose_item(P.in[4], DFF, DM, (bf16_t*)(ws + WS_WD1), r / 32, nb, nb * 64, scr, lane); continue; } r -= I_D;
                if (r < I_D) { const int nb = r % 32; transpose_item(P.in[22], DFF, DM, (bf16_t*)(ws + WS_WD2), r / 32, nb, nb * 64, scr, lane); continue; } r -= I_D;
                if (r < I_IN) { const int nb = r % 72; transpose_item(P.in[8], DM, 4608, (bf16_t*)(ws + WS_WIN), r / 72, nb, map_win(nb), scr, lane, P.in[6]); continue; } r -= I_IN;
                if (r < I_MKV) { const int nb = r % 16; transpose_item(P.in[9], DM, 1024, (bf16_t*)(ws + WS_WMKV), r / 16, nb, nb * 64, scr, lane); continue; } r -= I_MKV;
                { const int nb = r % 32; transpose_item(P.in[18], DM, DM, (bf16_t*)(ws + WS_WOUT), r / 32, nb, nb * 64, scr, lane); }
            }
            for (int i = gw * 64 + lane; i < 4 * 128 * 128 / 2; i += ngw * 64) { const float2 v = *(const float2*)(P.in[13] + 2 * i); ((unsigned*)(ws + WS_WSB))[i] = pk2(v.x, v.y); }
            for (int m = gw; m < MTOK; m += ngw) x_row(P.in[0] + (size_t)m * DM, XN + (size_t)m * DM, RS + m, lane);
            for (int m = gw; m < 1024; m += ngw) norm_row_bf16(P.in[1] + (size_t)m * DM, P.in[7], (bf16_t*)(ws + WS_MEMN) + (size_t)m * DM, lane);
        } else if (ph == 3 || ph == 8 || ph == 11) {
            PH_LAUNDER();
            const float* gpp = a.in[ph == 3 ? 5 : ph == 8 ? 19 : 23];
            const float* gnp = a.in[24];
            f32x4 gp[8], gn[8];
#pragma unroll
            for (int j = 0; j < 8; ++j) { gp[j] = *(const f32x4*)(gpp + 256 * j + 4 * lane); gn[j] = *(const f32x4*)(gnp + 256 * j + 4 * lane); }
            if (ph == 11) { for (int m = gw; m < MTOK; m += ngw) resid_row<true>(F + (size_t)m * DM, XN + (size_t)m * DM, gp, 0.5f, nullptr, gn, P.out + (size_t)m * DM, lane); }
            else { const float alpha = ph == 3 ? 0.5f : 1.0f;
                for (int m = gw; m < MTOK; m += ngw) resid_row<false>(F + (size_t)m * DM, XN + (size_t)m * DM, gp, alpha, RS + m, gn, nullptr, lane); }
        } else if (ph == 5) {
            PH_LAUNDER();
            for (int u = bid; u < 256; u += G) p5_unit(P, lds, (G == 256) ? ((u & 7) * 32 + (u >> 3)) : u, tid, wave);
        }
        if (ph + 1 < a.ph_hi) xcd_barrier(bar);
    }
}

extern "C" void kernel_launch(void* const* d_in, const int* in_sizes, int n_in, void* d_out, int out_size, void* d_ws, size_t ws_size, hipStream_t stream) {
    static int grid = 0;
    if (grid == 0) {
        if (n_in != 25 || out_size != MTOK * DM || ws_size < WS_TOTAL) { fprintf(stderr, "kernel_launch: unexpected problem (n_in %d, out %d, ws %zu < %zu)\n", n_in, out_size, ws_size, (size_t)WS_TOTAL); grid = -1; return; }
        int dev = 0, cus = 0, per_cu = 0;
        (void)hipGetDevice(&dev);
        (void)hipDeviceGetAttribute(&cus, hipDeviceAttributeMultiprocessorCount, dev);
        (void)hipFuncSetAttribute((const void*)fwd_kernel, hipFuncAttributeMaxDynamicSharedMemorySize, LDS_BYTES);
        (void)hipOccupancyMaxActiveBlocksPerMultiprocessor(&per_cu, (const void*)fwd_kernel, 512, LDS_BYTES);
        if (per_cu < 1) { fprintf(stderr, "kernel_launch: occupancy query says %d blocks per CU\n", per_cu); per_cu = 1; }
        grid = cus * 1;
        (void)hipGetLastError();
    }
    if (grid < 0) return;
    Args a{};
    for (int i = 0; i < 25; ++i) a.in[i] = (const float*)d_in[i];
    a.out = (float*)d_out; a.ws = (unsigned char*)d_ws;
    a.ph_lo = 0; a.ph_hi = NPHASE;
    (void)hipMemsetAsync((unsigned char*)d_ws + WS_BAR, 0, 16384, stream);
    void* args[] = {&a};
    hipError_t e = hipLaunchCooperativeKernel((const void*)fwd_kernel, dim3(grid), dim3(512), args, LDS_BYTES, stream);
    if (e != hipSuccess) fprintf(stderr, "cooperative launch failed: %s (grid %d)\n", hipGetErrorString(e), grid);
}
```
